# Optimizing an MI355X kernel written in HIP

```python
import math
import jax, jax.numpy as jnp
from jax import lax
import numpy as np

D_MODEL = 1024
BATCH = 32
SEQ = 256
DEPTH = 2
DEC_BATCH = 2
DEC_SEQ = 1024
PAST_LEN = 256

GRID_W = 64
CONV_W = 512
CONV_K = 31
CONV_PAD = (CONV_K - 1) // 2
SSM_W = 512
SSM_GC = 16
SSM_G = SSM_W // SSM_GC
SSM_P = 64
N_DIR = 2
N_HEADS = 8
N_KV_HEADS = 2
HEAD_DIM = 64
GQ = N_HEADS // N_KV_HEADS
ATTN_W = N_HEADS * HEAD_DIM
KV_W = N_KV_HEADS * HEAD_DIM
ROPE_PAIRS = HEAD_DIM // 4
ROPE_BASE = 10000.0
Q_BLOCK = 128
N_BRANCH = 3
EPS = 1e-6
IN_SIZES = (2 * CONV_W, CONV_W, SSM_W, SSM_W, ATTN_W, KV_W, KV_W, ATTN_W, N_BRANCH * D_MODEL)
IN_COLS = sum(IN_SIZES)

kernel_name = 'hybrid_conv_s5_gqa_prefix_dit_step'

F32 = jnp.float32


def _rmsnorm(x, g):
    xf = x.astype(F32)
    y = xf * lax.rsqrt(jnp.mean(xf * xf, axis=-1, keepdims=True) + EPS)
    return (y * g.astype(F32)).astype(x.dtype)


def _layernorm(x, g, b):
    xf = x.astype(F32)
    mu = jnp.mean(xf, axis=-1, keepdims=True)
    xc = xf - mu
    y = xc * lax.rsqrt(jnp.mean(xc * xc, axis=-1, keepdims=True) + EPS)
    return (y * g.astype(F32) + b.astype(F32)).astype(x.dtype)


def _adaln(cond, w, b):
    m = jax.nn.silu(cond) @ w + b
    return jnp.split(m[:, None, :], 3, axis=-1)


def _grid_angles(n_tok):
    rows = n_tok // GRID_W
    row = jnp.repeat(jnp.arange(rows, dtype=F32), GRID_W)
    col = jnp.tile(jnp.arange(GRID_W, dtype=F32), rows)
    inv = ROPE_BASE ** (-jnp.arange(ROPE_PAIRS, dtype=F32) / ROPE_PAIRS)
    return row[:, None] * inv[None, :], col[:, None] * inv[None, :]


def _rotate(xp, ang):
    x1, x2 = xp[..., :ROPE_PAIRS], xp[..., ROPE_PAIRS:]
    cos = jnp.cos(ang)[None, :, None, :]
    sin = jnp.sin(ang)[None, :, None, :]
    return jnp.concatenate([x1 * cos - x2 * sin, x1 * sin + x2 * cos], axis=-1)


def _axial_rope(x, angles):
    ang_row, ang_col = angles
    xf = x.astype(F32)
    half = HEAD_DIM // 2
    out = jnp.concatenate([_rotate(xf[..., :half], ang_row), _rotate(xf[..., half:], ang_col)], axis=-1)
    return out.astype(x.dtype)


def _blocked_attention(q, k, v):
    bsz, lq = q.shape[:2]
    nb = lq // Q_BLOCK
    qb = q.reshape(bsz, nb, Q_BLOCK, N_KV_HEADS, GQ, HEAD_DIM).transpose(1, 0, 2, 3, 4, 5)
    scale = HEAD_DIM ** -0.5

    def one_block(qblk):
        s = jnp.einsum('bqkgd,bskd->bkgqs', qblk, k).astype(F32) * scale
        p = jax.nn.softmax(s, axis=-1).astype(v.dtype)
        return jnp.einsum('bkgqs,bskd->bqkgd', p, v)

    o = lax.map(one_block, qb)
    return o.transpose(1, 0, 2, 3, 4, 5).reshape(bsz, lq, ATTN_W)


def _conformer_conv(u, dw_w, dw_b, ln_g, ln_b):
    a, g = jnp.split(u, 2, axis=-1)
    y = a * jax.nn.sigmoid(g)
    y = lax.conv_general_dilated(
        y, dw_w[:, None, :].astype(y.dtype), window_strides=(1,), padding=[(CONV_PAD, CONV_PAD)],
        dimension_numbers=('NWC', 'WIO', 'NWC'), feature_group_count=CONV_W) + dw_b.astype(y.dtype)
    return jax.nn.silu(_layernorm(y, ln_g, ln_b))


def _ssm_combine(e1, e2):
    a1, b1 = e1
    a2, b2 = e2
    return a1 * a2, a2 * b1 + b2


def _s5_bidirectional(u, a_re, a_im, log_dt, b_re, b_im, c_re, c_im, d, init_re, init_im):
    bsz, n = u.shape[:2]
    uf = u.astype(F32).reshape(bsz, n, SSM_G, SSM_GC)
    uc = uf.astype(jnp.complex64)
    y = d.astype(F32).reshape(SSM_G, SSM_GC) * uf
    want_final = init_re is None
    fin_re, fin_im = [], []
    for dirn in range(N_DIR):
        rev = dirn == 1
        lam = lax.complex(a_re[dirn].astype(F32), a_im[dirn].astype(F32))
        dt = jnp.exp(log_dt[dirn].astype(F32))[:, None]
        lam_bar = jnp.exp(lam * dt)
        b_bar = ((lam_bar - 1.0) / lam)[..., None] * lax.complex(b_re[dirn].astype(F32), b_im[dirn].astype(F32))
        bu = jnp.einsum('blgc,gpc->blgp', uc, b_bar)
        if not want_final:
            h0 = lax.complex(init_re[:, dirn].astype(F32), init_im[:, dirn].astype(F32))
            edge = n - 1 if rev else 0
            bu = bu.at[:, edge].add(lam_bar * h0)
        a = jnp.broadcast_to(lam_bar, bu.shape)
        _, hs = lax.associative_scan(_ssm_combine, (a, bu), axis=1, reverse=rev)
        if want_final:
            fin = hs[:, 0] if rev else hs[:, -1]
            fin_re.append(fin.real)
            fin_im.append(fin.imag)
        c_mat = lax.complex(c_re[dirn].astype(F32), c_im[dirn].astype(F32))
        y = y + jnp.einsum('blgp,gcp->blgc', hs, c_mat).real
    y = y.reshape(bsz, n, SSM_W).astype(u.dtype)
    if want_final:
        return y, jnp.stack(fin_re, axis=1), jnp.stack(fin_im, axis=1)
    return y, None, None


def _layer(x, mods, lp, angles, ctx_k, ctx_v, init_re, init_im):
    shift, scale, gate = mods
    bsz, n = x.shape[:2]
    h = _rmsnorm(x, lp['norm_g']) * (1.0 + scale) + shift
    z = h @ lp['w_in']
    cuts = np.cumsum(IN_SIZES)[:-1].tolist()
    conv_in, conv_gate, ssm_in, ssm_gate, q, k, v, attn_gate, merge = jnp.split(z, cuts, axis=-1)
    ya = _conformer_conv(conv_in, lp['conv_dw_w'], lp['conv_dw_b'], lp['conv_ln_g'], lp['conv_ln_b'])
    br_a = (ya * jax.nn.silu(conv_gate)) @ lp['w_conv_out']
    yb, fin_re, fin_im = _s5_bidirectional(
        ssm_in, lp['ssm_a_re'], lp['ssm_a_im'], lp['ssm_log_dt'], lp['ssm_b_re'], lp['ssm_b_im'],
        lp['ssm_c_re'], lp['ssm_c_im'], lp['ssm_d'], init_re, init_im)
    yg_a, yg_b = jnp.split(jax.nn.gelu(yb) @ lp['w_ssm_glu'], 2, axis=-1)
    yb = yg_a * jax.nn.sigmoid(yg_b)
    br_b = (yb * jax.nn.silu(ssm_gate)) @ lp['w_ssm_out']
    q = _rmsnorm(q.reshape(bsz, n, N_HEADS, HEAD_DIM), lp['q_norm_g'])
    k = _rmsnorm(k.reshape(bsz, n, N_KV_HEADS, HEAD_DIM), lp['k_norm_g'])
    v = v.reshape(bsz, n, N_KV_HEADS, HEAD_DIM)
    if ctx_k is None:
        k_all, v_all = k, v
    else:
        q = _axial_rope(q, angles)
        k_all = jnp.concatenate([_axial_rope(k, angles), ctx_k.astype(k.dtype)], axis=1)
        v_all = jnp.concatenate([v, ctx_v.astype(v.dtype)], axis=1)
    o = _blocked_attention(q, k_all, v_all)
    br_c = (o * jax.nn.silu(attn_gate)) @ lp['w_attn_out']
    g_a, g_b, g_c = jnp.split(jax.nn.sigmoid(merge), N_BRANCH, axis=-1)
    mixed = g_a * br_a + g_b * br_b + g_c * br_c
    x = x + gate * (mixed @ lp['w_out'])
    side = (k, v, fin_re, fin_im) if ctx_k is None else None
    return x, side


def setup_inputs(seed: int = 0) -> dict:
    key = jax.random.key(seed)
    ks = iter(jax.random.split(key, 48))

    def nrm(shape, scale):
        return jax.random.normal(next(ks), shape, F32) * scale

    n_idx = jnp.arange(SSM_P, dtype=F32)
    return {
        'x_prompt': nrm((BATCH, SEQ, D_MODEL), 1.0),
        'x_sample': nrm((DEC_BATCH, DEC_SEQ, D_MODEL), 1.0),
        'cache_k': nrm((DEC_BATCH, DEPTH, PAST_LEN, N_KV_HEADS, HEAD_DIM), 1.0),
        'cache_v': nrm((DEC_BATCH, DEPTH, PAST_LEN, N_KV_HEADS, HEAD_DIM), 1.0),
        'state_ssm_re': nrm((DEC_BATCH, DEPTH, N_DIR, SSM_G, SSM_P), 0.5),
        'state_ssm_im': nrm((DEC_BATCH, DEPTH, N_DIR, SSM_G, SSM_P), 0.5),
        'c': nrm((DEC_BATCH, D_MODEL), 1.0),
        'c_ctx': nrm((D_MODEL,), 1.0),
        'norm_g': 1.0 + nrm((DEPTH, D_MODEL), 0.02),
        'w_ada': nrm((DEPTH, D_MODEL, 3 * D_MODEL), 0.5 * D_MODEL ** -0.5),
        'b_ada': nrm((DEPTH, 3 * D_MODEL), 0.01),
        'w_in': nrm((DEPTH, D_MODEL, IN_COLS), D_MODEL ** -0.5),
        'conv_dw_w': nrm((DEPTH, CONV_K, CONV_W), CONV_K ** -0.5),
        'conv_dw_b': nrm((DEPTH, CONV_W), 0.01),
        'conv_ln_g': 1.0 + nrm((DEPTH, CONV_W), 0.02),
        'conv_ln_b': nrm((DEPTH, CONV_W), 0.01),
        'w_conv_out': nrm((DEPTH, CONV_W, D_MODEL), CONV_W ** -0.5),
        'ssm_a_re': -0.5 + nrm((DEPTH, N_DIR, SSM_G, SSM_P), 0.01),
        'ssm_a_im': math.pi * n_idx + nrm((DEPTH, N_DIR, SSM_G, SSM_P), 0.01),
        'ssm_log_dt': jax.random.uniform(next(ks), (DEPTH, N_DIR, SSM_G), F32, math.log(1e-3), math.log(1e-1)),
        'ssm_b_re': nrm((DEPTH, N_DIR, SSM_G, SSM_P, SSM_GC), (2 * SSM_GC) ** -0.5),
        'ssm_b_im': nrm((DEPTH, N_DIR, SSM_G, SSM_P, SSM_GC), (2 * SSM_GC) ** -0.5),
        'ssm_c_re': nrm((DEPTH, N_DIR, SSM_G, SSM_GC, SSM_P), (2 * SSM_P) ** -0.5),
        'ssm_c_im': nrm((DEPTH, N_DIR, SSM_G, SSM_GC, SSM_P), (2 * SSM_P) ** -0.5),
        'ssm_d': nrm((DEPTH, SSM_W), 1.0),
        'w_ssm_glu': nrm((DEPTH, SSM_W, 2 * SSM_W), SSM_W ** -0.5),
        'w_ssm_out': nrm((DEPTH, SSM_W, D_MODEL), SSM_W ** -0.5),
        'q_norm_g': 1.0 + nrm((DEPTH, HEAD_DIM), 0.02),
        'k_norm_g': 1.0 + nrm((DEPTH, HEAD_DIM), 0.02),
        'w_attn_out': nrm((DEPTH, ATTN_W, D_MODEL), ATTN_W ** -0.5),
        'w_out': nrm((DEPTH, D_MODEL, D_MODEL), D_MODEL ** -0.5),
    }


def reference(x_prompt, x_sample, cache_k, cache_v, state_ssm_re, state_ssm_im, c, c_ctx,
              norm_g, w_ada, b_ada, w_in, conv_dw_w, conv_dw_b, conv_ln_g, conv_ln_b, w_conv_out,
              ssm_a_re, ssm_a_im, ssm_log_dt, ssm_b_re, ssm_b_im, ssm_c_re, ssm_c_im, ssm_d,
              w_ssm_glu, w_ssm_out, q_norm_g, k_norm_g, w_attn_out, w_out):
    angles = _grid_angles(x_sample.shape[1])
    yp = x_prompt
    ys = x_sample
    ks_out, vs_out, re_out, im_out = [], [], [], []
    for l in range(DEPTH):
        lp = dict(norm_g=norm_g[l], w_in=w_in[l], conv_dw_w=conv_dw_w[l], conv_dw_b=conv_dw_b[l],
                  conv_ln_g=conv_ln_g[l], conv_ln_b=conv_ln_b[l], w_conv_out=w_conv_out[l],
                  ssm_a_re=ssm_a_re[l], ssm_a_im=ssm_a_im[l], ssm_log_dt=ssm_log_dt[l],
                  ssm_b_re=ssm_b_re[l], ssm_b_im=ssm_b_im[l], ssm_c_re=ssm_c_re[l], ssm_c_im=ssm_c_im[l],
                  ssm_d=ssm_d[l], w_ssm_glu=w_ssm_glu[l], w_ssm_out=w_ssm_out[l],
                  q_norm_g=q_norm_g[l], k_norm_g=k_norm_g[l], w_attn_out=w_attn_out[l], w_out=w_out[l])
        ctx_mods = _adaln(c_ctx[None, :], w_ada[l], b_ada[l])
        yp, side = _layer(yp, ctx_mods, lp, None, None, None, None, None)
        k_l, v_l, re_l, im_l = side
        ks_out.append(k_l)
        vs_out.append(v_l)
        re_out.append(re_l)
        im_out.append(im_l)
        lat_mods = _adaln(c, w_ada[l], b_ada[l])
        ys, _ = _layer(ys, lat_mods, lp, angles, cache_k[:, l], cache_v[:, l],
                       state_ssm_re[:, l], state_ssm_im[:, l])
    new_cache_k = jnp.stack(ks_out, axis=1)
    new_cache_v = jnp.stack(vs_out, axis=1)
    new_state_ssm_re = jnp.stack(re_out, axis=1)
    new_state_ssm_im = jnp.stack(im_out, axis=1)
    return (yp, ys, new_cache_k, new_cache_v, new_state_ssm_re, new_state_ssm_im)
```

```cpp
#include <hip/hip_runtime.h>
#include <hip/hip_cooperative_groups.h>
#include <cstdio>
#include <cstdint>
#include <cmath>
namespace cg = cooperative_groups;
namespace pg8 {
#define PG8_LAS __attribute__((address_space(3)))
typedef unsigned short bf16_t;
typedef short bf16x8 __attribute__((ext_vector_type(8)));
typedef float f32x4 __attribute__((ext_vector_type(4)));
typedef unsigned u32x4 __attribute__((ext_vector_type(4)));
constexpr int BM = 256, BK = 64, HALF = 128, HTB = HALF * BK * 2  , STAGE_BYTES = 8 * HTB, NXCD = 8, WGM = 8;

__host__ __device__ __forceinline__ int lds_byte(int r, int c) { const int st = (r >> 4) * 2 + (c >> 5), rr = r & 15, cc = c & 31, ob = rr * 64 + cc * 2; return st * 1024 + (ob ^ (((ob >> 9) & 1) << 5)); }
__host__ __device__ __forceinline__ void stage_rc(int b, int& R, int& C) { const int st = b / 1024, sb = b % 1024, swz = sb ^ (((sb >> 9) & 1) << 5); R = (st >> 1) * 16 + swz / 64; C = (st & 1) * 32 + (swz % 64) / 2; }
__host__ __device__ __forceinline__ int perm32(int rho) { const int n = rho >> 4, i = rho & 15; return 8 * (i >> 2) + 4 * n + (i & 3); }

struct Unit { int pm, pn; };
struct Gemm { const bf16_t* A; const bf16_t* Bt; int M, N, K; };

struct StaticOrder {
    int nM, nN, nwg, G, c;
    __host__ __device__ void init(int M, int N, int G_, int c_) { nM = M / BM; nN = N / BM; nwg = nM * nN; G = G_; c = c_; }
    __host__ __device__ bool next(int i, Unit& u) const {
        const long L = (long)i * G + c; if (L >= nwg) return false;
        int wgid = (int)L; { const int q = nwg / NXCD, r = nwg % NXCD, xcd = wgid % NXCD, off = wgid / NXCD; wgid = (xcd < r ? xcd * (q + 1) : r * (q + 1) + (xcd - r) * q) + off; }
        const int nig = WGM * nN, gid = wgid / nig, fm = gid * WGM, gsz = (nM - fm) < WGM ? (nM - fm) : WGM;
        u.pm = fm + ((wgid % nig) % gsz); u.pn = (wgid % nig) / gsz; return true;
    }
    __device__ __forceinline__ void a_ready(const Unit&) const {}
    __device__ __forceinline__ void done(const Unit&) const {}
};

__device__ __forceinline__ unsigned cvt_pk_bf16(float lo, float hi) { unsigned r; asm volatile("v_cvt_pk_bf16_f32 %0, %1, %2" : "=v"(r) : "v"(lo), "v"(hi)); return r; }
typedef float f32x2 __attribute__((ext_vector_type(2)));
typedef unsigned u32x4e __attribute__((ext_vector_type(4)));
__device__ __forceinline__ float bf_lo(unsigned w) { return __uint_as_float(w << 16); }
__device__ __forceinline__ float bf_hi(unsigned w) { return __uint_as_float(w & 0xffff0000u); }
__device__ __forceinline__ float sigm(float x) { return __builtin_amdgcn_rcpf(1.f + __builtin_amdgcn_exp2f(-1.4426950408889634f * x)); }
__device__ __forceinline__ float silu_f(float x) { return x * __builtin_amdgcn_rcpf(1.f + __builtin_amdgcn_exp2f(-1.4426950408889634f * x)); }

struct EpiPlain {
    static constexpr bool PERM = true, AFTER_DRAIN = false;
    bf16_t* O; int ldc;
    __device__ __forceinline__ void operator()(const f32x4 (&acc)[2][2][4][2], const Unit& u, int wr, int wc, int fr, int fq) const {
        const int row0 = u.pm * BM + wr * 64 + fr, col0 = u.pn * BM + wc * 32 + 8 * fq;
#pragma unroll
        for (int ai = 0; ai < 2; ++ai)
#pragma unroll
            for (int m = 0; m < 4; ++m) { bf16_t* rowp = O + (size_t)(row0 + ai * HALF + m * 16) * ldc + col0;
#pragma unroll
                for (int bj = 0; bj < 2; ++bj) { const f32x4 v0 = acc[ai][bj][m][0], v1 = acc[ai][bj][m][1];
                    u32x4e w; w.x = cvt_pk_bf16(v0[0], v0[1]); w.y = cvt_pk_bf16(v0[2], v0[3]); w.z = cvt_pk_bf16(v1[0], v1[1]); w.w = cvt_pk_bf16(v1[2], v1[3]);
                    *(u32x4e*)(rowp + bj * HALF) = w; } }
    }
};
struct EpiGlu {
    static constexpr bool PERM = true, AFTER_DRAIN = false;
    bf16_t* O; const bf16_t* Zg; int ldz;
    __device__ __forceinline__ void operator()(const f32x4 (&acc)[2][2][4][2], const Unit& u, int wr, int wc, int fr, int fq) const {
        const int row0 = u.pm * BM + wr * 64 + fr, oc0 = u.pn * 128 + wc * 32 + 8 * fq;
#pragma unroll
        for (int ai = 0; ai < 2; ++ai)
#pragma unroll
            for (int m = 0; m < 4; ++m) { const int r = row0 + ai * HALF + m * 16;
                const u32x4e gz = *(const u32x4e*)(Zg + (size_t)r * ldz + oc0);
                const f32x4 a0 = acc[ai][0][m][0], a1 = acc[ai][0][m][1], b0 = acc[ai][1][m][0], b1 = acc[ai][1][m][1];
                float o[8];
                o[0] = a0[0] * sigm(b0[0]) * silu_f(bf_lo(gz.x)); o[1] = a0[1] * sigm(b0[1]) * silu_f(bf_hi(gz.x));
                o[2] = a0[2] * sigm(b0[2]) * silu_f(bf_lo(gz.y)); o[3] = a0[3] * sigm(b0[3]) * silu_f(bf_hi(gz.y));
                o[4] = a1[0] * sigm(b1[0]) * silu_f(bf_lo(gz.z)); o[5] = a1[1] * sigm(b1[1]) * silu_f(bf_hi(gz.z));
                o[6] = a1[2] * sigm(b1[2]) * silu_f(bf_lo(gz.w)); o[7] = a1[3] * sigm(b1[3]) * silu_f(bf_hi(gz.w));
                u32x4e w; w.x = cvt_pk_bf16(o[0], o[1]); w.y = cvt_pk_bf16(o[2], o[3]); w.z = cvt_pk_bf16(o[4], o[5]); w.w = cvt_pk_bf16(o[6], o[7]);
                *(u32x4e*)(O + (size_t)r * 512 + oc0) = w; }
    }
};
struct EpiBranch {
    static constexpr bool PERM = true, AFTER_DRAIN = false;
    bf16_t* MIX; const bf16_t* Zm; int ldz;
    __device__ __forceinline__ void operator()(const f32x4 (&acc)[2][2][4][2], const Unit& u, int wr, int wc, int fr, int fq) const {
        const int br = u.pn >> 2, pn = u.pn & 3, pm = u.pm - 40 * br;
        const int row0 = pm * BM + wr * 64 + fr, col0 = pn * BM + wc * 32 + 8 * fq;
#pragma unroll
        for (int ai = 0; ai < 2; ++ai)
#pragma unroll
            for (int m = 0; m < 4; ++m) { const int r = row0 + ai * HALF + m * 16;
#pragma unroll
                for (int bj = 0; bj < 2; ++bj) { const int c = col0 + bj * HALF;
                    const u32x4e gz = *(const u32x4e*)(Zm + (size_t)r * ldz + br * 1024 + c);
                    u32x4e pv = (u32x4e){0u, 0u, 0u, 0u};
                    if (br > 0) pv = *(const u32x4e*)(MIX + (size_t)r * 1024 + c);
                    const f32x4 v0 = acc[ai][bj][m][0], v1 = acc[ai][bj][m][1];
                    float o[8];
                    o[0] = v0[0] * sigm(bf_lo(gz.x)) + bf_lo(pv.x); o[1] = v0[1] * sigm(bf_hi(gz.x)) + bf_hi(pv.x);
                    o[2] = v0[2] * sigm(bf_lo(gz.y)) + bf_lo(pv.y); o[3] = v0[3] * sigm(bf_hi(gz.y)) + bf_hi(pv.y);
                    o[4] = v1[0] * sigm(bf_lo(gz.z)) + bf_lo(pv.z); o[5] = v1[1] * sigm(bf_hi(gz.z)) + bf_hi(pv.z);
                    o[6] = v1[2] * sigm(bf_lo(gz.w)) + bf_lo(pv.w); o[7] = v1[3] * sigm(bf_hi(gz.w)) + bf_hi(pv.w);
                    u32x4e w; w.x = cvt_pk_bf16(o[0], o[1]); w.y = cvt_pk_bf16(o[2], o[3]); w.z = cvt_pk_bf16(o[4], o[5]); w.w = cvt_pk_bf16(o[6], o[7]);
                    *(u32x4e*)(MIX + (size_t)r * 1024 + c) = w; } }
    }
};
struct WinOrder {
    int G, c;
    __device__ __forceinline__ static void unit_of(int W, Unit& u) { const int gid = W / 216, rr = W % 216; u.pm = gid * 8 + (rr & 7); u.pn = rr >> 3; }
    __device__ __forceinline__ bool next(int i, Unit& u) const {
        const int L = i * G + c; if (L >= 1024) return false;
        unit_of((L & 7) * 128 + (L >> 3), u); return true;
    }
    __device__ __forceinline__ void a_ready(const Unit&) const {}
    __device__ __forceinline__ void done(const Unit&) const {}
};
struct OneUnit {
    int W;
    __device__ __forceinline__ bool next(int i, Unit& u) const { if (i > 0) return false; WinOrder::unit_of(W, u); return true; }
    __device__ __forceinline__ void a_ready(const Unit&) const {}
    __device__ __forceinline__ void done(const Unit&) const {}
};
struct BranchOrderX {
    int NB, c;
    __device__ __forceinline__ bool next(int i, Unit& u) const {
        const int tI = (i >> 1) * NB + c, br = (i & 1) * 2; if (tI >= 160) return false;
        u.pm = br * 40 + (tI >> 2); u.pn = br * 4 + (tI & 3); return true;
    }
    __device__ __forceinline__ void a_ready(const Unit&) const {}
    __device__ __forceinline__ void done(const Unit&) const {}
};
struct GluOrder {
    int NG, c;
    __device__ __forceinline__ bool next(int i, Unit& u) const {
        const int tI = i * NG + c; if (tI >= 160) return false;
        u.pm = tI >> 2; u.pn = tI & 3; return true;
    }
    __device__ __forceinline__ void a_ready(const Unit&) const {}
    __device__ __forceinline__ void done(const Unit&) const {}
};
struct BranchOrderY {
    int G, c;
    __device__ __forceinline__ bool next(int i, Unit& u) const {
        const int tI = i * G + c; if (tI >= 160) return false;
        u.pm = 40 + (tI >> 2); u.pn = 4 + (tI & 3); return true;
    }
    __device__ __forceinline__ void a_ready(const Unit&) const {}
    __device__ __forceinline__ void done(const Unit&) const {}
};
struct BranchOrder {
    int G, c;
    __device__ __forceinline__ bool next(int i, Unit& u) const {
        const int tI = (i / 3) * G + c, br = i % 3; if (tI >= 160) return false;
        u.pm = br * 40 + (tI >> 2); u.pn = br * 4 + (tI & 3); return true;
    }
    __device__ __forceinline__ void a_ready(const Unit&) const {}
    __device__ __forceinline__ void done(const Unit&) const {}
};
struct EpiResid {
    static constexpr bool PERM = false, AFTER_DRAIN = false;
    const float* base_ctx; const float* base_lat; float* out; const float* gate;
    __device__ __forceinline__ void operator()(const f32x4 (&acc)[2][2][4][2], const Unit& u, int wr, int wc, int fr, int fq) const {
        const int row0 = u.pm * BM + wr * 64 + fr, col0 = u.pn * BM + wc * 32 + 4 * fq;
        const int cond = u.pm < 32 ? 0 : 1 + ((u.pm - 32) >> 2);
        const float* bp = u.pm < 32 ? base_ctx : base_lat - (size_t)8192 * 1024;
        f32x4 gv[2][2];
#pragma unroll
        for (int bj = 0; bj < 2; ++bj)
#pragma unroll
            for (int n = 0; n < 2; ++n) gv[bj][n] = *(const f32x4*)(gate + cond * 3072 + col0 + bj * HALF + n * 16);
#pragma unroll
        for (int ai = 0; ai < 2; ++ai)
#pragma unroll
            for (int m = 0; m < 4; ++m) { const size_t off = (size_t)(row0 + ai * HALF + m * 16) * 1024 + col0;
#pragma unroll
                for (int bj = 0; bj < 2; ++bj)
#pragma unroll
                    for (int n = 0; n < 2; ++n) { const f32x4 bs = *(const f32x4*)(bp + off + bj * HALF + n * 16);
                        *(f32x4*)(out + off + bj * HALF + n * 16) = bs + gv[bj][n] * acc[ai][bj][m][n]; } }
    }
};
template <class Epi, class Sched, bool ALIGN_EPI = false, bool SP2 = false>
__device__ __forceinline__ void gemm_phase(PG8_LAS unsigned char* lds, const Gemm g, const Sched& S, const Epi& E) {
    int tid_l = threadIdx.x; asm volatile("" : "+v"(tid_l));
    const int tid = tid_l, wid = __builtin_amdgcn_readfirstlane(tid >> 6), lane = tid & 63, wr = wid >> 2, wc = wid & 3, fr = lane & 15, fq = lane >> 4;
    const int K = g.K, nt = K / BK;
    unsigned voffA[2], voffB[2];
#pragma unroll
    for (int i = 0; i < 2; ++i) { int R, C; stage_rc(tid * 16 + i * 8192, R, C); const int Rb = Epi::PERM ? ((R & ~31) + perm32(R & 31)) : R;
        voffA[i] = (unsigned)(R * K + C) * 2u; voffB[i] = (unsigned)(Rb * K + C) * 2u; }
    const size_t kstep = (size_t)(BK * 2);
    const size_t hstep = (size_t)HALF * K * 2;
    const size_t tstep = 2 * hstep;
    const unsigned ldsw = (unsigned)wid * 1024u;
    const int aoff = lds_byte(wr * 64 + fr, fq * 8), boff = lds_byte(wc * 32 + fr, fq * 8);
#define PG8_SA(b, h) (((b) * 2 + (h)) * HTB)
#define PG8_SB(b, h) ((4 + (b) * 2 + (h)) * HTB)
#define PG8_STAGE(bufoff, gbase, voff) do { _Pragma("unroll") for (int _i = 0; _i < 2; ++_i) \
        __builtin_amdgcn_global_load_lds((const unsigned*)((const char*)(gbase) + (voff)[_i]), (PG8_LAS unsigned*)(lds + (bufoff) + ldsw + _i * 8192), 16, 0, 0); } while (0)
#define PG8_LDA(dst, b, h) do { _Pragma("unroll") for (int m = 0; m < 4; ++m) _Pragma("unroll") for (int k = 0; k < 2; ++k) dst[m][k] = *(const PG8_LAS bf16x8*)(lds + PG8_SA(b, h) + aoff + m * 2048 + k * 1024); } while (0)
#define PG8_LDB(dst, b, h) do { _Pragma("unroll") for (int n = 0; n < 2; ++n) _Pragma("unroll") for (int k = 0; k < 2; ++k) dst[n][k] = *(const PG8_LAS bf16x8*)(lds + PG8_SB(b, h) + boff + n * 2048 + k * 1024); } while (0)
#define PG8_MMA(ai, bj, At, Bt) do { __builtin_amdgcn_s_setprio(1); _Pragma("unroll") for (int m = 0; m < 4; ++m) _Pragma("unroll") for (int n = 0; n < 2; ++n) _Pragma("unroll") for (int k = 0; k < 2; ++k) \
        acc[ai][bj][m][n] = __builtin_amdgcn_mfma_f32_16x16x32_bf16(Bt[n][k], At[m][k], acc[ai][bj][m][n], 0, 0, 0); __builtin_amdgcn_s_setprio(0); } while (0)
#define PG8_WAIT_V(n) asm volatile("s_waitcnt vmcnt(" #n ")" ::: "memory")
#define PG8_WAIT_L(n) asm volatile("s_waitcnt lgkmcnt(" #n ")" ::: "memory")
#define PG8_BAR __builtin_amdgcn_s_barrier()
#define PG8_SCHED __builtin_amdgcn_sched_barrier(0)
    Unit cur, nxt; int ui = 0;
    if (!S.next(0, cur)) return;
    f32x4 acc[2][2][4][2];
#pragma unroll
    for (int a = 0; a < 2; ++a)
#pragma unroll
        for (int b = 0; b < 2; ++b)
#pragma unroll
            for (int m = 0; m < 4; ++m)
#pragma unroll
                for (int n = 0; n < 2; ++n) acc[a][b][m][n] = (f32x4){0.f, 0.f, 0.f, 0.f};
    bf16x8 At[4][2], B0[2][2], B1[2][2];
    const char* cA = (const char*)g.A + (size_t)cur.pm * tstep; const char* cB = (const char*)g.Bt + (size_t)cur.pn * tstep;
    S.a_ready(cur);
    if constexpr (SP2) {
        PG8_STAGE(PG8_SB(0, 0), cB, voffB); PG8_STAGE(PG8_SB(0, 1), cB + hstep, voffB); PG8_STAGE(PG8_SA(0, 0), cA, voffA); PG8_STAGE(PG8_SA(0, 1), cA + hstep, voffA);
        if (wr == 1) PG8_BAR;
        PG8_WAIT_V(2); PG8_BAR;
        PG8_STAGE(PG8_SB(1, 0), cB + kstep, voffB); PG8_STAGE(PG8_SA(1, 0), cA + kstep, voffA); PG8_STAGE(PG8_SB(1, 1), cB + hstep + kstep, voffB);
        PG8_WAIT_V(6); PG8_BAR;
    } else {
        PG8_STAGE(PG8_SB(0, 0), cB, voffB); PG8_STAGE(PG8_SA(0, 0), cA, voffA); PG8_STAGE(PG8_SB(0, 1), cB + hstep, voffB); PG8_STAGE(PG8_SA(0, 1), cA + hstep, voffA);
        if (wr == 1) PG8_BAR;
        PG8_WAIT_V(4); PG8_BAR;
        PG8_STAGE(PG8_SB(1, 0), cB + kstep, voffB); PG8_STAGE(PG8_SA(1, 0), cA + kstep, voffA); PG8_STAGE(PG8_SB(1, 1), cB + hstep + kstep, voffB);
        PG8_WAIT_V(6); PG8_BAR;
    }
    for (;;) {
        const bool has_next = S.next(ui + 1, nxt);
        const char* nA = has_next ? (const char*)g.A + (size_t)nxt.pm * tstep : cA; const char* nB = has_next ? (const char*)g.Bt + (size_t)nxt.pn * tstep : cB;
        for (int t = 0; t < nt; t += 2) {
            const bool last = (t == nt - 2);
            const char* a1 = cA + (size_t)(t + 1) * kstep;
            const char* a2 = last ? nA : cA + (size_t)(t + 2) * kstep; const char* b2 = last ? nB : cB + (size_t)(t + 2) * kstep;
            const char* a3 = a2 + kstep; const char* b3 = b2 + kstep;
            if (last && has_next) S.a_ready(nxt);
            if constexpr (SP2) {
            PG8_LDB(B0, 0, 0); PG8_LDB(B1, 0, 1); PG8_SCHED; PG8_LDA(At, 0, 0); PG8_STAGE(PG8_SA(1, 1), a1 + hstep, voffA);
            PG8_WAIT_V(8); PG8_WAIT_L(0); PG8_BAR; PG8_MMA(0, 0, At, B0); PG8_MMA(0, 1, At, B1); PG8_BAR; PG8_SCHED;
            PG8_LDA(At, 0, 1); PG8_STAGE(PG8_SB(0, 0), b2, voffB); PG8_STAGE(PG8_SB(0, 1), b2 + hstep, voffB); PG8_STAGE(PG8_SA(0, 0), a2, voffA);
            PG8_WAIT_V(8); PG8_WAIT_L(0); PG8_BAR; PG8_MMA(1, 0, At, B0); PG8_MMA(1, 1, At, B1); PG8_BAR; PG8_SCHED;
            PG8_LDB(B0, 1, 0); PG8_LDB(B1, 1, 1); PG8_SCHED; PG8_LDA(At, 1, 0); PG8_STAGE(PG8_SA(0, 1), a2 + hstep, voffA);
            PG8_WAIT_V(8); PG8_WAIT_L(0); PG8_BAR; PG8_MMA(0, 0, At, B0); PG8_MMA(0, 1, At, B1); PG8_BAR; PG8_SCHED;
            PG8_LDA(At, 1, 1); PG8_STAGE(PG8_SB(1, 0), b3, voffB); PG8_STAGE(PG8_SB(1, 1), b3 + hstep, voffB); PG8_STAGE(PG8_SA(1, 0), a3, voffA);
            PG8_WAIT_V(8); PG8_WAIT_L(0); PG8_BAR; PG8_MMA(1, 0, At, B0); PG8_MMA(1, 1, At, B1); PG8_BAR; PG8_SCHED;
            } else {
            PG8_LDB(B0, 0, 0); PG8_SCHED; PG8_LDA(At, 0, 0); PG8_STAGE(PG8_SA(1, 1), a1 + hstep, voffA);
            PG8_WAIT_L(8); PG8_BAR; PG8_WAIT_L(0); PG8_MMA(0, 0, At, B0); PG8_BAR; PG8_SCHED;
            PG8_LDB(B1, 0, 1); PG8_STAGE(PG8_SB(0, 0), b2, voffB);
            PG8_BAR; PG8_WAIT_L(0); PG8_MMA(0, 1, At, B1); PG8_BAR;
            PG8_LDA(At, 0, 1); PG8_STAGE(PG8_SA(0, 0), a2, voffA);
            PG8_BAR; PG8_WAIT_L(0); PG8_MMA(1, 0, At, B0); PG8_BAR; PG8_SCHED;
            PG8_STAGE(PG8_SB(0, 1), b2 + hstep, voffB);
            PG8_WAIT_V(6); PG8_BAR; PG8_MMA(1, 1, At, B1); PG8_BAR;
            PG8_LDB(B0, 1, 0); PG8_SCHED; PG8_LDA(At, 1, 0); PG8_STAGE(PG8_SA(0, 1), a2 + hstep, voffA);
            PG8_WAIT_L(8); PG8_BAR; PG8_WAIT_L(0); PG8_MMA(0, 0, At, B0); PG8_BAR; PG8_SCHED;
            PG8_LDB(B1, 1, 1); PG8_STAGE(PG8_SB(1, 0), b3, voffB);
            PG8_BAR; PG8_WAIT_L(0); PG8_MMA(0, 1, At, B1); PG8_BAR;
            PG8_LDA(At, 1, 1); PG8_STAGE(PG8_SA(1, 0), a3, voffA);
            PG8_BAR; PG8_WAIT_L(0); PG8_MMA(1, 0, At, B0); PG8_BAR; PG8_SCHED;
            PG8_STAGE(PG8_SB(1, 1), b3 + hstep, voffB);
            PG8_WAIT_V(6); PG8_BAR; PG8_MMA(1, 1, At, B1); PG8_BAR;
            }
        }
        if constexpr (ALIGN_EPI) { if (wr == 0) PG8_BAR; }
        if constexpr (!Epi::AFTER_DRAIN) { E(acc, cur, wr, wc, fr, fq); S.done(cur); }
        if (!has_next) break;
#pragma unroll
        for (int a = 0; a < 2; ++a)
#pragma unroll
            for (int b = 0; b < 2; ++b)
#pragma unroll
                for (int m = 0; m < 4; ++m)
#pragma unroll
                    for (int n = 0; n < 2; ++n) acc[a][b][m][n] = (f32x4){0.f, 0.f, 0.f, 0.f};
        cur = nxt; cA = nA; cB = nB; ++ui;
        if constexpr (ALIGN_EPI) { if (wr == 1) PG8_BAR; }
    }
    PG8_WAIT_V(0);
    if constexpr (!ALIGN_EPI) { if (wr == 0) PG8_BAR; }
    PG8_BAR;
    if constexpr (Epi::AFTER_DRAIN) { E.fused(acc, cur, wr, wc, fr, fq, lds, wid, lane); S.done(cur); }
#undef PG8_SA
#undef PG8_SB
#undef PG8_STAGE
#undef PG8_LDA
#undef PG8_LDB
#undef PG8_MMA
#undef PG8_WAIT_V
#undef PG8_WAIT_L
#undef PG8_BAR
#undef PG8_SCHED
}
}

#define LAS __attribute__((address_space(3)))
typedef unsigned short bf16;
typedef unsigned u32x4 __attribute__((ext_vector_type(4)));
typedef unsigned u32x2 __attribute__((ext_vector_type(2)));
typedef float f32x4 __attribute__((ext_vector_type(4)));
typedef float f32x2 __attribute__((ext_vector_type(2)));
typedef float f32x16 __attribute__((ext_vector_type(16)));
typedef short bf16x8 __attribute__((ext_vector_type(8)));
using pg8::cvt_pk_bf16; using pg8::bf_lo; using pg8::bf_hi; using pg8::sigm; using pg8::silu_f;

constexpr int DM = 1024, NCOL = 6912, MTOK = 10240, MCTX = 8192;
constexpr int C_CONVA = 0, C_CONVG = 512, C_CGATE = 1024, C_SSMIN = 1536, C_SGATE = 2048, C_Q = 2560, C_K = 3072, C_V = 3200, C_AGATE = 3328, C_MERGE = 3840;
constexpr float EPS = 1e-6f;
constexpr size_t MiB = (size_t)1 << 20;
constexpr size_t WS_CTL = 0, CTL_ZERO_BYTES = 256 * 1024;
constexpr size_t WS_MODS = 4096;
constexpr size_t WS_ROPE = 1 * MiB;
constexpr size_t WS_LAM = 1 * MiB + 64 * 1024;
constexpr size_t WS_BB = 2 * MiB;
constexpr size_t WS_CT = 3 * MiB;
constexpr size_t WS_E = 4 * MiB;
constexpr size_t WS_W = 10 * MiB;
constexpr size_t W_IN_B = (size_t)NCOL * DM * 2, W_GLU_B = (size_t)1024 * 512 * 2, W_BR_B = (size_t)3 * 1024 * 512 * 2, W_OUT_B = (size_t)1024 * 1024 * 2;
constexpr size_t W_LAYER_B = W_IN_B + W_GLU_B + W_BR_B + W_OUT_B;
constexpr size_t WS_H = 50 * MiB;
constexpr size_t WS_ABR = 70 * MiB;
constexpr size_t WS_YB = 100 * MiB;
constexpr size_t WS_MODSP = WS_YB;
constexpr size_t WS_Z = 110 * MiB;
constexpr size_t WS_END = WS_Z + (size_t)MTOK * NCOL * 2;
static_assert(WS_W + 2 * W_LAYER_B <= WS_H && WS_END <= 256 * MiB, "ws map");
constexpr int LDS_BYTES = 147456;

struct Params { const float* in[31]; float* out; unsigned char* ws; };
typedef const __attribute__((address_space(4))) Params* KP;
#define RELOAD_P(P) asm volatile("" : "+s"(P))
enum { I_XP = 0, I_XS, I_CK, I_CV, I_SRE, I_SIM, I_C, I_CCTX, I_NG, I_WADA, I_BADA, I_WIN, I_DWW, I_DWB, I_LNG, I_LNB, I_WCO, I_ARE, I_AIM, I_LDT, I_BRE, I_BIM, I_CRE, I_CIM, I_SD, I_WGLU, I_WSO, I_QG, I_KG, I_WAO, I_WOUT };
constexpr size_t O_Y = 0, O_CK = 10485760, O_CV = 12582912, O_SRE = 14680064, O_SIM = 14942208;

__device__ __forceinline__ float wave_sum(float v) {
#pragma unroll
    for (int o = 1; o < 64; o <<= 1) v += __shfl_xor(v, o);
    return v;
}
__device__ __forceinline__ void unpack8(const u32x4 w, float* f) {
    f[0] = bf_lo(w.x); f[1] = bf_hi(w.x); f[2] = bf_lo(w.y); f[3] = bf_hi(w.y); f[4] = bf_lo(w.z); f[5] = bf_hi(w.z); f[6] = bf_lo(w.w); f[7] = bf_hi(w.w);
}
__device__ __forceinline__ u32x4 pack8(const float* f) {
    u32x4 w; w.x = cvt_pk_bf16(f[0], f[1]); w.y = cvt_pk_bf16(f[2], f[3]); w.z = cvt_pk_bf16(f[4], f[5]); w.w = cvt_pk_bf16(f[6], f[7]); return w;
}
#define MFMA32(a, b, c) __builtin_amdgcn_mfma_f32_32x32x16_bf16((a), (b), (c), 0, 0, 0)
#define MFMA16(a, b, c) __builtin_amdgcn_mfma_f32_16x16x32_bf16((a), (b), (c), 0, 0, 0)

__device__ __forceinline__ void p0_transpose_item(const float* W, int K, int N, bf16* WT, int glu, LAS float* scr, int item, int lane) {
    const int nblk = N / 32, kb = item / nblk, nb = item % nblk, k0 = 64 * kb, n0 = 32 * nb;
    int d0 = n0;
    if (glu) { const int bj = n0 >> 9, rem = n0 & 511; d0 = 256 * (rem >> 7) + 128 * bj + (rem & 127); }
    float wv[32];
    const float* wsrc = W + (size_t)(k0 + (lane >> 5)) * N + n0 + (lane & 31);
#pragma unroll
    for (int i = 0; i < 32; ++i) wv[i] = wsrc[(size_t)(2 * i) * N];
#pragma unroll
    for (int i = 0; i < 32; ++i) scr[(2 * i + (lane >> 5)) * 33 + (lane & 31)] = wv[i];
    asm volatile("s_waitcnt lgkmcnt(0)" ::: "memory");
    const int c = lane & 7;
#pragma unroll
    for (int j = 0; j < 4; ++j) { const int n = (lane >> 3) + 8 * j; const LAS float* s = scr + (8 * c) * 33 + n;
        u32x4 o; o.x = cvt_pk_bf16(s[0 * 33], s[1 * 33]); o.y = cvt_pk_bf16(s[2 * 33], s[3 * 33]); o.z = cvt_pk_bf16(s[4 * 33], s[5 * 33]); o.w = cvt_pk_bf16(s[6 * 33], s[7 * 33]);
        *(u32x4*)(WT + (size_t)(d0 + n) * K + k0 + 8 * c) = o; }
    asm volatile("s_waitcnt lgkmcnt(0)" ::: "memory");
}

#ifndef REP_P0A
#define REP_P0A 1
#endif
__device__ __forceinline__ void convert_weights(KP P, int l, int part, int first_block, LAS unsigned char* lds) {
    RELOAD_P(P);
    asm volatile("" : "+s"(l));
    int tid_ = threadIdx.x; asm volatile("" : "+v"(tid_));
    const int lane = tid_ & 63, wid = __builtin_amdgcn_readfirstlane(tid_ >> 6);
    const int gw = ((int)blockIdx.x - first_block) * 8 + wid, NGW = ((int)gridDim.x - first_block) * 8;
    LAS float* scr = (LAS float*)(lds + wid * 8448);
    constexpr int I_IN = 16 * 216, I_S = 8 * 32, I_O = 16 * 32;
    unsigned char* wl = P->ws + WS_W + (size_t)l * W_LAYER_B;
    if (part == 0) {
        for (int r = gw; r < I_IN; r += NGW) p0_transpose_item(P->in[I_WIN] + (size_t)l * DM * NCOL, DM, NCOL, (bf16*)wl, 0, scr, r, lane);
    } else {
        for (int it = gw; it < 4 * I_S + I_O; it += NGW) {
            int r = it;
            if (r < I_S) { p0_transpose_item(P->in[I_WGLU] + (size_t)l * 512 * 1024, 512, 1024, (bf16*)(wl + W_IN_B), 1, scr, r, lane); continue; } r -= I_S;
            if (r < I_S) { p0_transpose_item(P->in[I_WCO] + (size_t)l * 512 * 1024, 512, 1024, (bf16*)(wl + W_IN_B + W_GLU_B), 0, scr, r, lane); continue; } r -= I_S;
            if (r < I_S) { p0_transpose_item(P->in[I_WSO] + (size_t)l * 512 * 1024, 512, 1024, (bf16*)(wl + W_IN_B + W_GLU_B) + (size_t)1024 * 512, 0, scr, r, lane); continue; } r -= I_S;
            if (r < I_S) { p0_transpose_item(P->in[I_WAO] + (size_t)l * 512 * 1024, 512, 1024, (bf16*)(wl + W_IN_B + W_GLU_B) + (size_t)2048 * 512, 0, scr, r, lane); continue; } r -= I_S;
            p0_transpose_item(P->in[I_WOUT] + (size_t)l * 1024 * 1024, 1024, 1024, (bf16*)(wl + W_IN_B + W_GLU_B + W_BR_B), 0, scr, r, lane);
        }
    }
}
__device__ __forceinline__ bool defer_l1_weights() { return gridDim.x >= 200; }

__device__ __forceinline__ void p0_prologue(KP P, LAS unsigned char* lds, int tid, int lane, int wid) {
    RELOAD_P(P);
    unsigned char* ws = P->ws;
    {
        const int nl = defer_l1_weights() ? 1 : 2;
#pragma unroll 1
        for (int rep0_ = 0; rep0_ < REP_P0A; ++rep0_)
#pragma unroll 1
        for (int lp = 0; lp < 2 * nl; ++lp) convert_weights(P, lp >> 1, lp & 1, 0, lds);
    }
    __syncthreads();
    for (int it = blockIdx.x; it < 209; it += gridDim.x) {
        if (it < 192) {
            const int l = it / 96, n0 = 32 * (it % 96);
            LAS float* sc = (LAS float*)lds;
            LAS float* red = (LAS float*)(lds + 12288);
            __syncthreads();
            for (int i = tid; i < 3072; i += 512) { const int j = i >> 10, k = i & 1023; const float cv = (j == 0) ? P->in[I_CCTX][k] : P->in[I_C][(j - 1) * 1024 + k]; sc[i] = cv / (1.f + __expf(-cv)); }
            __syncthreads();
            const int ks = tid >> 5, col = tid & 31;
            const float* w = P->in[I_WADA] + ((size_t)l * 1024 + ks * 64) * 3072 + n0 + col;
            float a0 = 0.f, a1 = 0.f, a2 = 0.f;
#pragma unroll 16
            for (int k = 0; k < 64; ++k) { const float wv = w[(size_t)k * 3072]; a0 += sc[ks * 64 + k] * wv; a1 += sc[1024 + ks * 64 + k] * wv; a2 += sc[2048 + ks * 64 + k] * wv; }
            red[(ks * 3 + 0) * 32 + col] = a0; red[(ks * 3 + 1) * 32 + col] = a1; red[(ks * 3 + 2) * 32 + col] = a2;
            __syncthreads();
            if (tid < 96) { const int j = tid >> 5, c2 = tid & 31; float sum = P->in[I_BADA][l * 3072 + n0 + c2];
#pragma unroll
                for (int q = 0; q < 16; ++q) sum += red[(q * 3 + j) * 32 + c2];
                ((float*)(ws + WS_MODS))[(l * 3 + j) * 3072 + n0 + c2] = sum; }
        } else if (it < 208) {
            const int idx = (it - 192) * 512 + tid; const int l = idx >> 12, dir = (idx >> 11) & 1, g = (idx >> 6) & 31, p = idx & 63;
            const double are = (double)P->in[I_ARE][idx], aim = (double)P->in[I_AIM][idx], dt = exp((double)P->in[I_LDT][(l * 2 + dir) * 32 + g]);
            const double mag = exp(are * dt), lr = mag * cos(aim * dt), li = mag * sin(aim * dt);
            ((f32x2*)(ws + WS_LAM))[idx] = (f32x2){(float)lr, (float)li};
            const double d2 = are * are + aim * aim, qr = ((lr - 1.0) * are + li * aim) / d2, qi = (li * are - (lr - 1.0) * aim) / d2;
            float bre[16], bim[16];
#pragma unroll
            for (int c = 0; c < 16; ++c) { const double br = (double)P->in[I_BRE][(size_t)idx * 16 + c], bi = (double)P->in[I_BIM][(size_t)idx * 16 + c]; bre[c] = (float)(qr * br - qi * bi); bim[c] = (float)(qr * bi + qi * br); }
            bf16* bb = (bf16*)(ws + WS_BB);
            u32x4* d_re = (u32x4*)(bb + ((size_t)(((l * 2 + dir) * 32 + g) * 2 + 0) * 64 + p) * 16);
            u32x4* d_im = (u32x4*)(bb + ((size_t)(((l * 2 + dir) * 32 + g) * 2 + 1) * 64 + p) * 16);
            d_re[0] = pack8(bre); d_re[1] = pack8(bre + 8); d_im[0] = pack8(bim); d_im[1] = pack8(bim + 8);
            bf16* ct = (bf16*)(ws + WS_CT);
#pragma unroll
            for (int cc = 0; cc < 16; ++cc) { const size_t ci = ((size_t)((l * 2 + dir) * 32 + g) * 16 + cc) * 64 + p;
                const float cre = P->in[I_CRE][ci], cim = P->in[I_CIM][ci];
                *(unsigned*)(ct + ((size_t)(((l * 32 + g) * 2 + dir) * 16 + cc) * 128 + 2 * p)) = cvt_pk_bf16(cre, -cim); }
        } else {
            for (int idx = tid; idx < 1024; idx += 512) { const int pos = idx >> 4, j = idx & 15;
                const double inv = exp(-(double)j / 16.0 * log(10000.0)), ang = (double)pos * inv;
                ((f32x2*)(ws + WS_ROPE))[idx] = (f32x2){(float)cos(ang), (float)sin(ang)}; }
        }
    }
}


__device__ __forceinline__ void p1_rows(KP P, int l, int lane, int wid) {
    RELOAD_P(P);
    const float* mods = (const float*)(P->ws + WS_MODS) + (size_t)l * 3 * 3072;
    const float* ng = P->in[I_NG] + l * DM;
    bf16* H = (bf16*)(P->ws + WS_H);
    const int gw = blockIdx.x * 8 + wid, NGW = gridDim.x * 8;
    for (int m = gw; m < MTOK; m += NGW) {
        const float* xr = (l == 0) ? (m < MCTX ? P->in[I_XP] + (size_t)m * DM : P->in[I_XS] + (size_t)(m - MCTX) * DM) : P->out + (size_t)m * DM;
        const int cond = m < MCTX ? 0 : 1 + ((m - MCTX) >> 10);
        const float* sh = mods + cond * 3072; const float* sc = sh + 1024;
        f32x4 v[4]; float s = 0.f;
#pragma unroll
        for (int j = 0; j < 4; ++j) { v[j] = *(const f32x4*)(xr + 4 * lane + 256 * j); s += (v[j].x * v[j].x + v[j].y * v[j].y) + (v[j].z * v[j].z + v[j].w * v[j].w); }
        const float rstd = rsqrtf(wave_sum(s) * (1.f / DM) + EPS);
#pragma unroll
        for (int j = 0; j < 4; ++j) { const int c = 4 * lane + 256 * j;
            const f32x4 g4 = *(const f32x4*)(ng + c), sc4 = *(const f32x4*)(sc + c), sh4 = *(const f32x4*)(sh + c);
            const f32x4 o = v[j] * rstd * g4 * (sc4 + 1.f) + sh4;
            u32x2 w; w.x = cvt_pk_bf16(o.x, o.y); w.y = cvt_pk_bf16(o.z, o.w);
            *(u32x2*)(H + (size_t)m * DM + c) = w; }
    }
}

constexpr int KS_PITCH = 144, VT_PITCH = 528, VT_OFF = 256 * KS_PITCH;
__device__ __forceinline__ int crow(int r, int hi) { return (r & 3) + 8 * (r >> 2) + 4 * hi; }
__device__ __forceinline__ void attn_item(KP P, int l, int it, LAS unsigned char* lds, int tid, int lane, int wid) {
    RELOAD_P(P);
    asm volatile("" : "+s"(l)); asm volatile("" : "+v"(tid)); lane = tid & 63; wid = __builtin_amdgcn_readfirstlane(tid >> 6);
    const bf16* Z = (const bf16*)(P->ws + WS_Z);
    bf16* OA = (bf16*)(P->ws + WS_ABR) + (size_t)2 * MTOK * 512;
    const f32x2* rope = (const f32x2*)(P->ws + WS_ROPE);
    const bool lat = it < 64;
    int b, kvh, qb;
    if (lat) { b = it >> 5; kvh = (it >> 4) & 1; qb = it & 15; } else { const int j = it - 64; b = j >> 3; kvh = (j >> 2) & 1; qb = j & 3; }
    const int rowbase = lat ? MCTX + b * 1024 : b * 256;
    const int nkt = lat ? 5 : 1;
    const int r32 = lane & 31, hi = lane >> 5;
    const int h = 4 * kvh + (wid & 3);
    const int tq = qb * 64 + 32 * (wid >> 2) + r32;
    const int qrow = rowbase + tq;
    bf16x8 qf[4];
    {
        float qv[4][8]; float ss = 0.f;
        const bf16* zq = Z + (size_t)qrow * NCOL + C_Q + 64 * h + 8 * hi;
#pragma unroll
        for (int d0 = 0; d0 < 4; ++d0) { const u32x4 w = *(const u32x4*)(zq + 16 * d0); unpack8(w, qv[d0]);
#pragma unroll
            for (int i = 0; i < 8; ++i) ss += qv[d0][i] * qv[d0][i]; }
        ss += __shfl_xor(ss, 32);
        const float rs = rsqrtf(ss * (1.f / 64.f) + EPS);
        const float* qg = P->in[I_QG] + l * 64 + 8 * hi;
#pragma unroll
        for (int d0 = 0; d0 < 4; ++d0)
#pragma unroll
            for (int i = 0; i < 8; ++i) qv[d0][i] *= rs * qg[16 * d0 + i];
        if (lat) {
            const int prow = tq >> 6, pcol = tq & 63;
#pragma unroll
            for (int i = 0; i < 8; ++i) { const int j = 8 * hi + i;
                const f32x2 a = rope[prow * 16 + j]; float x1 = qv[0][i], x2 = qv[1][i]; qv[0][i] = x1 * a.x - x2 * a.y; qv[1][i] = x1 * a.y + x2 * a.x;
                const f32x2 c = rope[pcol * 16 + j]; x1 = qv[2][i]; x2 = qv[3][i]; qv[2][i] = x1 * c.x - x2 * c.y; qv[3][i] = x1 * c.y + x2 * c.x; }
        }
        const float qs = 0.125f * 1.4426950408889634f;
#pragma unroll
        for (int d0 = 0; d0 < 4; ++d0) {
#pragma unroll
            for (int i = 0; i < 8; ++i) qv[d0][i] *= qs;
            qf[d0] = __builtin_bit_cast(bf16x8, pack8(qv[d0])); }
    }
    float mrun = -INFINITY, lrun = 0.f;
    f32x16 o0, o1;
#pragma unroll
    for (int r = 0; r < 16; ++r) { o0[r] = 0.f; o1[r] = 0.f; }
    for (int kt = 0; kt < nkt; ++kt) {
        __syncthreads();
        {
            const int key = tid >> 1, half = tid & 1;
            float kx[32];
            const bool from_z = (!lat) || kt < 4;
            if (from_z) {
                const int t = kt * 256 + key;
                const bf16* src = Z + (size_t)(rowbase + t) * NCOL + C_K + 64 * kvh + 32 * half;
                float ss = 0.f;
#pragma unroll
                for (int q = 0; q < 4; ++q) { const u32x4 w = *(const u32x4*)(src + 8 * q); unpack8(w, kx + 8 * q); }
#pragma unroll
                for (int i = 0; i < 32; ++i) ss += kx[i] * kx[i];
                ss += __shfl_xor(ss, 1);
                const float rs = rsqrtf(ss * (1.f / 64.f) + EPS);
                const float* kg = P->in[I_KG] + l * 64 + 32 * half;
#pragma unroll
                for (int i = 0; i < 32; ++i) kx[i] *= rs * kg[i];
                if (!lat && qb == 0) { float* dst = P->out + O_CK + ((size_t)((b * 2 + l) * 256 + key) * 2 + kvh) * 64 + 32 * half;
#pragma unroll
                    for (int q = 0; q < 8; ++q) *(f32x4*)(dst + 4 * q) = (f32x4){kx[4 * q], kx[4 * q + 1], kx[4 * q + 2], kx[4 * q + 3]}; }
                if (lat) { const int pos = half ? (t & 63) : (t >> 6);
#pragma unroll
                    for (int j = 0; j < 16; ++j) { const f32x2 a = rope[pos * 16 + j]; const float x1 = kx[j], x2 = kx[16 + j]; kx[j] = x1 * a.x - x2 * a.y; kx[16 + j] = x1 * a.y + x2 * a.x; } }
            } else {
                const float* src = P->in[I_CK] + ((size_t)((b * 2 + l) * 256 + key) * 2 + kvh) * 64 + 32 * half;
#pragma unroll
                for (int q = 0; q < 8; ++q) { const f32x4 w = *(const f32x4*)(src + 4 * q); kx[4 * q] = w.x; kx[4 * q + 1] = w.y; kx[4 * q + 2] = w.z; kx[4 * q + 3] = w.w; }
            }
            LAS u32x4* kd = (LAS u32x4*)(lds + key * KS_PITCH + 64 * half);
#pragma unroll
            for (int q = 0; q < 4; ++q) kd[q] = pack8(kx + 8 * q);
            if (from_z) {
                const int t = kt * 256 + key;
                const bf16* src = Z + (size_t)(rowbase + t) * NCOL + C_V + 64 * kvh + 32 * half;
#pragma unroll
                for (int q = 0; q < 4; ++q) { const u32x4 w = *(const u32x4*)(src + 8 * q); unpack8(w, kx + 8 * q); }
                if (!lat && qb == 0) { float* dst = P->out + O_CV + ((size_t)((b * 2 + l) * 256 + key) * 2 + kvh) * 64 + 32 * half;
#pragma unroll
                    for (int q = 0; q < 8; ++q) *(f32x4*)(dst + 4 * q) = (f32x4){kx[4 * q], kx[4 * q + 1], kx[4 * q + 2], kx[4 * q + 3]}; }
            } else {
                const float* src = P->in[I_CV] + ((size_t)((b * 2 + l) * 256 + key) * 2 + kvh) * 64 + 32 * half;
#pragma unroll
                for (int q = 0; q < 8; ++q) { const f32x4 w = *(const f32x4*)(src + 4 * q); kx[4 * q] = w.x; kx[4 * q + 1] = w.y; kx[4 * q + 2] = w.z; kx[4 * q + 3] = w.w; }
            }
            const int pos = (key & ~15) | ((key & 4) << 1) | ((key & 8) >> 1) | (key & 3);
            LAS bf16* vd = (LAS bf16*)(lds + VT_OFF + (32 * half) * VT_PITCH + 2 * pos);
#pragma unroll
            for (int i = 0; i < 32; i += 2) { const unsigned w = cvt_pk_bf16(kx[i], kx[i + 1]);
                vd[(size_t)i * (VT_PITCH / 2)] = (bf16)(w & 0xffffu); vd[(size_t)(i + 1) * (VT_PITCH / 2)] = (bf16)(w >> 16); }
        }
        __syncthreads();
#pragma unroll 1
        for (int st = 0; st < 4; ++st) {
            f32x16 p0, p1;
#pragma unroll
            for (int r = 0; r < 16; ++r) { p0[r] = 0.f; p1[r] = 0.f; }
            const LAS unsigned char* kb = lds + (64 * st + r32) * KS_PITCH + 16 * hi;
#pragma unroll
            for (int d0 = 0; d0 < 4; ++d0) {
                const bf16x8 a0 = *(const LAS bf16x8*)(kb + 32 * d0);
                const bf16x8 a1 = *(const LAS bf16x8*)(kb + 32 * KS_PITCH + 32 * d0);
                p0 = MFMA32(a0, qf[d0], p0); p1 = MFMA32(a1, qf[d0], p1);
            }
            float tm = fmaxf(p0[0], p1[0]);
#pragma unroll
            for (int r = 1; r < 16; ++r) tm = fmaxf(tm, fmaxf(p0[r], p1[r]));
            tm = fmaxf(tm, __shfl_xor(tm, 32));
            const float mnew = fmaxf(mrun, tm);
            const float alpha = __builtin_amdgcn_exp2f(mrun - mnew);
            mrun = mnew;
            float ps = 0.f;
#pragma unroll
            for (int r = 0; r < 16; ++r) { p0[r] = __builtin_amdgcn_exp2f(p0[r] - mnew); p1[r] = __builtin_amdgcn_exp2f(p1[r] - mnew); ps += p0[r] + p1[r]; }
            lrun = lrun * alpha + ps;
#pragma unroll
            for (int r = 0; r < 16; ++r) { o0[r] *= alpha; o1[r] *= alpha; }
            bf16x8 pb[4];
            { float t8[8];
#pragma unroll
              for (int J = 0; J < 4; ++J) {
#pragma unroll
                  for (int i = 0; i < 8; ++i) t8[i] = (J < 2) ? p0[8 * (J & 1) + i] : p1[8 * (J & 1) + i];
                  pb[J] = __builtin_bit_cast(bf16x8, pack8(t8)); } }
            const LAS unsigned char* vb = lds + VT_OFF + r32 * VT_PITCH + 2 * (64 * st + 8 * hi);
#pragma unroll
            for (int J = 0; J < 4; ++J) {
                const bf16x8 v0 = *(const LAS bf16x8*)(vb + 32 * J);
                const bf16x8 v1 = *(const LAS bf16x8*)(vb + 32 * VT_PITCH + 32 * J);
                o0 = MFMA32(v0, pb[J], o0); o1 = MFMA32(v1, pb[J], o1);
            }
        }
    }
    lrun += __shfl_xor(lrun, 32);
    const float inv = 1.f / lrun;
    const bf16* zg = Z + (size_t)qrow * NCOL + C_AGATE + 64 * h;
    bf16* od = OA + (size_t)qrow * 512 + 64 * h;
#pragma unroll
    for (int dt = 0; dt < 2; ++dt)
#pragma unroll
        for (int rq = 0; rq < 4; ++rq) { const int d = 32 * dt + 8 * rq + 4 * hi;
            const u32x2 gw = *(const u32x2*)(zg + d);
            float v[4];
#pragma unroll
            for (int i = 0; i < 4; ++i) v[i] = (dt ? o1[4 * rq + i] : o0[4 * rq + i]) * inv;
            v[0] *= silu_f(bf_lo(gw.x)); v[1] *= silu_f(bf_hi(gw.x)); v[2] *= silu_f(bf_lo(gw.y)); v[3] *= silu_f(bf_hi(gw.y));
            u32x2 w; w.x = cvt_pk_bf16(v[0], v[1]); w.y = cvt_pk_bf16(v[2], v[3]);
            *(u32x2*)(od + d) = w; }
}

__device__ __forceinline__ float fsigm(float x) { return __builtin_amdgcn_rcpf(1.f + __builtin_amdgcn_exp2f(-1.4426950408889634f * x)); }
__device__ __forceinline__ void conv_item(KP P, int l, int it, LAS unsigned char* lds, int tid, int lane, int wid) {
    RELOAD_P(P);
    asm volatile("" : "+s"(l)); asm volatile("" : "+v"(tid)); lane = tid & 63; wid = __builtin_amdgcn_readfirstlane(tid >> 6);
    const bf16* Z = (const bf16*)(P->ws + WS_Z);
    bf16* YA = (bf16*)(P->ws + WS_ABR);
    int rowbase, L, t0;
    if (it < 512) { rowbase = (it >> 4) * 256; L = 256; t0 = 16 * (it & 15); } else { const int j = it - 512; rowbase = MCTX + (j >> 6) * 1024; L = 1024; t0 = 16 * (j & 63); }
    LAS float* yb = (LAS float*)lds;
    LAS float* sb = (LAS float*)(lds + 47 * 512 * 4);
    LAS float* st = (LAS float*)(lds + 47 * 512 * 4 + 16 * 516 * 4);
    u32x4 la[6], lg[6];
#pragma unroll
    for (int i = 0; i < 6; ++i) {
        const int e = tid + 512 * i, rr = e >> 6, ch = e & 63, t = t0 - 15 + rr;
        la[i] = (u32x4){0u, 0u, 0u, 0u}; lg[i] = (u32x4){0u, 0u, 0u, 0u};
        if (rr < 47 && t >= 0 && t < L) { const bf16* src = Z + (size_t)(rowbase + t) * NCOL + 8 * ch; la[i] = *(const u32x4*)(src + C_CONVA); lg[i] = *(const u32x4*)(src + C_CONVG); }
    }
    const int c = tid;
    float w[32];
    const float* wp = P->in[I_DWW] + (size_t)l * 31 * 512 + c;
#pragma unroll
    for (int k = 0; k < 31; ++k) w[k] = wp[k * 512];
    w[31] = 0.f;
    const float bias = P->in[I_DWB][l * 512 + c], lgam = P->in[I_LNG][l * 512 + c], lbet = P->in[I_LNB][l * 512 + c];
    bf16 gt[16];
#pragma unroll
    for (int t = 0; t < 16; ++t) gt[t] = Z[(size_t)(rowbase + t0 + t) * NCOL + C_CGATE + c];
#pragma unroll
    for (int i = 0; i < 6; ++i) {
        const int e = tid + 512 * i, rr = e >> 6, ch = e & 63;
        if (rr < 47) {
            float a[8], g[8]; unpack8(la[i], a); unpack8(lg[i], g);
#pragma unroll
            for (int q = 0; q < 8; ++q) a[q] *= fsigm(g[q]);
            LAS f32x4* d = (LAS f32x4*)(yb + rr * 512 + 8 * ch);
            d[0] = (f32x4){a[0], a[1], a[2], a[3]}; d[1] = (f32x4){a[4], a[5], a[6], a[7]};
        }
    }
    __syncthreads();
    float acc[16];
#pragma unroll
    for (int t = 0; t < 16; ++t) acc[t] = bias;
#pragma unroll
    for (int kb = 0; kb < 32; kb += 8) {
        const LAS float* yp = yb + kb * 512 + c;
        float rows[23];
#pragma unroll
        for (int j = 0; j < 23; ++j) rows[j] = yp[j * 512];
#pragma unroll
        for (int t = 0; t < 16; ++t)
#pragma unroll
            for (int i = 0; i < 8; ++i) acc[t] += w[kb + i] * rows[t + i];
    }
#pragma unroll
    for (int t = 0; t < 16; ++t) sb[t * 516 + c] = acc[t];
    __syncthreads();
    {
        const int t = tid >> 5, j = tid & 31;
        const LAS f32x4* q = (const LAS f32x4*)(sb + t * 516 + 16 * j);
        float s1 = 0.f, s2 = 0.f;
#pragma unroll
        for (int i = 0; i < 4; ++i) { const f32x4 v = q[i]; s1 += (v.x + v.y) + (v.z + v.w); s2 += (v.x * v.x + v.y * v.y) + (v.z * v.z + v.w * v.w); }
#pragma unroll
        for (int o = 1; o < 32; o <<= 1) { s1 += __shfl_xor(s1, o); s2 += __shfl_xor(s2, o); }
        if (j == 0) { const float mean = s1 * (1.f / 512.f); const float var = fmaxf(s2 * (1.f / 512.f) - mean * mean, 0.f); st[2 * t] = mean; st[2 * t + 1] = rsqrtf(var + EPS); }
    }
    __syncthreads();
#pragma unroll
    for (int t = 0; t < 16; ++t) {
        const float y = (acc[t] - st[2 * t]) * st[2 * t + 1] * lgam + lbet;
        const float gate = __uint_as_float((unsigned)gt[t] << 16);
        const float o = (y * fsigm(y)) * (gate * fsigm(gate));
        YA[(size_t)(rowbase + t0 + t) * 512 + c] = (bf16)(cvt_pk_bf16(o, o) & 0xffffu);
    }
}

constexpr int HS_PITCH = 272, HS_S = 16 * HS_PITCH, HS_WAVE = 2 * HS_S;
struct SsmIdx { int lat, b, rg, go, NR; };
__device__ __forceinline__ SsmIdx ssm_decode(int it) {
    SsmIdx s;
    if (it < 512) { s.lat = 0; s.b = it >> 4; s.rg = (it >> 2) & 3; s.go = it & 3; s.NR = 4; }
    else { const int j = it - 512; s.lat = 1; s.b = j >> 6; s.rg = (j >> 2) & 15; s.go = j & 3; s.NR = 16; }
    return s;
}
#define CMUL_ADD(hr, hi_, lr, li, br, bi) do { const float _nr = (lr) * (hr) - (li) * (hi_) + (br); const float _ni = (lr) * (hi_) + (li) * (hr) + (bi); (hr) = _nr; (hi_) = _ni; } while (0)

template <int PASS>
__device__ __forceinline__ void ssm_item(KP P, int l, int it, LAS unsigned char* lds, int tid, int lane, int wid, int gsel) {
    RELOAD_P(P);
    asm volatile("" : "+s"(l)); asm volatile("" : "+v"(tid)); lane = tid & 63; wid = __builtin_amdgcn_readfirstlane(tid >> 6);
    const bf16* Z = (const bf16*)(P->ws + WS_Z);
    const SsmIdx S = ssm_decode(it);
    const int g = 8 * S.go + gsel;
    const int r32 = lane & 31, hi = lane >> 5;
    const int rb = S.lat ? MCTX + S.b * 1024 : S.b * 256;
    const int kA = (r32 & 3) + 4 * (r32 >> 3);
    const int t_start = 64 * S.rg;
    const int sr_base = S.lat ? 128 + S.b * 16 : S.b * 4;
    const bf16* zu = Z + (size_t)(rb + t_start + kA) * NCOL + C_SSMIN + 16 * g + 8 * hi;
    bf16x8 uf[4];
    if (PASS == 2) {
#pragma unroll
        for (int j = 0; j < 4; ++j) uf[j] = __builtin_bit_cast(bf16x8, *(const u32x4*)(zu + (size_t)(16 * j) * NCOL));
    }
    f32x2* E = (f32x2*)(P->ws + WS_E);
    const f32x2* LAM = (const f32x2*)(P->ws + WS_LAM);
    const bf16* BB = (const bf16*)(P->ws + WS_BB);
    const bf16* CT = (const bf16*)(P->ws + WS_CT);
    LAS unsigned char* hs = lds + wid * HS_WAVE;
    f32x4 yacc[4];
    if (PASS == 2) {
#pragma unroll
        for (int j = 0; j < 4; ++j) yacc[j] = (f32x4){0.f, 0.f, 0.f, 0.f};
    }
#pragma unroll
    for (int dir = 0; dir < 2; ++dir) {
        const int ldg = (l * 2 + dir) * 32 + g;
        bf16x8 bfr[2][2];
        f32x2 lam[2];
#pragma unroll
        for (int pt = 0; pt < 2; ++pt) {
            lam[pt] = LAM[(size_t)ldg * 64 + 32 * pt + r32];
#pragma unroll
            for (int ri = 0; ri < 2; ++ri) bfr[pt][ri] = __builtin_bit_cast(bf16x8, *(const u32x4*)(BB + ((size_t)(ldg * 2 + ri) * 64 + 32 * pt + r32) * 16 + 8 * hi));
        }
        float hr[2], hm[2];
        bf16x8 ctf[4];
        if (PASS == 1) { hr[0] = hr[1] = hm[0] = hm[1] = 0.f; }
        else {
            const int q4 = lane >> 4, cc = lane & 15;
#pragma unroll
            for (int kk = 0; kk < 4; ++kk) ctf[kk] = __builtin_bit_cast(bf16x8, *(const u32x4*)(CT + ((size_t)((l * 32 + g) * 2 + dir) * 16 + cc) * 128 + 32 * kk + 8 * q4));
#pragma unroll
            for (int pt = 0; pt < 2; ++pt) {
                float l64r = lam[pt].x, l64i = lam[pt].y;
#pragma unroll
                for (int q = 0; q < 6; ++q) { const float nr = l64r * l64r - l64i * l64i, ni = 2.f * l64r * l64i; l64r = nr; l64i = ni; }
                float cr = 0.f, ci = 0.f;
                if (S.lat) { const size_t si = ((size_t)((S.b * 2 + l) * 2 + dir) * 32 + g) * 64 + 32 * pt + r32; cr = P->in[I_SRE][si]; ci = P->in[I_SIM][si]; }
                {
                    const int n_it = dir == 0 ? S.rg : S.NR - 1 - S.rg;
                    const f32x2* Eb = E + ((size_t)(sr_base * 32 + g) * 2 + dir) * 64 + 32 * pt + r32;
                    for (int i0 = 0; i0 < n_it; i0 += 4) {
                        f32x2 e4[4];
#pragma unroll
                        for (int k = 0; k < 4; ++k) { const int i = min(i0 + k, n_it - 1); const int ri = dir == 0 ? i : S.NR - 1 - i; e4[k] = Eb[(size_t)ri * 4096]; }
#pragma unroll
                        for (int k = 0; k < 4; ++k) { const bool ok = i0 + k < n_it; const float nr = l64r * cr - l64i * ci + e4[k].x, ni = l64r * ci + l64i * cr + e4[k].y; cr = ok ? nr : cr; ci = ok ? ni : ci; }
                    }
                }
                hr[pt] = cr; hm[pt] = ci;
            }
        }
#pragma unroll (PASS == 2 ? 4 : 1)
        for (int jj = 0; jj < 4; ++jj) {
            const int j = dir ? 3 - jj : jj;
            bf16x8 ufj;
            if (PASS == 2) ufj = uf[j]; else ufj = __builtin_bit_cast(bf16x8, *(const u32x4*)(zu + (size_t)(16 * j) * NCOL));
            const f32x16 zero16 = (f32x16){0.f, 0.f, 0.f, 0.f, 0.f, 0.f, 0.f, 0.f, 0.f, 0.f, 0.f, 0.f, 0.f, 0.f, 0.f, 0.f};
#pragma unroll
            for (int pt = 0; pt < 2; ++pt) {
                const f32x16 are = MFMA32(ufj, bfr[pt][0], zero16);
                const f32x16 aim = MFMA32(ufj, bfr[pt][1], zero16);
                LAS unsigned* hw = (LAS unsigned*)(hs + hi * HS_S + 4 * (32 * pt + r32));
#pragma unroll
                for (int rr = 0; rr < 16; ++rr) { const int r = dir ? 15 - rr : rr;
                    CMUL_ADD(hr[pt], hm[pt], lam[pt].x, lam[pt].y, are[r], aim[r]);
                    if (PASS == 2) hw[r * (HS_PITCH / 4)] = cvt_pk_bf16(hr[pt], hm[pt]); }
                __builtin_amdgcn_sched_barrier(0);
            }
            if (PASS == 2) {
                const int q4 = lane >> 4, n = lane & 15;
#pragma unroll
                for (int kk = 0; kk < 4; ++kk) { const bf16x8 hb = *(const LAS bf16x8*)(hs + n * HS_PITCH + 64 * kk + 16 * q4);
                    yacc[j] = MFMA16(ctf[kk], hb, yacc[j]); }
            }
        }
        if (hi == 0) {
            if (PASS == 1) {
#pragma unroll
                for (int pt = 0; pt < 2; ++pt) E[((size_t)((sr_base + S.rg) * 32 + g) * 2 + dir) * 64 + 32 * pt + r32] = (f32x2){hr[pt], hm[pt]};
            } else if (!S.lat && ((dir == 0 && S.rg == 3) || (dir == 1 && S.rg == 0))) {
#pragma unroll
                for (int pt = 0; pt < 2; ++pt) { const size_t oi = ((size_t)((S.b * 2 + l) * 2 + dir) * 32 + g) * 64 + 32 * pt + r32;
                    P->out[O_SRE + oi] = hr[pt]; P->out[O_SIM + oi] = hm[pt]; }
            }
        }
    }
    if (PASS == 2) {
        bf16* YB = (bf16*)(P->ws + WS_YB);
        const int q4 = lane >> 4, n = lane & 15;
        const f32x4 dv = *(const f32x4*)(P->in[I_SD] + l * 512 + 16 * g + 4 * q4);
#pragma unroll
        for (int j = 0; j < 4; ++j) {
            const size_t row = (size_t)(rb + t_start + 16 * j + n);
            const u32x2 uw = *(const u32x2*)(Z + row * NCOL + C_SSMIN + 16 * g + 4 * q4);
            float y[4];
            y[0] = yacc[j][0] + dv.x * bf_lo(uw.x); y[1] = yacc[j][1] + dv.y * bf_hi(uw.x); y[2] = yacc[j][2] + dv.z * bf_lo(uw.y); y[3] = yacc[j][3] + dv.w * bf_hi(uw.y);
#pragma unroll
            for (int i = 0; i < 4; ++i) { const float x = y[i]; y[i] = x * sigm(1.5957691216057308f * (x + 0.044715f * x * x * x)); }
            u32x2 w; w.x = cvt_pk_bf16(y[0], y[1]); w.y = cvt_pk_bf16(y[2], y[3]);
            *(u32x2*)(YB + row * 512 + 16 * g + 4 * q4) = w;
        }
    }
}

#ifdef DBG_NAIVE_STATE
__device__ __forceinline__ void naive_state_item(KP P, int l, int it, int tid) {
    RELOAD_P(P);
    asm volatile("" : "+s"(l)); asm volatile("" : "+v"(tid));
    const bf16* Z = (const bf16*)(P->ws + WS_Z);
    const int idx = it * 512 + tid; const int p = idx & 63, g = (idx >> 6) & 31, dir = (idx >> 11) & 1, b = idx >> 12;
    const int ti = ((l * 2 + dir) * 32 + g) * 64 + p;
    const float are = P->in[I_ARE][ti], aim = P->in[I_AIM][ti];
    const f32x2 lmb = ((const f32x2*)(P->ws + WS_LAM))[ti];
    const float lr = lmb.x, li = lmb.y;
    const float d2 = are * are + aim * aim, qr = ((lr - 1.0f) * are + li * aim) / d2, qi = (li * are - (lr - 1.0f) * aim) / d2;
    float bre[16], bim[16];
#pragma unroll
    for (int c = 0; c < 16; ++c) { const float br = P->in[I_BRE][(size_t)ti * 16 + c], bi = P->in[I_BIM][(size_t)ti * 16 + c]; bre[c] = qr * br - qi * bi; bim[c] = qr * bi + qi * br;
#ifdef DBG_BF16_B
        { const unsigned w = cvt_pk_bf16(bre[c], bim[c]); bre[c] = bf_lo(w); bim[c] = bf_hi(w); }
#endif
#ifdef DBG_USE_BB
        { const bf16* BBt = (const bf16*)(P->ws + WS_BB); const int ldg_ = (l * 2 + dir) * 32 + g;
          bre[c] = __uint_as_float((unsigned)BBt[((size_t)(ldg_ * 2 + 0) * 64 + p) * 16 + c] << 16); bim[c] = __uint_as_float((unsigned)BBt[((size_t)(ldg_ * 2 + 1) * 64 + p) * 16 + c] << 16); }
#endif
    }
    float hr = 0.f, hm = 0.f;
#pragma unroll 1
    for (int tt = 0; tt < 256; ++tt) {
        const int t = dir ? 255 - tt : tt;
        const bf16* src = Z + (size_t)(b * 256 + t) * NCOL + C_SSMIN + 16 * g;
        float u[16]; unpack8(*(const u32x4*)src, u); unpack8(*(const u32x4*)(src + 8), u + 8);
        float br = 0.f, bi = 0.f;
#pragma unroll
        for (int c = 0; c < 16; ++c) { br += bre[c] * u[c]; bi += bim[c] * u[c]; }
        CMUL_ADD(hr, hm, lr, li, br, bi);
    }
    const size_t oi = ((size_t)((b * 2 + l) * 2 + dir) * 32 + g) * 64 + p;
#if defined(DBG_SPLIT_HI) && defined(DBG_SWAP)
    if ((b & 1) == DBG_SPLIT_HI)
#elif defined(DBG_SPLIT_HI)
    if ((b & 1) != DBG_SPLIT_HI)
#endif
    { P->out[O_SRE + oi] = hr; P->out[O_SIM + oi] = hm; }
}
#endif

__device__ __forceinline__ void state_item(KP P, int l, int it, int tid, int lane, int wid) {
    RELOAD_P(P);
    asm volatile("" : "+s"(l)); asm volatile("" : "+v"(tid)); lane = tid & 63; wid = __builtin_amdgcn_readfirstlane(tid >> 6);
    const bf16* Z = (const bf16*)(P->ws + WS_Z);
    const int w = __builtin_amdgcn_readfirstlane(it * 8 + wid);
    const int g = w & 31, dir = (w >> 5) & 1, b = w >> 6;
    const int r32 = lane & 31, hi = lane >> 5;
    const int kA = (r32 & 3) + 4 * (r32 >> 3);
    const int ldg = (l * 2 + dir) * 32 + g;
    const f32x2* LAM = (const f32x2*)(P->ws + WS_LAM);
    const bf16* BB = (const bf16*)(P->ws + WS_BB);
    bf16x8 bfr[2][2]; f32x2 lam[2]; float hr[2] = {0.f, 0.f}, hm[2] = {0.f, 0.f};
#pragma unroll
    for (int pt = 0; pt < 2; ++pt) {
        lam[pt] = LAM[(size_t)ldg * 64 + 32 * pt + r32];
#pragma unroll
        for (int ri = 0; ri < 2; ++ri) bfr[pt][ri] = __builtin_bit_cast(bf16x8, *(const u32x4*)(BB + ((size_t)(ldg * 2 + ri) * 64 + 32 * pt + r32) * 16 + 8 * hi));
    }
    const bf16* zb = Z + (size_t)(b * 256 + kA) * NCOL + C_SSMIN + 16 * g + 8 * hi;
    const f32x16 z16 = (f32x16){0.f, 0.f, 0.f, 0.f, 0.f, 0.f, 0.f, 0.f, 0.f, 0.f, 0.f, 0.f, 0.f, 0.f, 0.f, 0.f};
#pragma unroll 1
    for (int q = 0; q < 16; q += 2) {
        const int j0 = dir ? 15 - q : q, j1 = dir ? 14 - q : q + 1;
        const bf16x8 u0 = __builtin_bit_cast(bf16x8, *(const u32x4*)(zb + (size_t)(16 * j0) * NCOL));
        const bf16x8 u1 = __builtin_bit_cast(bf16x8, *(const u32x4*)(zb + (size_t)(16 * j1) * NCOL));
#pragma unroll
        for (int half = 0; half < 2; ++half) {
            const bf16x8 ux = half ? u1 : u0;
#pragma unroll
            for (int pt = 0; pt < 2; ++pt) {
                const f32x16 xr = MFMA32(ux, bfr[pt][0], z16);
                const f32x16 xi = MFMA32(ux, bfr[pt][1], z16);
                if (dir == 0) {
#pragma unroll
                    for (int r = 0; r < 16; ++r) CMUL_ADD(hr[pt], hm[pt], lam[pt].x, lam[pt].y, xr[r], xi[r]);
                } else {
#pragma unroll
                    for (int r = 15; r >= 0; --r) CMUL_ADD(hr[pt], hm[pt], lam[pt].x, lam[pt].y, xr[r], xi[r]);
                }
            }
        }
    }
    if (hi == 0) {
#pragma unroll
        for (int pt = 0; pt < 2; ++pt) { const size_t oi = ((size_t)((b * 2 + l) * 2 + dir) * 32 + g) * 64 + 32 * pt + r32;
            P->out[O_SRE + oi] = hr[pt]; P->out[O_SIM + oi] = hm[pt]; }
    }
}
#define XB_TMO      128
#define XB_XCNT(j)  (256  + 64 * (j))
#define XB_XSUB(j)  (1280 + 64 * (j))
#define XB_XGEN(j)  (2304 + 64 * (j))
#define XB_TOP      3328
#define XB_TOPGEN   3392
#define XCD_BAR_WORDS 3456
#define XB_SPIN_CAP (1u << 18)

__device__ __forceinline__ unsigned xb_ld(unsigned* p)              { return __hip_atomic_load(p, __ATOMIC_RELAXED, __HIP_MEMORY_SCOPE_AGENT); }
__device__ __forceinline__ unsigned xb_add(unsigned* p, unsigned v) { return __hip_atomic_fetch_add(p, v, __ATOMIC_RELAXED, __HIP_MEMORY_SCOPE_AGENT); }
__device__ __forceinline__ unsigned xb_xcc_id() { return (unsigned)__builtin_amdgcn_s_getreg((3 << 11) | 20) & 0xFu; }
#define XB_SPIN(cond, bar) do { unsigned _sp = 0; while (cond) { __builtin_amdgcn_s_sleep(1); \
    if ((++_sp & 255u) == 0u) { if (xb_ld(&(bar)[XB_TMO])) break; if (_sp > XB_SPIN_CAP) { atomicAdd(&(bar)[XB_TMO], 1u); break; } } } } while (0)

struct XcdBarrier {
    unsigned* bar; unsigned x;
    volatile LAS unsigned* st;
};

__device__ __forceinline__ XcdBarrier xcd_barrier_post(unsigned* bar, volatile LAS unsigned* st) {
    XcdBarrier b; b.bar = bar; b.x = xb_xcc_id(); b.st = st;
    if (threadIdx.x == 0) (void)xb_add(&bar[XB_XCNT(b.x)], 1u);
    return b;
}
__device__ __forceinline__ void xcd_barrier_complete(unsigned* bar, unsigned x, unsigned& nloc, unsigned& nx) {
    const unsigned G = gridDim.x * gridDim.y * gridDim.z;
    unsigned sum, cnt, mine, sp = 0u;
    for (;;) {
        sum = 0u; cnt = 0u; mine = 0u;
#pragma unroll
        for (unsigned j = 0; j < 16; ++j) { const unsigned c = xb_ld(&bar[XB_XCNT(j)]); sum += c; cnt += (c > 0u) ? 1u : 0u; mine = (j == x) ? c : mine; }
        if (sum == G) break;
        __builtin_amdgcn_s_sleep(1);
        if ((++sp & 255u) == 0u) { if (xb_ld(&bar[XB_TMO])) break; if (sp > XB_SPIN_CAP) { atomicAdd(&bar[XB_TMO], 1u); break; } }
    }
    nloc = mine > 0u ? mine : 1u; nx = cnt > 0u ? cnt : 1u;
}

__device__ __forceinline__ void xcd_barrier(const XcdBarrier& b) {
    asm volatile("s_waitcnt vmcnt(0)" ::: "memory");
    __syncthreads();
    if (threadIdx.x == 0) {
        unsigned* bar = b.bar;
        __builtin_amdgcn_s_waitcnt(0);
        unsigned nloc = b.st[0], nx = b.st[1];
        if (nloc == 0u) { xcd_barrier_complete(bar, b.x, nloc, nx); b.st[0] = nloc; b.st[1] = nx; }
        const unsigned old = xb_add(&bar[XB_XSUB(b.x)], 1u);
        const unsigned gen = old / nloc;
        if (old + 1u == (gen + 1u) * nloc) {
            __builtin_amdgcn_fence(__ATOMIC_RELEASE, "agent");
            asm volatile("s_waitcnt vmcnt(0)" ::: "memory");
            const unsigned og = xb_add(&bar[XB_TOP], 1u);
            const unsigned tg = og / nx;
            if (og + 1u == (tg + 1u) * nx) xb_add(&bar[XB_TOPGEN], 1u);
            else XB_SPIN(xb_ld(&bar[XB_TOPGEN]) == tg, bar);
            __builtin_amdgcn_fence(__ATOMIC_ACQUIRE, "agent");
            xb_add(&bar[XB_XGEN(b.x)], 1u);
            asm volatile("s_waitcnt vmcnt(0)" ::: "memory");
        } else {
            XB_SPIN(xb_ld(&bar[XB_XGEN(b.x)]) == gen, bar);
            __builtin_amdgcn_fence(__ATOMIC_ACQUIRE, "agent");
            asm volatile("s_waitcnt vmcnt(0)" ::: "memory");
        }
    }
    __syncthreads();
}


constexpr int CW_XBAR = 32768;
#ifndef REP_SYNC
#define REP_SYNC 1
#endif
#ifndef REP_ATT
#define REP_ATT 1
#endif
#ifndef REP_SSM1
#define REP_SSM1 1
#endif
#ifndef REP_CONV
#define REP_CONV 1
#endif
#ifndef REP_P2
#define REP_P2 1
#endif
#ifndef REP_P3
#define REP_P3 1
#endif
#ifndef REP_P4
#define REP_P4 1
#endif
#ifndef REP_P56
#define REP_P56 1
#endif
__device__ __forceinline__ void grid_sync_all(cg::grid_group& grid) {
    asm volatile("s_waitcnt vmcnt(0) lgkmcnt(0)" ::: "memory");
    grid.sync();
    __builtin_amdgcn_fence(__ATOMIC_ACQUIRE, "agent");
    asm volatile("s_waitcnt vmcnt(0)" ::: "memory");
}
__device__ __forceinline__ int q_next(unsigned* ctr, LAS int* slot, int tid) {
    __syncthreads();
    if (tid == 0) *slot = (int)atomicAdd(ctr, 1u);
    __syncthreads();
    return *slot;
}

__global__ void __launch_bounds__(512, 2) fwd_kernel(Params Pk_unused) {
    KP P = (KP)__builtin_amdgcn_kernarg_segment_ptr();
    extern __shared__ __attribute__((aligned(16))) unsigned char lds_raw[];
    cg::grid_group grid = cg::this_grid();
    LAS unsigned char* lds = (LAS unsigned char*)lds_raw;
    LAS int* qslot = (LAS int*)(lds + 131072 + 1024);
    const int tid = threadIdx.x, lane = tid & 63, wid = __builtin_amdgcn_readfirstlane(tid >> 6);
    volatile LAS unsigned* xst = (volatile LAS unsigned*)(lds + 131072 + 2048);
    if (tid < 2) xst[tid] = 0u;
    __syncthreads();
    const XcdBarrier xbar = xcd_barrier_post((unsigned*)(P->ws + WS_CTL) + CW_XBAR, xst);

#ifndef REP_P0
#define REP_P0 1
#endif
    for (int r0_ = 0; r0_ < REP_P0; ++r0_) { if (r0_) __syncthreads(); p0_prologue(P, lds, tid, lane, wid); }
    for (int rs_ = 0; rs_ < REP_SYNC; ++rs_) xcd_barrier(xbar);
    if (xb_ld(&xbar.bar[XB_TMO]) != 0u) grid.sync();

#pragma unroll 1
    for (int l = 0; l < 2; ++l) {
#ifndef REP_P1
#define REP_P1 1
#endif
        for (int r1_ = 0; r1_ < REP_P1; ++r1_) p1_rows(P, l, lane, wid);
        for (int rs_ = 0; rs_ < REP_SYNC; ++rs_) xcd_barrier(xbar);
#ifndef NO_P2
#pragma unroll 1
        for (int rep_ = 0; rep_ < REP_P2; ++rep_) {
            RELOAD_P(P); unsigned char* ws = P->ws; const unsigned char* wl = ws + WS_W + (size_t)l * W_LAYER_B; bf16* Z = (bf16*)(ws + WS_Z); unsigned* ctl = (unsigned*)(ws + WS_CTL); (void)wl; (void)Z; (void)ctl;
            pg8::Gemm g{(const bf16*)(ws + WS_H), (const bf16*)wl, MTOK, NCOL, DM};
            pg8::WinOrder S{(int)gridDim.x, (int)blockIdx.x};
            pg8::EpiPlain E{Z, NCOL};
            pg8::gemm_phase<pg8::EpiPlain, pg8::WinOrder, true, true>(lds, g, S, E);
        }
#endif
        for (int rs_ = 0; rs_ < REP_SYNC; ++rs_) xcd_barrier(xbar);
#ifndef NO_P3
#pragma unroll 1
        for (int rep_ = 0; rep_ < REP_P3; ++rep_) {
            RELOAD_P(P); unsigned char* ws = P->ws; const unsigned char* wl = ws + WS_W + (size_t)l * W_LAYER_B; bf16* Z = (bf16*)(ws + WS_Z); unsigned* ctl = (unsigned*)(ws + WS_CTL); (void)wl; (void)Z; (void)ctl;
            unsigned* ctr = ctl + 64 * (1 + 2 * l) + 320 * rep_;
            unsigned pre0 = 0u; if (tid == 0) pre0 = atomicAdd(ctr, 1u);
            if (gridDim.x == 256) {
#pragma unroll 1
                for (int k = 0; k < 3; ++k) {
                    int item, gs;
                    if (k < 2) { item = (int)blockIdx.x + 256 * k; gs = wid; }
                    else { if (wid >= 4) break; item = 512 + ((int)blockIdx.x >> 1); gs = ((int)blockIdx.x & 1) * 4 + wid; }
                    ssm_item<1>(P, l, item, lds, tid, lane, wid, gs);
                }
            } else {
                for (int item = (int)blockIdx.x; item < 640; item += (int)gridDim.x) ssm_item<1>(P, l, item, lds, tid, lane, wid, wid);
            }
            for (bool first = true;; first = false) {
                int it;
                if (first) { __syncthreads(); if (tid == 0) *qslot = (int)pre0; __syncthreads(); it = *qslot; } else it = q_next(ctr, qslot, tid);
                if (it >= 1016) break;
                if (it < 64 || (it >= 760 && it < 1016)) {
                    const int ia = it < 64 ? it : it - 696;
                    for (int ra_ = 0; ra_ < REP_ATT; ++ra_) { if (ra_) __syncthreads(); attn_item(P, l, ia, lds, tid, lane, wid); }
                } else if (it < 120) {
                    pg8::Gemm g{(const bf16*)(ws + WS_H), (const bf16*)wl, MTOK, NCOL, DM};
                    pg8::OneUnit S1{1024 + (it - 64)};
                    pg8::EpiPlain E{Z, NCOL};
                    pg8::gemm_phase<pg8::EpiPlain, pg8::OneUnit, true, true>(lds, g, S1, E);
                } else {
                    for (int ra_ = 0; ra_ < REP_CONV; ++ra_) { if (ra_) __syncthreads(); conv_item(P, l, it - 120, lds, tid, lane, wid); }
                }
            }
        }
#endif
        for (int rs_ = 0; rs_ < REP_SYNC; ++rs_) xcd_barrier(xbar);
#ifndef NO_P4
#pragma unroll 1
        for (int rep_ = 0; rep_ < REP_P4; ++rep_) {
            RELOAD_P(P); unsigned char* ws = P->ws; const unsigned char* wl = ws + WS_W + (size_t)l * W_LAYER_B; bf16* Z = (bf16*)(ws + WS_Z); unsigned* ctl = (unsigned*)(ws + WS_CTL); (void)wl; (void)Z; (void)ctl;
            unsigned* ctr = ctl + 64 * (2 + 2 * l) + 320 * rep_;
            (void)ctr;
            if (gridDim.x == 256) {
#pragma unroll 1
                for (int k = 0; k < 3; ++k) {
                    int item, gs;
                    if (k < 2) { item = (int)blockIdx.x + 256 * k; gs = wid; }
                    else { if (wid >= 4) break; item = 512 + ((int)blockIdx.x >> 1); gs = ((int)blockIdx.x & 1) * 4 + wid; }
                    const int it2 = item < 128 ? 512 + item : item - 128;
                    ssm_item<2>(P, l, it2, lds, tid, lane, wid, gs);
                }
            } else {
                for (int item = (int)blockIdx.x; item < 640; item += (int)gridDim.x) { const int it2 = item < 128 ? 512 + item : item - 128; ssm_item<2>(P, l, it2, lds, tid, lane, wid, wid); }
            }
#ifdef DBG_NAIVE_STATE
#pragma unroll 1
            for (int it = blockIdx.x; it < 256; it += gridDim.x) naive_state_item(P, l, it, tid);
#endif
        }
#endif
        for (int rs_ = 0; rs_ < REP_SYNC; ++rs_) xcd_barrier(xbar);
#pragma unroll 1
        for (int rep_ = 0; rep_ < REP_P56; ++rep_) {
            RELOAD_P(P); unsigned char* ws = P->ws; const unsigned char* wl = ws + WS_W + (size_t)l * W_LAYER_B; bf16* Z = (bf16*)(ws + WS_Z);
            const int G = (int)gridDim.x, NB = G >= 200 ? 160 : (G * 5) / 8;
            if ((int)blockIdx.x < NB) {
                pg8::Gemm g{(const bf16*)(ws + WS_ABR), (const bf16*)(wl + W_IN_B + W_GLU_B), 3 * MTOK, 3 * 1024, 512};
                pg8::BranchOrderX S{NB, (int)blockIdx.x};
                pg8::EpiBranch E{(bf16*)(ws + WS_H), Z + C_MERGE, NCOL};
                pg8::gemm_phase<pg8::EpiBranch, pg8::BranchOrderX, true, true>(lds, g, S, E);
            } else {
                pg8::Gemm g{(const bf16*)(ws + WS_YB), (const bf16*)(wl + W_IN_B), MTOK, 1024, 512};
                pg8::GluOrder S{G - NB, (int)blockIdx.x - NB};
                pg8::EpiGlu E{(bf16*)(ws + WS_ABR) + (size_t)MTOK * 512, Z + C_SGATE, NCOL};
                pg8::gemm_phase<pg8::EpiGlu, pg8::GluOrder, true, true>(lds, g, S, E);
            }
        }
        for (int rs_ = 0; rs_ < REP_SYNC; ++rs_) xcd_barrier(xbar);
#pragma unroll 1
        for (int rep_ = 0; rep_ < 1; ++rep_) {
            RELOAD_P(P); unsigned char* ws = P->ws; const unsigned char* wl = ws + WS_W + (size_t)l * W_LAYER_B; bf16* Z = (bf16*)(ws + WS_Z);
            pg8::Gemm g{(const bf16*)(ws + WS_ABR), (const bf16*)(wl + W_IN_B + W_GLU_B), 3 * MTOK, 3 * 1024, 512};
            pg8::BranchOrderY S{(int)gridDim.x, (int)blockIdx.x};
            pg8::EpiBranch E{(bf16*)(ws + WS_H), Z + C_MERGE, NCOL};
            pg8::gemm_phase<pg8::EpiBranch, pg8::BranchOrderY, true, true>(lds, g, S, E);
            if (l == 0 && defer_l1_weights() && blockIdx.x >= 160) convert_weights(P, 1, 1, 160, lds);
        }
        for (int rs_ = 0; rs_ < REP_SYNC; ++rs_) xcd_barrier(xbar);
#ifndef REP_P7L0
#define REP_P7L0 1
#endif
#pragma unroll 1
        for (int rep7_ = 0; rep7_ < (l == 0 ? REP_P7L0 : 1); ++rep7_) {
            RELOAD_P(P); unsigned char* ws = P->ws; const unsigned char* wl = ws + WS_W + (size_t)l * W_LAYER_B; bf16* Z = (bf16*)(ws + WS_Z); unsigned* ctl = (unsigned*)(ws + WS_CTL); (void)wl; (void)Z; (void)ctl;
            pg8::Gemm g{(const bf16*)(ws + WS_H), (const bf16*)(wl + W_IN_B + W_GLU_B + W_BR_B), MTOK, 1024, 1024};
            pg8::StaticOrder S; S.init(MTOK, 1024, (int)gridDim.x, (int)blockIdx.x);
            const float* gate = (const float*)(ws + WS_MODS) + (size_t)l * 3 * 3072 + 2048;
            pg8::EpiResid E{l == 0 ? P->in[I_XP] : P->out, l == 0 ? P->in[I_XS] : P->out + (size_t)MCTX * DM, P->out, gate};
            pg8::gemm_phase<pg8::EpiResid, pg8::StaticOrder, true, true>(lds, g, S, E);
            if (l == 0 && defer_l1_weights() && blockIdx.x >= 160) convert_weights(P, 1, 0, 160, lds);
        }
        if (l == 0) for (int rs_ = 0; rs_ < REP_SYNC; ++rs_) xcd_barrier(xbar);
    }
}

extern "C" void kernel_launch(void* const* d_in, const int* in_sizes, int n_in, void* d_out, int out_size, void* d_ws, size_t ws_size, hipStream_t stream) {
    static int grid = 0;
    if (grid == 0) {
        if (n_in != 31 || ws_size < WS_END) { fprintf(stderr, "kernel_launch: unexpected n_in %d / ws_size %zu (need %zu)\n", n_in, ws_size, (size_t)WS_END); grid = -1; return; }
        int dev = 0, cus = 0, per_cu = 0;
        hipGetDevice(&dev);
        hipDeviceGetAttribute(&cus, hipDeviceAttributeMultiprocessorCount, dev);
        if (hipFuncSetAttribute((const void*)fwd_kernel, hipFuncAttributeMaxDynamicSharedMemorySize, LDS_BYTES) != hipSuccess) { fprintf(stderr, "kernel_launch: hipFuncSetAttribute failed\n"); grid = -1; return; }
        if (hipOccupancyMaxActiveBlocksPerMultiprocessor(&per_cu, (const void*)fwd_kernel, 512, LDS_BYTES) != hipSuccess || per_cu < 1) { fprintf(stderr, "kernel_launch: occupancy query says %d\n", per_cu); (void)hipGetLastError(); per_cu = 1; }
        grid = cus * 1;
    }
    if (grid < 0) return;
    (void)hipMemsetAsync((char*)d_ws + WS_CTL, 0, CTL_ZERO_BYTES, stream);
    Params p{};
    for (int i = 0; i < 31; ++i) p.in[i] = (const float*)d_in[i];
    p.out = (float*)d_out; p.ws = (unsigned char*)d_ws;
    void* args[] = {&p};
    hipError_t e = hipLaunchCooperativeKernel((const void*)fwd_kernel, dim3(grid), dim3(512), args, LDS_BYTES, stream);
    if (e != hipSuccess) fprintf(stderr, "cooperative launch failed: %s (grid %d)\n", hipGetErrorString(e), grid);
}
```

```cpp
#include <hip/hip_runtime.h>
#include <hip/hip_cooperative_groups.h>
#include <cstdio>
#include <cstdint>
#include <cmath>
namespace cg = cooperative_groups;
namespace pg8 {
#define PG8_LAS __attribute__((address_space(3)))
typedef unsigned short bf16_t;
typedef short bf16x8 __attribute__((ext_vector_type(8)));
typedef float f32x4 __attribute__((ext_vector_type(4)));
typedef unsigned u32x4 __attribute__((ext_vector_type(4)));
constexpr int BM = 256, BK = 64, HALF = 128, HTB = HALF * BK * 2  , STAGE_BYTES = 8 * HTB, NXCD = 8, WGM = 8;

__host__ __device__ __forceinline__ int lds_byte(int r, int c) { const int st = (r >> 4) * 2 + (c >> 5), rr = r & 15, cc = c & 31, ob = rr * 64 + cc * 2; return st * 1024 + (ob ^ (((ob >> 9) & 1) << 5)); }
__host__ __device__ __forceinline__ void stage_rc(int b, int& R, int& C) { const int st = b / 1024, sb = b % 1024, swz = sb ^ (((sb >> 9) & 1) << 5); R = (st >> 1) * 16 + swz / 64; C = (st & 1) * 32 + (swz % 64) / 2; }
__host__ __device__ __forceinline__ int perm32(int rho) { const int n = rho >> 4, i = rho & 15; return 8 * (i >> 2) + 4 * n + (i & 3); }

struct Unit { int pm, pn; };
struct Gemm { const bf16_t* A; const bf16_t* Bt; int M, N, K; };

struct StaticOrder {
    int nM, nN, nwg, G, c;
    __host__ __device__ void init(int M, int N, int G_, int c_) { nM = M / BM; nN = N / BM; nwg = nM * nN; G = G_; c = c_; }
    __host__ __device__ bool next(int i, Unit& u) const {
        const long L = (long)i * G + c; if (L >= nwg) return false;
        int wgid = (int)L; { const int q = nwg / NXCD, r = nwg % NXCD, xcd = wgid % NXCD, off = wgid / NXCD; wgid = (xcd < r ? xcd * (q + 1) : r * (q + 1) + (xcd - r) * q) + off; }
        const int nig = WGM * nN, gid = wgid / nig, fm = gid * WGM, gsz = (nM - fm) < WGM ? (nM - fm) : WGM;
        u.pm = fm + ((wgid % nig) % gsz); u.pn = (wgid % nig) / gsz; return true;
    }
    __device__ __forceinline__ void a_ready(const Unit&) const {}
    __device__ __forceinline__ void done(const Unit&) const {}
};

__device__ __forceinline__ unsigned cvt_pk_bf16(float lo, float hi) { unsigned r; asm volatile("v_cvt_pk_bf16_f32 %0, %1, %2" : "=v"(r) : "v"(lo), "v"(hi)); return r; }
typedef float f32x2 __attribute__((ext_vector_type(2)));
typedef unsigned u32x4e __attribute__((ext_vector_type(4)));
__device__ __forceinline__ float bf_lo(unsigned w) { return __uint_as_float(w << 16); }
__device__ __forceinline__ float bf_hi(unsigned w) { return __uint_as_float(w & 0xffff0000u); }
__device__ __forceinline__ float sigm(float x) { return __builtin_amdgcn_rcpf(1.f + __builtin_amdgcn_exp2f(-1.4426950408889634f * x)); }
__device__ __forceinline__ float silu_f(float x) { return x * __builtin_amdgcn_rcpf(1.f + __builtin_amdgcn_exp2f(-1.4426950408889634f * x)); }

struct EpiPlain {
    static constexpr bool PERM = true, AFTER_DRAIN = false;
    bf16_t* O; int ldc;
    __device__ __forceinline__ void operator()(const f32x4 (&acc)[2][2][4][2], const Unit& u, int wr, int wc, int fr, int fq) const {
        const int row0 = u.pm * BM + wr * 64 + fr, col0 = u.pn * BM + wc * 32 + 8 * fq;
#pragma unroll
        for (int ai = 0; ai < 2; ++ai)
#pragma unroll
            for (int m = 0; m < 4; ++m) { bf16_t* rowp = O + (size_t)(row0 + ai * HALF + m * 16) * ldc + col0;
#pragma unroll
                for (int bj = 0; bj < 2; ++bj) { const f32x4 v0 = acc[ai][bj][m][0], v1 = acc[ai][bj][m][1];
                    u32x4e w; w.x = cvt_pk_bf16(v0[0], v0[1]); w.y = cvt_pk_bf16(v0[2], v0[3]); w.z = cvt_pk_bf16(v1[0], v1[1]); w.w = cvt_pk_bf16(v1[2], v1[3]);
                    *(u32x4e*)(rowp + bj * HALF) = w; } }
    }
};
struct EpiGlu {
    static constexpr bool PERM = true, AFTER_DRAIN = false;
    bf16_t* O; const bf16_t* Zg; int ldz;
    __device__ __forceinline__ void operator()(const f32x4 (&acc)[2][2][4][2], const Unit& u, int wr, int wc, int fr, int fq) const {
        const int row0 = u.pm * BM + wr * 64 + fr, oc0 = u.pn * 128 + wc * 32 + 8 * fq;
#pragma unroll
        for (int ai = 0; ai < 2; ++ai)
#pragma unroll
            for (int m = 0; m < 4; ++m) { const int r = row0 + ai * HALF + m * 16;
                const u32x4e gz = *(const u32x4e*)(Zg + (size_t)r * ldz + oc0);
                const f32x4 a0 = acc[ai][0][m][0], a1 = acc[ai][0][m][1], b0 = acc[ai][1][m][0], b1 = acc[ai][1][m][1];
                float o[8];
                o[0] = a0[0] * sigm(b0[0]) * silu_f(bf_lo(gz.x)); o[1] = a0[1] * sigm(b0[1]) * silu_f(bf_hi(gz.x));
                o[2] = a0[2] * sigm(b0[2]) * silu_f(bf_lo(gz.y)); o[3] = a0[3] * sigm(b0[3]) * silu_f(bf_hi(gz.y));
                o[4] = a1[0] * sigm(b1[0]) * silu_f(bf_lo(gz.z)); o[5] = a1[1] * sigm(b1[1]) * silu_f(bf_hi(gz.z));
                o[6] = a1[2] * sigm(b1[2]) * silu_f(bf_lo(gz.w)); o[7] = a1[3] * sigm(b1[3]) * silu_f(bf_hi(gz.w));
                u32x4e w; w.x = cvt_pk_bf16(o[0], o[1]); w.y = cvt_pk_bf16(o[2], o[3]); w.z = cvt_pk_bf16(o[4], o[5]); w.w = cvt_pk_bf16(o[6], o[7]);
                *(u32x4e*)(O + (size_t)r * 512 + oc0) = w; }
    }
};
struct EpiBranch {
    static constexpr bool PERM = true, AFTER_DRAIN = false;
    bf16_t* MIX; const bf16_t* Zm; int ldz;
    __device__ __forceinline__ void operator()(const f32x4 (&acc)[2][2][4][2], const Unit& u, int wr, int wc, int fr, int fq) const {
        const int br = u.pn >> 2, pn = u.pn & 3, pm = u.pm - 40 * br;
        const int row0 = pm * BM + wr * 64 + fr, col0 = pn * BM + wc * 32 + 8 * fq;
#pragma unroll
        for (int ai = 0; ai < 2; ++ai)
#pragma unroll
            for (int m = 0; m < 4; ++m) { const int r = row0 + ai * HALF + m * 16;
#pragma unroll
                for (int bj = 0; bj < 2; ++bj) { const int c = col0 + bj * HALF;
                    const u32x4e gz = *(const u32x4e*)(Zm + (size_t)r * ldz + br * 1024 + c);
                    u32x4e pv = (u32x4e){0u, 0u, 0u, 0u};
                    if (br > 0) pv = *(const u32x4e*)(MIX + (size_t)r * 1024 + c);
                    const f32x4 v0 = acc[ai][bj][m][0], v1 = acc[ai][bj][m][1];
                    float o[8];
                    o[0] = v0[0] * sigm(bf_lo(gz.x)) + bf_lo(pv.x); o[1] = v0[1] * sigm(bf_hi(gz.x)) + bf_hi(pv.x);
                    o[2] = v0[2] * sigm(bf_lo(gz.y)) + bf_lo(pv.y); o[3] = v0[3] * sigm(bf_hi(gz.y)) + bf_hi(pv.y);
                    o[4] = v1[0] * sigm(bf_lo(gz.z)) + bf_lo(pv.z); o[5] = v1[1] * sigm(bf_hi(gz.z)) + bf_hi(pv.z);
                    o[6] = v1[2] * sigm(bf_lo(gz.w)) + bf_lo(pv.w); o[7] = v1[3] * sigm(bf_hi(gz.w)) + bf_hi(pv.w);
                    u32x4e w; w.x = cvt_pk_bf16(o[0], o[1]); w.y = cvt_pk_bf16(o[2], o[3]); w.z = cvt_pk_bf16(o[4], o[5]); w.w = cvt_pk_bf16(o[6], o[7]);
                    *(u32x4e*)(MIX + (size_t)r * 1024 + c) = w; } }
    }
};
struct WinOrder {
    int G, c;
    __device__ __forceinline__ static void unit_of(int W, Unit& u) { const int gid = W / 216, rr = W % 216; u.pm = gid * 8 + (rr & 7); u.pn = rr >> 3; }
    __device__ __forceinline__ bool next(int i, Unit& u) const {
        const int L = i * G + c; if (L >= 1024) return false;
        unit_of((L & 7) * 128 + (L >> 3), u); return true;
    }
    __device__ __forceinline__ void a_ready(const Unit&) const {}
    __device__ __forceinline__ void done(const Unit&) const {}
};
struct OneUnit {
    int W;
    __device__ __forceinline__ bool next(int i, Unit& u) const { if (i > 0) return false; WinOrder::unit_of(W, u); return true; }
    __device__ __forceinline__ void a_ready(const Unit&) const {}
    __device__ __forceinline__ void done(const Unit&) const {}
};
struct BranchOrderX {
    int NB, c;
    __device__ __forceinline__ bool next(int i, Unit& u) const {
        const int tI = (i >> 1) * NB + c, br = (i & 1) * 2; if (tI >= 160) return false;
        u.pm = br * 40 + (tI >> 2); u.pn = br * 4 + (tI & 3); return true;
    }
    __device__ __forceinline__ void a_ready(const Unit&) const {}
    __device__ __forceinline__ void done(const Unit&) const {}
};
struct GluOrder {
    int NG, c;
    __device__ __forceinline__ bool next(int i, Unit& u) const {
        const int tI = i * NG + c; if (tI >= 160) return false;
        u.pm = tI >> 2; u.pn = tI & 3; return true;
    }
    __device__ __forceinline__ void a_ready(const Unit&) const {}
    __device__ __forceinline__ void done(const Unit&) const {}
};
struct BranchOrderY {
    int G, c;
    __device__ __forceinline__ bool next(int i, Unit& u) const {
        const int tI = i * G + c; if (tI >= 160) return false;
        u.pm = 40 + (tI >> 2); u.pn = 4 + (tI & 3); return true;
    }
    __device__ __forceinline__ void a_ready(const Unit&) const {}
    __device__ __forceinline__ void done(const Unit&) const {}
};
struct BranchOrder {
    int G, c;
    __device__ __forceinline__ bool next(int i, Unit& u) const {
        const int tI = (i / 3) * G + c, br = i % 3; if (tI >= 160) return false;
        u.pm = br * 40 + (tI >> 2); u.pn = br * 4 + (tI & 3); return true;
    }
    __device__ __forceinline__ void a_ready(const Unit&) const {}
    __device__ __forceinline__ void done(const Unit&) const {}
};
struct EpiResid {
    static constexpr bool PERM = false, AFTER_DRAIN = false;
    const float* base_ctx; const float* base_lat; float* out; const float* gate;
    __device__ __forceinline__ void operator()(const f32x4 (&acc)[2][2][4][2], const Unit& u, int wr, int wc, int fr, int fq) const {
        const int row0 = u.pm * BM + wr * 64 + fr, col0 = u.pn * BM + wc * 32 + 4 * fq;
        const int cond = u.pm < 32 ? 0 : 1 + ((u.pm - 32) >> 2);
        const float* bp = u.pm < 32 ? base_ctx : base_lat - (size_t)8192 * 1024;
        f32x4 gv[2][2];
#pragma unroll
        for (int bj = 0; bj < 2; ++bj)
#pragma unroll
            for (int n = 0; n < 2; ++n) gv[bj][n] = *(const f32x4*)(gate + cond * 3072 + col0 + bj * HALF + n * 16);
#pragma unroll
        for (int ai = 0; ai < 2; ++ai)
#pragma unroll
            for (int m = 0; m < 4; ++m) { const size_t off = (size_t)(row0 + ai * HALF + m * 16) * 1024 + col0;
#pragma unroll
                for (int bj = 0; bj < 2; ++bj)
#pragma unroll
                    for (int n = 0; n < 2; ++n) { const f32x4 bs = *(const f32x4*)(bp + off + bj * HALF + n * 16);
                        *(f32x4*)(out + off + bj * HALF + n * 16) = bs + gv[bj][n] * acc[ai][bj][m][n]; } }
    }
};
template <class Epi, class Sched, bool ALIGN_EPI = false, bool SP2 = false>
__device__ __forceinline__ void gemm_phase(PG8_LAS unsigned char* lds, const Gemm g, const Sched& S, const Epi& E) {
    int tid_l = threadIdx.x; asm volatile("" : "+v"(tid_l));
    const int tid = tid_l, wid = __builtin_amdgcn_readfirstlane(tid >> 6), lane = tid & 63, wr = wid >> 2, wc = wid & 3, fr = lane & 15, fq = lane >> 4;
    const int K = g.K, nt = K / BK;
    unsigned voffA[2], voffB[2];
#pragma unroll
    for (int i = 0; i < 2; ++i) { int R, C; stage_rc(tid * 16 + i * 8192, R, C); const int Rb = Epi::PERM ? ((R & ~31) + perm32(R & 31)) : R;
        voffA[i] = (unsigned)(R * K + C) * 2u; voffB[i] = (unsigned)(Rb * K + C) * 2u; }
    const size_t kstep = (size_t)(BK * 2);
    const size_t hstep = (size_t)HALF * K * 2;
    const size_t tstep = 2 * hstep;
    const unsigned ldsw = (unsigned)wid * 1024u;
    const int aoff = lds_byte(wr * 64 + fr, fq * 8), boff = lds_byte(wc * 32 + fr, fq * 8);
#define PG8_SA(b, h) (((b) * 2 + (h)) * HTB)
#define PG8_SB(b, h) ((4 + (b) * 2 + (h)) * HTB)
#define PG8_STAGE(bufoff, gbase, voff) do { _Pragma("unroll") for (int _i = 0; _i < 2; ++_i) \
        __builtin_amdgcn_global_load_lds((const unsigned*)((const char*)(gbase) + (voff)[_i]), (PG8_LAS unsigned*)(lds + (bufoff) + ldsw + _i * 8192), 16, 0, 0); } while (0)
#define PG8_LDA(dst, b, h) do { _Pragma("unroll") for (int m = 0; m < 4; ++m) _Pragma("unroll") for (int k = 0; k < 2; ++k) dst[m][k] = *(const PG8_LAS bf16x8*)(lds + PG8_SA(b, h) + aoff + m * 2048 + k * 1024); } while (0)
#define PG8_LDB(dst, b, h) do { _Pragma("unroll") for (int n = 0; n < 2; ++n) _Pragma("unroll") for (int k = 0; k < 2; ++k) dst[n][k] = *(const PG8_LAS bf16x8*)(lds + PG8_SB(b, h) + boff + n * 2048 + k * 1024); } while (0)
#define PG8_MMA(ai, bj, At, Bt) do { __builtin_amdgcn_s_setprio(1); _Pragma("unroll") for (int m = 0; m < 4; ++m) _Pragma("unroll") for (int n = 0; n < 2; ++n) _Pragma("unroll") for (int k = 0; k < 2; ++k) \
        acc[ai][bj][m][n] = __builtin_amdgcn_mfma_f32_16x16x32_bf16(Bt[n][k], At[m][k], acc[ai][bj][m][n], 0, 0, 0); __builtin_amdgcn_s_setprio(0); } while (0)
#define PG8_WAIT_V(n) asm volatile("s_waitcnt vmcnt(" #n ")" ::: "memory")
#define PG8_WAIT_L(n) asm volatile("s_waitcnt lgkmcnt(" #n ")" ::: "memory")
#define PG8_BAR __builtin_amdgcn_s_barrier()
#define PG8_SCHED __builtin_amdgcn_sched_barrier(0)
    Unit cur, nxt; int ui = 0;
    if (!S.next(0, cur)) return;
    f32x4 acc[2][2][4][2];
#pragma unroll
    for (int a = 0; a < 2; ++a)
#pragma unroll
        for (int b = 0; b < 2; ++b)
#pragma unroll
            for (int m = 0; m < 4; ++m)
#pragma unroll
                for (int n = 0; n < 2; ++n) acc[a][b][m][n] = (f32x4){0.f, 0.f, 0.f, 0.f};
    bf16x8 At[4][2], B0[2][2], B1[2][2];
    const char* cA = (const char*)g.A + (size_t)cur.pm * tstep; const char* cB = (const char*)g.Bt + (size_t)cur.pn * tstep;
    S.a_ready(cur);
    if constexpr (SP2) {
        PG8_STAGE(PG8_SB(0, 0), cB, voffB); PG8_STAGE(PG8_SB(0, 1), cB + hstep, voffB); PG8_STAGE(PG8_SA(0, 0), cA, voffA); PG8_STAGE(PG8_SA(0, 1), cA + hstep, voffA);
        if (wr == 1) PG8_BAR;
        PG8_WAIT_V(2); PG8_BAR;
        PG8_STAGE(PG8_SB(1, 0), cB + kstep, voffB); PG8_STAGE(PG8_SA(1, 0), cA + kstep, voffA); PG8_STAGE(PG8_SB(1, 1), cB + hstep + kstep, voffB);
        PG8_WAIT_V(6); PG8_BAR;
    } else {
        PG8_STAGE(PG8_SB(0, 0), cB, voffB); PG8_STAGE(PG8_SA(0, 0), cA, voffA); PG8_STAGE(PG8_SB(0, 1), cB + hstep, voffB); PG8_STAGE(PG8_SA(0, 1), cA + hstep, voffA);
        if (wr == 1) PG8_BAR;
        PG8_WAIT_V(4); PG8_BAR;
        PG8_STAGE(PG8_SB(1, 0), cB + kstep, voffB); PG8_STAGE(PG8_SA(1, 0), cA + kstep, voffA); PG8_STAGE(PG8_SB(1, 1), cB + hstep + kstep, voffB);
        PG8_WAIT_V(6); PG8_BAR;
    }
    for (;;) {
        const bool has_next = S.next(ui + 1, nxt);
        const char* nA = has_next ? (const char*)g.A + (size_t)nxt.pm * tstep : cA; const char* nB = has_next ? (const char*)g.Bt + (size_t)nxt.pn * tstep : cB;
        for (int t = 0; t < nt; t += 2) {
            const bool last = (t == nt - 2);
            const char* a1 = cA + (size_t)(t + 1) * kstep;
            const char* a2 = last ? nA : cA + (size_t)(t + 2) * kstep; const char* b2 = last ? nB : cB + (size_t)(t + 2) * kstep;
            const char* a3 = a2 + kstep; const char* b3 = b2 + kstep;
            if (last && has_next) S.a_ready(nxt);
            if constexpr (SP2) {
            PG8_LDB(B0, 0, 0); PG8_LDB(B1, 0, 1); PG8_SCHED; PG8_LDA(At, 0, 0); PG8_STAGE(PG8_SA(1, 1), a1 + hstep, voffA);
            PG8_WAIT_V(8); PG8_WAIT_L(0); PG8_BAR; PG8_MMA(0, 0, At, B0); PG8_MMA(0, 1, At, B1); PG8_BAR; PG8_SCHED;
            PG8_LDA(At, 0, 1); PG8_STAGE(PG8_SB(0, 0), b2, voffB); PG8_STAGE(PG8_SB(0, 1), b2 + hstep, voffB); PG8_STAGE(PG8_SA(0, 0), a2, voffA);
            PG8_WAIT_V(8); PG8_WAIT_L(0); PG8_BAR; PG8_MMA(1, 0, At, B0); PG8_MMA(1, 1, At, B1); PG8_BAR; PG8_SCHED;
            PG8_LDB(B0, 1, 0); PG8_LDB(B1, 1, 1); PG8_SCHED; PG8_LDA(At, 1, 0); PG8_STAGE(PG8_SA(0, 1), a2 + hstep, voffA);
            PG8_WAIT_V(8); PG8_WAIT_L(0); PG8_BAR; PG8_MMA(0, 0, At, B0); PG8_MMA(0, 1, At, B1); PG8_BAR; PG8_SCHED;
            PG8_LDA(At, 1, 1); PG8_STAGE(PG8_SB(1, 0), b3, voffB); PG8_STAGE(PG8_SB(1, 1), b3 + hstep, voffB); PG8_STAGE(PG8_SA(1, 0), a3, voffA);
            PG8_WAIT_V(8); PG8_WAIT_L(0); PG8_BAR; PG8_MMA(1, 0, At, B0); PG8_MMA(1, 1, At, B1); PG8_BAR; PG8_SCHED;
            } else {
            PG8_LDB(B0, 0, 0); PG8_SCHED; PG8_LDA(At, 0, 0); PG8_STAGE(PG8_SA(1, 1), a1 + hstep, voffA);
            PG8_WAIT_L(8); PG8_BAR; PG8_WAIT_L(0); PG8_MMA(0, 0, At, B0); PG8_BAR; PG8_SCHED;
            PG8_LDB(B1, 0, 1); PG8_STAGE(PG8_SB(0, 0), b2, voffB);
            PG8_BAR; PG8_WAIT_L(0); PG8_MMA(0, 1, At, B1); PG8_BAR;
            PG8_LDA(At, 0, 1); PG8_STAGE(PG8_SA(0, 0), a2, voffA);
            PG8_BAR; PG8_WAIT_L(0); PG8_MMA(1, 0, At, B0); PG8_BAR; PG8_SCHED;
            PG8_STAGE(PG8_SB(0, 1), b2 + hstep, voffB);
            PG8_WAIT_V(6); PG8_BAR; PG8_MMA(1, 1, At, B1); PG8_BAR;
            PG8_LDB(B0, 1, 0); PG8_SCHED; PG8_LDA(At, 1, 0); PG8_STAGE(PG8_SA(0, 1), a2 + hstep, voffA);
            PG8_WAIT_L(8); PG8_BAR; PG8_WAIT_L(0); PG8_MMA(0, 0, At, B0); PG8_BAR; PG8_SCHED;
            PG8_LDB(B1, 1, 1); PG8_STAGE(PG8_SB(1, 0), b3, voffB);
            PG8_BAR; PG8_WAIT_L(0); PG8_MMA(0, 1, At, B1); PG8_BAR;
            PG8_LDA(At, 1, 1); PG8_STAGE(PG8_SA(1, 0), a3, voffA);
            PG8_BAR; PG8_WAIT_L(0); PG8_MMA(1, 0, At, B0); PG8_BAR; PG8_SCHED;
            PG8_STAGE(PG8_SB(1, 1), b3 + hstep, voffB);
            PG8_WAIT_V(6); PG8_BAR; PG8_MMA(1, 1, At, B1); PG8_BAR;
            }
        }
        if constexpr (ALIGN_EPI) { if (wr == 0) PG8_BAR; }
        if constexpr (!Epi::AFTER_DRAIN) { E(acc, cur, wr, wc, fr, fq); S.done(cur); }
        if (!has_next) break;
#pragma unroll
        for (int a = 0; a < 2; ++a)
#pragma unroll
            for (int b = 0; b < 2; ++b)
#pragma unroll
                for (int m = 0; m < 4; ++m)
#pragma unroll
                    for (int n = 0; n < 2; ++n) acc[a][b][m][n] = (f32x4){0.f, 0.f, 0.f, 0.f};
        cur = nxt; cA = nA; cB = nB; ++ui;
        if constexpr (ALIGN_EPI) { if (wr == 1) PG8_BAR; }
    }
    PG8_WAIT_V(0);
    if constexpr (!ALIGN_EPI) { if (wr == 0) PG8_BAR; }
    PG8_BAR;
    if constexpr (Epi::AFTER_DRAIN) { E.fused(acc, cur, wr, wc, fr, fq, lds, wid, lane); S.done(cur); }
#undef PG8_SA
#undef PG8_SB
#undef PG8_STAGE
#undef PG8_LDA
#undef PG8_LDB
#undef PG8_MMA
#undef PG8_WAIT_V
#undef PG8_WAIT_L
#undef PG8_BAR
#undef PG8_SCHED
}
}

#define LAS __attribute__((address_space(3)))
typedef unsigned short bf16;
typedef unsigned u32x4 __attribute__((ext_vector_type(4)));
typedef unsigned u32x2 __attribute__((ext_vector_type(2)));
typedef float f32x4 __attribute__((ext_vector_type(4)));
typedef float f32x2 __attribute__((ext_vector_type(2)));
typedef float f32x16 __attribute__((ext_vector_type(16)));
typedef short bf16x8 __attribute__((ext_vector_type(8)));
using pg8::cvt_pk_bf16; using pg8::bf_lo; using pg8::bf_hi; using pg8::sigm; using pg8::silu_f;

constexpr int DM = 1024, NCOL = 6912, MTOK = 10240, MCTX = 8192;
constexpr int C_CONVA = 0, C_CONVG = 512, C_CGATE = 1024, C_SSMIN = 1536, C_SGATE = 2048, C_Q = 2560, C_K = 3072, C_V = 3200, C_AGATE = 3328, C_MERGE = 3840;
constexpr float EPS = 1e-6f;
constexpr size_t MiB = (size_t)1 << 20;
constexpr size_t WS_CTL = 0, CTL_ZERO_BYTES = 256 * 1024;
constexpr size_t WS_MODS = 4096;
constexpr size_t WS_ROPE = 1 * MiB;
constexpr size_t WS_LAM = 1 * MiB + 64 * 1024;
constexpr size_t WS_BB = 2 * MiB;
constexpr size_t WS_CT = 3 * MiB;
constexpr size_t WS_E = 4 * MiB;
constexpr size_t WS_W = 10 * MiB;
constexpr size_t W_IN_B = (size_t)NCOL * DM * 2, W_GLU_B = (size_t)1024 * 512 * 2, W_BR_B = (size_t)3 * 1024 * 512 * 2, W_OUT_B = (size_t)1024 * 1024 * 2;
constexpr size_t W_LAYER_B = W_IN_B + W_GLU_B + W_BR_B + W_OUT_B;
constexpr size_t WS_H = 50 * MiB;
constexpr size_t WS_ABR = 70 * MiB;
constexpr size_t WS_YB = 100 * MiB;
constexpr size_t WS_MODSP = WS_YB;
constexpr size_t WS_Z = 110 * MiB;
constexpr size_t WS_END = WS_Z + (size_t)MTOK * NCOL * 2;
static_assert(WS_W + 2 * W_LAYER_B <= WS_H && WS_END <= 256 * MiB, "ws map");
constexpr int LDS_BYTES = 147456;

struct Params { const float* in[31]; float* out; unsigned char* ws; };
typedef const __attribute__((address_space(4))) Params* KP;
#define RELOAD_P(P) asm volatile("" : "+s"(P))
enum { I_XP = 0, I_XS, I_CK, I_CV, I_SRE, I_SIM, I_C, I_CCTX, I_NG, I_WADA, I_BADA, I_WIN, I_DWW, I_DWB, I_LNG, I_LNB, I_WCO, I_ARE, I_AIM, I_LDT, I_BRE, I_BIM, I_CRE, I_CIM, I_SD, I_WGLU, I_WSO, I_QG, I_KG, I_WAO, I_WOUT };
constexpr size_t O_Y = 0, O_CK = 10485760, O_CV = 12582912, O_SRE = 14680064, O_SIM = 14942208;

__device__ __forceinline__ float wave_sum(float v) {
#pragma unroll
    for (int o = 1; o < 64; o <<= 1) v += __shfl_xor(v, o);
    return v;
}
__device__ __forceinline__ void unpack8(const u32x4 w, float* f) {
    f[0] = bf_lo(w.x); f[1] = bf_hi(w.x); f[2] = bf_lo(w.y); f[3] = bf_hi(w.y); f[4] = bf_lo(w.z); f[5] = bf_hi(w.z); f[6] = bf_lo(w.w); f[7] = bf_hi(w.w);
}
__device__ __forceinline__ u32x4 pack8(const float* f) {
    u32x4 w; w.x = cvt_pk_bf16(f[0], f[1]); w.y = cvt_pk_bf16(f[2], f[3]); w.z = cvt_pk_bf16(f[4], f[5]); w.w = cvt_pk_bf16(f[6], f[7]); return w;
}
#define MFMA32(a, b, c) __builtin_amdgcn_mfma_f32_32x32x16_bf16((a), (b), (c), 0, 0, 0)
#define MFMA16(a, b, c) __builtin_amdgcn_mfma_f32_16x16x32_bf16((a), (b), (c), 0, 0, 0)

__device__ __forceinline__ void p0_transpose_item(const float* W, int K, int N, bf16* WT, int glu, LAS float* scr, int item, int lane) {
    const int nblk = N / 32, kb = item / nblk, nb = item % nblk, k0 = 64 * kb, n0 = 32 * nb;
    int d0 = n0;
    if (glu) { const int bj = n0 >> 9, rem = n0 & 511; d0 = 256 * (rem >> 7) + 128 * bj + (rem & 127); }
    float wv[32];
    const float* wsrc = W + (size_t)(k0 + (lane >> 5)) * N + n0 + (lane & 31);
#pragma unroll
    for (int i = 0; i < 32; ++i) wv[i] = wsrc[(size_t)(2 * i) * N];
#pragma unroll
    for (int i = 0; i < 32; ++i) scr[(2 * i + (lane >> 5)) * 33 + (lane & 31)] = wv[i];
    asm volatile("s_waitcnt lgkmcnt(0)" ::: "memory");
    const int c = lane & 7;
#pragma unroll
    for (int j = 0; j < 4; ++j) { const int n = (lane >> 3) + 8 * j; const LAS float* s = scr + (8 * c) * 33 + n;
        u32x4 o; o.x = cvt_pk_bf16(s[0 * 33], s[1 * 33]); o.y = cvt_pk_bf16(s[2 * 33], s[3 * 33]); o.z = cvt_pk_bf16(s[4 * 33], s[5 * 33]); o.w = cvt_pk_bf16(s[6 * 33], s[7 * 33]);
        *(u32x4*)(WT + (size_t)(d0 + n) * K + k0 + 8 * c) = o; }
    asm volatile("s_waitcnt lgkmcnt(0)" ::: "memory");
}

#ifndef REP_P0A
#define REP_P0A 1
#endif
__device__ __forceinline__ void convert_weights(KP P, int l, int part, int first_block, LAS unsigned char* lds) {
    RELOAD_P(P);
    asm volatile("" : "+s"(l));
    int tid_ = threadIdx.x; asm volatile("" : "+v"(tid_));
    const int lane = tid_ & 63, wid = __builtin_amdgcn_readfirstlane(tid_ >> 6);
    const int gw = ((int)blockIdx.x - first_block) * 8 + wid, NGW = ((int)gridDim.x - first_block) * 8;
    LAS float* scr = (LAS float*)(lds + wid * 8448);
    constexpr int I_IN = 16 * 216, I_S = 8 * 32, I_O = 16 * 32;
    unsigned char* wl = P->ws + WS_W + (size_t)l * W_LAYER_B;
    if (part == 0) {
        for (int r = gw; r < I_IN; r += NGW) p0_transpose_item(P->in[I_WIN] + (size_t)l * DM * NCOL, DM, NCOL, (bf16*)wl, 0, scr, r, lane);
    } else {
        for (int it = gw; it < 4 * I_S + I_O; it += NGW) {
            int r = it;
            if (r < I_S) { p0_transpose_item(P->in[I_WGLU] + (size_t)l * 512 * 1024, 512, 1024, (bf16*)(wl + W_IN_B), 1, scr, r, lane); continue; } r -= I_S;
            if (r < I_S) { p0_transpose_item(P->in[I_WCO] + (size_t)l * 512 * 1024, 512, 1024, (bf16*)(wl + W_IN_B + W_GLU_B), 0, scr, r, lane); continue; } r -= I_S;
            if (r < I_S) { p0_transpose_item(P->in[I_WSO] + (size_t)l * 512 * 1024, 512, 1024, (bf16*)(wl + W_IN_B + W_GLU_B) + (size_t)1024 * 512, 0, scr, r, lane); continue; } r -= I_S;
            if (r < I_S) { p0_transpose_item(P->in[I_WAO] + (size_t)l * 512 * 1024, 512, 1024, (bf16*)(wl + W_IN_B + W_GLU_B) + (size_t)2048 * 512, 0, scr, r, lane); continue; } r -= I_S;
            p0_transpose_item(P->in[I_WOUT] + (size_t)l * 1024 * 1024, 1024, 1024, (bf16*)(wl + W_IN_B + W_GLU_B + W_BR_B), 0, scr, r, lane);
        }
    }
}
__device__ __forceinline__ bool defer_l1_weights() { return gridDim.x >= 200; }

__device__ __forceinline__ void p0_prologue(KP P, LAS unsigned char* lds, int tid, int lane, int wid) {
    RELOAD_P(P);
    unsigned char* ws = P->ws;
    {
        const int nl = defer_l1_weights() ? 1 : 2;
#pragma unroll 1
        for (int rep0_ = 0; rep0_ < REP_P0A; ++rep0_)
#pragma unroll 1
        for (int lp = 0; lp < 2 * nl; ++lp) convert_weights(P, lp >> 1, lp & 1, 0, lds);
    }
    __syncthreads();
    for (int it = blockIdx.x; it < 209; it += gridDim.x) {
        if (it < 192) {
            const int l = it / 96, n0 = 32 * (it % 96);
            LAS float* sc = (LAS float*)lds;
            LAS float* red = (LAS float*)(lds + 12288);
            __syncthreads();
            for (int i = tid; i < 3072; i += 512) { const int j = i >> 10, k = i & 1023; const float cv = (j == 0) ? P->in[I_CCTX][k] : P->in[I_C][(j - 1) * 1024 + k]; sc[i] = cv / (1.f + __expf(-cv)); }
            __syncthreads();
            const int ks = tid >> 5, col = tid & 31;
            const float* w = P->in[I_WADA] + ((size_t)l * 1024 + ks * 64) * 3072 + n0 + col;
            float a0 = 0.f, a1 = 0.f, a2 = 0.f;
#pragma unroll 16
            for (int k = 0; k < 64; ++k) { const float wv = w[(size_t)k * 3072]; a0 += sc[ks * 64 + k] * wv; a1 += sc[1024 + ks * 64 + k] * wv; a2 += sc[2048 + ks * 64 + k] * wv; }
            red[(ks * 3 + 0) * 32 + col] = a0; red[(ks * 3 + 1) * 32 + col] = a1; red[(ks * 3 + 2) * 32 + col] = a2;
            __syncthreads();
            if (tid < 96) { const int j = tid >> 5, c2 = tid & 31; float sum = P->in[I_BADA][l * 3072 + n0 + c2];
#pragma unroll
                for (int q = 0; q < 16; ++q) sum += red[(q * 3 + j) * 32 + c2];
                ((float*)(ws + WS_MODS))[(l * 3 + j) * 3072 + n0 + c2] = sum; }
        } else if (it < 208) {
            const int idx = (it - 192) * 512 + tid; const int l = idx >> 12, dir = (idx >> 11) & 1, g = (idx >> 6) & 31, p = idx & 63;
            const double are = (double)P->in[I_ARE][idx], aim = (double)P->in[I_AIM][idx], dt = exp((double)P->in[I_LDT][(l * 2 + dir) * 32 + g]);
            const double mag = exp(are * dt), lr = mag * cos(aim * dt), li = mag * sin(aim * dt);
            ((f32x2*)(ws + WS_LAM))[idx] = (f32x2){(float)lr, (float)li};
            const double d2 = are * are + aim * aim, qr = ((lr - 1.0) * are + li * aim) / d2, qi = (li * are - (lr - 1.0) * aim) / d2;
            float bre[16], bim[16];
#pragma unroll
            for (int c = 0; c < 16; ++c) { const double br = (double)P->in[I_BRE][(size_t)idx * 16 + c], bi = (double)P->in[I_BIM][(size_t)idx * 16 + c]; bre[c] = (float)(qr * br - qi * bi); bim[c] = (float)(qr * bi + qi * br); }
            bf16* bb = (bf16*)(ws + WS_BB);
            u32x4* d_re = (u32x4*)(bb + ((size_t)(((l * 2 + dir) * 32 + g) * 2 + 0) * 64 + p) * 16);
            u32x4* d_im = (u32x4*)(bb + ((size_t)(((l * 2 + dir) * 32 + g) * 2 + 1) * 64 + p) * 16);
            d_re[0] = pack8(bre); d_re[1] = pack8(bre + 8); d_im[0] = pack8(bim); d_im[1] = pack8(bim + 8);
            bf16* ct = (bf16*)(ws + WS_CT);
#pragma unroll
            for (int cc = 0; cc < 16; ++cc) { const size_t ci = ((size_t)((l * 2 + dir) * 32 + g) * 16 + cc) * 64 + p;
                const float cre = P->in[I_CRE][ci], cim = P->in[I_CIM][ci];
                *(unsigned*)(ct + ((size_t)(((l * 32 + g) * 2 + dir) * 16 + cc) * 128 + 2 * p)) = cvt_pk_bf16(cre, -cim); }
        } else {
            for (int idx = tid; idx < 1024; idx += 512) { const int pos = idx >> 4, j = idx & 15;
                const double inv = exp(-(double)j / 16.0 * log(10000.0)), ang = (double)pos * inv;
                ((f32x2*)(ws + WS_ROPE))[idx] = (f32x2){(float)cos(ang), (float)sin(ang)}; }
        }
    }
}


__device__ __forceinline__ void p1_rows(KP P, int l, int lane, int wid) {
    RELOAD_P(P);
    const float* mods = (const float*)(P->ws + WS_MODS) + (size_t)l * 3 * 3072;
    const float* ng = P->in[I_NG] + l * DM;
    bf16* H = (bf16*)(P->ws + WS_H);
    const int gw = blockIdx.x * 8 + wid, NGW = gridDim.x * 8;
    for (int m = gw; m < MTOK; m += NGW) {
        const float* xr = (l == 0) ? (m < MCTX ? P->in[I_XP] + (size_t)m * DM : P->in[I_XS] + (size_t)(m - MCTX) * DM) : P->out + (size_t)m * DM;
        const int cond = m < MCTX ? 0 : 1 + ((m - MCTX) >> 10);
        const float* sh = mods + cond * 3072; const float* sc = sh + 1024;
        f32x4 v[4]; float s = 0.f;
#pragma unroll
        for (int j = 0; j < 4; ++j) { v[j] = *(const f32x4*)(xr + 4 * lane + 256 * j); s += (v[j].x * v[j].x + v[j].y * v[j].y) + (v[j].z * v[j].z + v[j].w * v[j].w); }
        const float rstd = rsqrtf(wave_sum(s) * (1.f / DM) + EPS);
#pragma unroll
        for (int j = 0; j < 4; ++j) { const int c = 4 * lane + 256 * j;
            const f32x4 g4 = *(const f32x4*)(ng + c), sc4 = *(const f32x4*)(sc + c), sh4 = *(const f32x4*)(sh + c);
            const f32x4 o = v[j] * rstd * g4 * (sc4 + 1.f) + sh4;
            u32x2 w; w.x = cvt_pk_bf16(o.x, o.y); w.y = cvt_pk_bf16(o.z, o.w);
            *(u32x2*)(H + (size_t)m * DM + c) = w; }
    }
}

constexpr int KS_PITCH = 144, VT_PITCH = 528, VT_OFF = 256 * KS_PITCH;
__device__ __forceinline__ int crow(int r, int hi) { return (r & 3) + 8 * (r >> 2) + 4 * hi; }
__device__ __forceinline__ void attn_item(KP P, int l, int it, LAS unsigned char* lds, int tid, int lane, int wid) {
    RELOAD_P(P);
    asm volatile("" : "+s"(l)); asm volatile("" : "+v"(tid)); lane = tid & 63; wid = __builtin_amdgcn_readfirstlane(tid >> 6);
    const bf16* Z = (const bf16*)(P->ws + WS_Z);
    bf16* OA = (bf16*)(P->ws + WS_ABR) + (size_t)2 * MTOK * 512;
    const f32x2* rope = (const f32x2*)(P->ws + WS_ROPE);
    const bool lat = it < 64;
    int b, kvh, qb;
    if (lat) { b = it >> 5; kvh = (it >> 4) & 1; qb = it & 15; } else { const int j = it - 64; b = j >> 3; kvh = (j >> 2) & 1; qb = j & 3; }
    const int rowbase = lat ? MCTX + b * 1024 : b * 256;
    const int nkt = lat ? 5 : 1;
    const int r32 = lane & 31, hi = lane >> 5;
    const int h = 4 * kvh + (wid & 3);
    const int tq = qb * 64 + 32 * (wid >> 2) + r32;
    const int qrow = rowbase + tq;
    bf16x8 qf[4];
    {
        float qv[4][8]; float ss = 0.f;
        const bf16* zq = Z + (size_t)qrow * NCOL + C_Q + 64 * h + 8 * hi;
#pragma unroll
        for (int d0 = 0; d0 < 4; ++d0) { const u32x4 w = *(const u32x4*)(zq + 16 * d0); unpack8(w, qv[d0]);
#pragma unroll
            for (int i = 0; i < 8; ++i) ss += qv[d0][i] * qv[d0][i]; }
        ss += __shfl_xor(ss, 32);
        const float rs = rsqrtf(ss * (1.f / 64.f) + EPS);
        const float* qg = P->in[I_QG] + l * 64 + 8 * hi;
#pragma unroll
        for (int d0 = 0; d0 < 4; ++d0)
#pragma unroll
            for (int i = 0; i < 8; ++i) qv[d0][i] *= rs * qg[16 * d0 + i];
        if (lat) {
            const int prow = tq >> 6, pcol = tq & 63;
#pragma unroll
            for (int i = 0; i < 8; ++i) { const int j = 8 * hi + i;
                const f32x2 a = rope[prow * 16 + j]; float x1 = qv[0][i], x2 = qv[1][i]; qv[0][i] = x1 * a.x - x2 * a.y; qv[1][i] = x1 * a.y + x2 * a.x;
                const f32x2 c = rope[pcol * 16 + j]; x1 = qv[2][i]; x2 = qv[3][i]; qv[2][i] = x1 * c.x - x2 * c.y; qv[3][i] = x1 * c.y + x2 * c.x; }
        }
        const float qs = 0.125f * 1.4426950408889634f;
#pragma unroll
        for (int d0 = 0; d0 < 4; ++d0) {
#pragma unroll
            for (int i = 0; i < 8; ++i) qv[d0][i] *= qs;
            qf[d0] = __builtin_bit_cast(bf16x8, pack8(qv[d0])); }
    }
    float mrun = -INFINITY, lrun = 0.f;
    f32x16 o0, o1;
#pragma unroll
    for (int r = 0; r < 16; ++r) { o0[r] = 0.f; o1[r] = 0.f; }
    for (int kt = 0; kt < nkt; ++kt) {
        __syncthreads();
        {
            const int key = tid >> 1, half = tid & 1;
            float kx[32];
            const bool from_z = (!lat) || kt < 4;
            if (from_z) {
                const int t = kt * 256 + key;
                const bf16* src = Z + (size_t)(rowbase + t) * NCOL + C_K + 64 * kvh + 32 * half;
                float ss = 0.f;
#pragma unroll
                for (int q = 0; q < 4; ++q) { const u32x4 w = *(const u32x4*)(src + 8 * q); unpack8(w, kx + 8 * q); }
#pragma unroll
                for (int i = 0; i < 32; ++i) ss += kx[i] * kx[i];
                ss += __shfl_xor(ss, 1);
                const float rs = rsqrtf(ss * (1.f / 64.f) + EPS);
                const float* kg = P->in[I_KG] + l * 64 + 32 * half;
#pragma unroll
                for (int i = 0; i < 32; ++i) kx[i] *= rs * kg[i];
                if (!lat && qb == 0) { float* dst = P->out + O_CK + ((size_t)((b * 2 + l) * 256 + key) * 2 + kvh) * 64 + 32 * half;
#pragma unroll
                    for (int q = 0; q < 8; ++q) *(f32x4*)(dst + 4 * q) = (f32x4){kx[4 * q], kx[4 * q + 1], kx[4 * q + 2], kx[4 * q + 3]}; }
                if (lat) { const int pos = half ? (t & 63) : (t >> 6);
#pragma unroll
                    for (int j = 0; j < 16; ++j) { const f32x2 a = rope[pos * 16 + j]; const float x1 = kx[j], x2 = kx[16 + j]; kx[j] = x1 * a.x - x2 * a.y; kx[16 + j] = x1 * a.y + x2 * a.x; } }
            } else {
                const float* src = P->in[I_CK] + ((size_t)((b * 2 + l) * 256 + key) * 2 + kvh) * 64 + 32 * half;
#pragma unroll
                for (int q = 0; q < 8; ++q) { const f32x4 w = *(const f32x4*)(src + 4 * q); kx[4 * q] = w.x; kx[4 * q + 1] = w.y; kx[4 * q + 2] = w.z; kx[4 * q + 3] = w.w; }
            }
            LAS u32x4* kd = (LAS u32x4*)(lds + key * KS_PITCH + 64 * half);
#pragma unroll
            for (int q = 0; q < 4; ++q) kd[q] = pack8(kx + 8 * q);
            if (from_z) {
                const int t = kt * 256 + key;
                const bf16* src = Z + (size_t)(rowbase + t) * NCOL + C_V + 64 * kvh + 32 * half;
#pragma unroll
                for (int q = 0; q < 4; ++q) { const u32x4 w = *(const u32x4*)(src + 8 * q); unpack8(w, kx + 8 * q); }
                if (!lat && qb == 0) { float* dst = P->out + O_CV + ((size_t)((b * 2 + l) * 256 + key) * 2 + kvh) * 64 + 32 * half;
#pragma unroll
                    for (int q = 0; q < 8; ++q) *(f32x4*)(dst + 4 * q) = (f32x4){kx[4 * q], kx[4 * q + 1], kx[4 * q + 2], kx[4 * q + 3]}; }
            } else {
                const float* src = P->in[I_CV] + ((size_t)((b * 2 + l) * 256 + key) * 2 + kvh) * 64 + 32 * half;
#pragma unroll
                for (int q = 0; q < 8; ++q) { const f32x4 w = *(const f32x4*)(src + 4 * q); kx[4 * q] = w.x; kx[4 * q + 1] = w.y; kx[4 * q + 2] = w.z; kx[4 * q + 3] = w.w; }
            }
            const int pos = (key & ~15) | ((key & 4) << 1) | ((key & 8) >> 1) | (key & 3);
            LAS bf16* vd = (LAS bf16*)(lds + VT_OFF + (32 * half) * VT_PITCH + 2 * pos);
#pragma unroll
            for (int i = 0; i < 32; i += 2) { const unsigned w = cvt_pk_bf16(kx[i], kx[i + 1]);
                vd[(size_t)i * (VT_PITCH / 2)] = (bf16)(w & 0xffffu); vd[(size_t)(i + 1) * (VT_PITCH / 2)] = (bf16)(w >> 16); }
        }
        __syncthreads();
#pragma unroll 1
        for (int st = 0; st < 4; ++st) {
            f32x16 p0, p1;
#pragma unroll
            for (int r = 0; r < 16; ++r) { p0[r] = 0.f; p1[r] = 0.f; }
            const LAS unsigned char* kb = lds + (64 * st + r32) * KS_PITCH + 16 * hi;
#pragma unroll
            for (int d0 = 0; d0 < 4; ++d0) {
                const bf16x8 a0 = *(const LAS bf16x8*)(kb + 32 * d0);
                const bf16x8 a1 = *(const LAS bf16x8*)(kb + 32 * KS_PITCH + 32 * d0);
                p0 = MFMA32(a0, qf[d0], p0); p1 = MFMA32(a1, qf[d0], p1);
            }
            float tm = fmaxf(p0[0], p1[0]);
#pragma unroll
            for (int r = 1; r < 16; ++r) tm = fmaxf(tm, fmaxf(p0[r], p1[r]));
            tm = fmaxf(tm, __shfl_xor(tm, 32));
            const float mnew = fmaxf(mrun, tm);
            const float alpha = __builtin_amdgcn_exp2f(mrun - mnew);
            mrun = mnew;
            float ps = 0.f;
#pragma unroll
            for (int r = 0; r < 16; ++r) { p0[r] = __builtin_amdgcn_exp2f(p0[r] - mnew); p1[r] = __builtin_amdgcn_exp2f(p1[r] - mnew); ps += p0[r] + p1[r]; }
            lrun = lrun * alpha + ps;
#pragma unroll
            for (int r = 0; r < 16; ++r) { o0[r] *= alpha; o1[r] *= alpha; }
            bf16x8 pb[4];
            { float t8[8];
#pragma unroll
              for (int J = 0; J < 4; ++J) {
#pragma unroll
                  for (int i = 0; i < 8; ++i) t8[i] = (J < 2) ? p0[8 * (J & 1) + i] : p1[8 * (J & 1) + i];
                  pb[J] = __builtin_bit_cast(bf16x8, pack8(t8)); } }
            const LAS unsigned char* vb = lds + VT_OFF + r32 * VT_PITCH + 2 * (64 * st + 8 * hi);
#pragma unroll
            for (int J = 0; J < 4; ++J) {
                const bf16x8 v0 = *(const LAS bf16x8*)(vb + 32 * J);
                const bf16x8 v1 = *(const LAS bf16x8*)(vb + 32 * VT_PITCH + 32 * J);
                o0 = MFMA32(v0, pb[J], o0); o1 = MFMA32(v1, pb[J], o1);
            }
        }
    }
    lrun += __shfl_xor(lrun, 32);
    const float inv = 1.f / lrun;
    const bf16* zg = Z + (size_t)qrow * NCOL + C_AGATE + 64 * h;
    bf16* od = OA + (size_t)qrow * 512 + 64 * h;
#pragma unroll
    for (int dt = 0; dt < 2; ++dt)
#pragma unroll
        for (int rq = 0; rq < 4; ++rq) { const int d = 32 * dt + 8 * rq + 4 * hi;
            const u32x2 gw = *(const u32x2*)(zg + d);
            float v[4];
#pragma unroll
            for (int i = 0; i < 4; ++i) v[i] = (dt ? o1[4 * rq + i] : o0[4 * rq + i]) * inv;
            v[0] *= silu_f(bf_lo(gw.x)); v[1] *= silu_f(bf_hi(gw.x)); v[2] *= silu_f(bf_lo(gw.y)); v[3] *= silu_f(bf_hi(gw.y));
            u32x2 w; w.x = cvt_pk_bf16(v[0], v[1]); w.y = cvt_pk_bf16(v[2], v[3]);
            *(u32x2*)(od + d) = w; }
}

__device__ __forceinline__ float fsigm(float x) { return __builtin_amdgcn_rcpf(1.f + __builtin_amdgcn_exp2f(-1.4426950408889634f * x)); }
__device__ __forceinline__ void conv_item(KP P, int l, int it, LAS unsigned char* lds, int tid, int lane, int wid) {
    RELOAD_P(P);
    asm volatile("" : "+s"(l)); asm volatile("" : "+v"(tid)); lane = tid & 63; wid = __builtin_amdgcn_readfirstlane(tid >> 6);
    const bf16* Z = (const bf16*)(P->ws + WS_Z);
    bf16* YA = (bf16*)(P->ws + WS_ABR);
    int rowbase, L, t0;
    if (it < 512) { rowbase = (it >> 4) * 256; L = 256; t0 = 16 * (it & 15); } else { const int j = it - 512; rowbase = MCTX + (j >> 6) * 1024; L = 1024; t0 = 16 * (j & 63); }
    LAS float* yb = (LAS float*)lds;
    LAS float* sb = (LAS float*)(lds + 47 * 512 * 4);
    LAS float* st = (LAS float*)(lds + 47 * 512 * 4 + 16 * 516 * 4);
    u32x4 la[6], lg[6];
#pragma unroll
    for (int i = 0; i < 6; ++i) {
        const int e = tid + 512 * i, rr = e >> 6, ch = e & 63, t = t0 - 15 + rr;
        la[i] = (u32x4){0u, 0u, 0u, 0u}; lg[i] = (u32x4){0u, 0u, 0u, 0u};
        if (rr < 47 && t >= 0 && t < L) { const bf16* src = Z + (size_t)(rowbase + t) * NCOL + 8 * ch; la[i] = *(const u32x4*)(src + C_CONVA); lg[i] = *(const u32x4*)(src + C_CONVG); }
    }
    const int c = tid;
    float w[32];
    const float* wp = P->in[I_DWW] + (size_t)l * 31 * 512 + c;
#pragma unroll
    for (int k = 0; k < 31; ++k) w[k] = wp[k * 512];
    w[31] = 0.f;
    const float bias = P->in[I_DWB][l * 512 + c], lgam = P->in[I_LNG][l * 512 + c], lbet = P->in[I_LNB][l * 512 + c];
    bf16 gt[16];
#pragma unroll
    for (int t = 0; t < 16; ++t) gt[t] = Z[(size_t)(rowbase + t0 + t) * NCOL + C_CGATE + c];
#pragma unroll
    for (int i = 0; i < 6; ++i) {
        const int e = tid + 512 * i, rr = e >> 6, ch = e & 63;
        if (rr < 47) {
            float a[8], g[8]; unpack8(la[i], a); unpack8(lg[i], g);
#pragma unroll
            for (int q = 0; q < 8; ++q) a[q] *= fsigm(g[q]);
            LAS f32x4* d = (LAS f32x4*)(yb + rr * 512 + 8 * ch);
            d[0] = (f32x4){a[0], a[1], a[2], a[3]}; d[1] = (f32x4){a[4], a[5], a[6], a[7]};
        }
    }
    __syncthreads();
    float acc[16];
#pragma unroll
    for (int t = 0; t < 16; ++t) acc[t] = bias;
#pragma unroll
    for (int kb = 0; kb < 32; kb += 8) {
        const LAS float* yp = yb + kb * 512 + c;
        float rows[23];
#pragma unroll
        for (int j = 0; j < 23; ++j) rows[j] = yp[j * 512];
#pragma unroll
        for (int t = 0; t < 16; ++t)
#pragma unroll
            for (int i = 0; i < 8; ++i) acc[t] += w[kb + i] * rows[t + i];
    }
#pragma unroll
    for (int t = 0; t < 16; ++t) sb[t * 516 + c] = acc[t];
    __syncthreads();
    {
        const int t = tid >> 5, j = tid & 31;
        const LAS f32x4* q = (const LAS f32x4*)(sb + t * 516 + 16 * j);
        float s1 = 0.f, s2 = 0.f;
#pragma unroll
        for (int i = 0; i < 4; ++i) { const f32x4 v = q[i]; s1 += (v.x + v.y) + (v.z + v.w); s2 += (v.x * v.x + v.y * v.y) + (v.z * v.z + v.w * v.w); }
#pragma unroll
        for (int o = 1; o < 32; o <<= 1) { s1 += __shfl_xor(s1, o); s2 += __shfl_xor(s2, o); }
        if (j == 0) { const float mean = s1 * (1.f / 512.f); const float var = fmaxf(s2 * (1.f / 512.f) - mean * mean, 0.f); st[2 * t] = mean; st[2 * t + 1] = rsqrtf(var + EPS); }
    }
    __syncthreads();
#pragma unroll
    for (int t = 0; t < 16; ++t) {
        const float y = (acc[t] - st[2 * t]) * st[2 * t + 1] * lgam + lbet;
        const float gate = __uint_as_float((unsigned)gt[t] << 16);
        const float o = (y * fsigm(y)) * (gate * fsigm(gate));
        YA[(size_t)(rowbase + t0 + t) * 512 + c] = (bf16)(cvt_pk_bf16(o, o) & 0xffffu);
    }
}

constexpr int HS_PITCH = 272, HS_S = 16 * HS_PITCH, HS_WAVE = 2 * HS_S;
struct SsmIdx { int lat, b, rg, go, NR; };
__device__ __forceinline__ SsmIdx ssm_decode(int it) {
    SsmIdx s;
    if (it < 512) { s.lat = 0; s.b = it >> 4; s.rg = (it >> 2) & 3; s.go = it & 3; s.NR = 4; }
    else { const int j = it - 512; s.lat = 1; s.b = j >> 6; s.rg = (j >> 2) & 15; s.go = j & 3; s.NR = 16; }
    return s;
}
#define CMUL_ADD(hr, hi_, lr, li, br, bi) do { const float _tr = __builtin_fmaf(-(li), (hi_), (br)), _ti = __builtin_fmaf((li), (hr), (bi)); const float _nr = __builtin_fmaf((lr), (hr), _tr), _ni = __builtin_fmaf((lr), (hi_), _ti); (hr) = _nr; (hi_) = _ni; } while (0)

template <int PASS>
__device__ __forceinline__ void ssm_item(KP P, int l, int it, LAS unsigned char* lds, int tid, int lane, int wid, int gsel) {
    RELOAD_P(P);
    asm volatile("" : "+s"(l)); asm volatile("" : "+v"(tid)); lane = tid & 63; wid = __builtin_amdgcn_readfirstlane(tid >> 6);
    const bf16* Z = (const bf16*)(P->ws + WS_Z);
    const SsmIdx S = ssm_decode(it);
    const int g = 8 * S.go + gsel;
    const int r32 = lane & 31, hi = lane >> 5;
    const int rb = S.lat ? MCTX + S.b * 1024 : S.b * 256;
    const int kA = (r32 & 3) + 4 * (r32 >> 3);
    const int t_start = 64 * S.rg;
    const int sr_base = S.lat ? 128 + S.b * 16 : S.b * 4;
    const bf16* zu = Z + (size_t)(rb + t_start + kA) * NCOL + C_SSMIN + 16 * g + 8 * hi;
    bf16x8 uf[4];
    if (PASS == 2) {
#pragma unroll
        for (int j = 0; j < 4; ++j) uf[j] = __builtin_bit_cast(bf16x8, *(const u32x4*)(zu + (size_t)(16 * j) * NCOL));
    }
    f32x2* E = (f32x2*)(P->ws + WS_E);
    const f32x2* LAM = (const f32x2*)(P->ws + WS_LAM);
    const bf16* BB = (const bf16*)(P->ws + WS_BB);
    const bf16* CT = (const bf16*)(P->ws + WS_CT);
    LAS unsigned char* hs = lds + wid * HS_WAVE;
    f32x4 yacc[4];
    if (PASS == 2) {
#pragma unroll
        for (int j = 0; j < 4; ++j) yacc[j] = (f32x4){0.f, 0.f, 0.f, 0.f};
    }
#pragma unroll
    for (int dir = 0; dir < 2; ++dir) {
        const int ldg = (l * 2 + dir) * 32 + g;
        bf16x8 bfr[2][2];
        f32x2 lam[2];
#pragma unroll
        for (int pt = 0; pt < 2; ++pt) {
            lam[pt] = LAM[(size_t)ldg * 64 + 32 * pt + r32];
#pragma unroll
            for (int ri = 0; ri < 2; ++ri) bfr[pt][ri] = __builtin_bit_cast(bf16x8, *(const u32x4*)(BB + ((size_t)(ldg * 2 + ri) * 64 + 32 * pt + r32) * 16 + 8 * hi));
        }
        float hr[2], hm[2];
        bf16x8 ctf[4];
        if (PASS == 1) { hr[0] = hr[1] = hm[0] = hm[1] = 0.f; }
        else {
            const int q4 = lane >> 4, cc = lane & 15;
#pragma unroll
            for (int kk = 0; kk < 4; ++kk) ctf[kk] = __builtin_bit_cast(bf16x8, *(const u32x4*)(CT + ((size_t)((l * 32 + g) * 2 + dir) * 16 + cc) * 128 + 32 * kk + 8 * q4));
#pragma unroll
            for (int pt = 0; pt < 2; ++pt) {
                float l64r = lam[pt].x, l64i = lam[pt].y;
#pragma unroll
                for (int q = 0; q < 6; ++q) { const float nr = l64r * l64r - l64i * l64i, ni = 2.f * l64r * l64i; l64r = nr; l64i = ni; }
                float cr = 0.f, ci = 0.f;
                if (S.lat) { const size_t si = ((size_t)((S.b * 2 + l) * 2 + dir) * 32 + g) * 64 + 32 * pt + r32; cr = P->in[I_SRE][si]; ci = P->in[I_SIM][si]; }
                {
                    const int n_it = dir == 0 ? S.rg : S.NR - 1 - S.rg;
                    const f32x2* Eb = E + ((size_t)(sr_base * 32 + g) * 2 + dir) * 64 + 32 * pt + r32;
                    for (int i0 = 0; i0 < n_it; i0 += 4) {
                        f32x2 e4[4];
#pragma unroll
                        for (int k = 0; k < 4; ++k) { const int i = min(i0 + k, n_it - 1); const int ri = dir == 0 ? i : S.NR - 1 - i; e4[k] = Eb[(size_t)ri * 4096]; }
#pragma unroll
                        for (int k = 0; k < 4; ++k) { const bool ok = i0 + k < n_it; const float nr = __builtin_fmaf(l64r, cr, __builtin_fmaf(-l64i, ci, e4[k].x)), ni = __builtin_fmaf(l64r, ci, __builtin_fmaf(l64i, cr, e4[k].y)); cr = ok ? nr : cr; ci = ok ? ni : ci; }
                    }
                }
                hr[pt] = cr; hm[pt] = ci;
            }
        }
#pragma unroll (PASS == 2 ? 4 : 1)
        for (int jj = 0; jj < 4; ++jj) {
            const int j = dir ? 3 - jj : jj;
            bf16x8 ufj;
            if (PASS == 2) ufj = uf[j]; else ufj = __builtin_bit_cast(bf16x8, *(const u32x4*)(zu + (size_t)(16 * j) * NCOL));
            const f32x16 zero16 = (f32x16){0.f, 0.f, 0.f, 0.f, 0.f, 0.f, 0.f, 0.f, 0.f, 0.f, 0.f, 0.f, 0.f, 0.f, 0.f, 0.f};
#pragma unroll
            for (int pt = 0; pt < 2; ++pt) {
                const f32x16 are = MFMA32(ufj, bfr[pt][0], zero16);
                const f32x16 aim = MFMA32(ufj, bfr[pt][1], zero16);
                LAS unsigned* hw = (LAS unsigned*)(hs + hi * HS_S + 4 * (32 * pt + r32));
#pragma unroll
                for (int rr = 0; rr < 16; ++rr) { const int r = dir ? 15 - rr : rr;
                    CMUL_ADD(hr[pt], hm[pt], lam[pt].x, lam[pt].y, are[r], aim[r]);
                    if (PASS == 2) hw[r * (HS_PITCH / 4)] = cvt_pk_bf16(hr[pt], hm[pt]); }
                __builtin_amdgcn_sched_barrier(0);
            }
            if (PASS == 2) {
                const int q4 = lane >> 4, n = lane & 15;
#pragma unroll
                for (int kk = 0; kk < 4; ++kk) { const bf16x8 hb = *(const LAS bf16x8*)(hs + n * HS_PITCH + 64 * kk + 16 * q4);
                    yacc[j] = MFMA16(ctf[kk], hb, yacc[j]); }
            }
        }
        if (hi == 0) {
            if (PASS == 1) {
#pragma unroll
                for (int pt = 0; pt < 2; ++pt) E[((size_t)((sr_base + S.rg) * 32 + g) * 2 + dir) * 64 + 32 * pt + r32] = (f32x2){hr[pt], hm[pt]};
            } else if (!S.lat && ((dir == 0 && S.rg == 3) || (dir == 1 && S.rg == 0))) {
#pragma unroll
                for (int pt = 0; pt < 2; ++pt) { const size_t oi = ((size_t)((S.b * 2 + l) * 2 + dir) * 32 + g) * 64 + 32 * pt + r32;
                    P->out[O_SRE + oi] = hr[pt]; P->out[O_SIM + oi] = hm[pt]; }
            }
        }
    }
    if (PASS == 2) {
        bf16* YB = (bf16*)(P->ws + WS_YB);
        const int q4 = lane >> 4, n = lane & 15;
        const f32x4 dv = *(const f32x4*)(P->in[I_SD] + l * 512 + 16 * g + 4 * q4);
#pragma unroll
        for (int j = 0; j < 4; ++j) {
            const size_t row = (size_t)(rb + t_start + 16 * j + n);
            const u32x2 uw = *(const u32x2*)(Z + row * NCOL + C_SSMIN + 16 * g + 4 * q4);
            float y[4];
            y[0] = yacc[j][0] + dv.x * bf_lo(uw.x); y[1] = yacc[j][1] + dv.y * bf_hi(uw.x); y[2] = yacc[j][2] + dv.z * bf_lo(uw.y); y[3] = yacc[j][3] + dv.w * bf_hi(uw.y);
#pragma unroll
            for (int i = 0; i < 4; ++i) { const float x = y[i]; y[i] = x * sigm(1.5957691216057308f * (x + 0.044715f * x * x * x)); }
            u32x2 w; w.x = cvt_pk_bf16(y[0], y[1]); w.y = cvt_pk_bf16(y[2], y[3]);
            *(u32x2*)(YB + row * 512 + 16 * g + 4 * q4) = w;
        }
    }
}

#ifdef DBG_NAIVE_STATE
__device__ __forceinline__ void naive_state_item(KP P, int l, int it, int tid) {
    RELOAD_P(P);
    asm volatile("" : "+s"(l)); asm volatile("" : "+v"(tid));
    const bf16* Z = (const bf16*)(P->ws + WS_Z);
    const int idx = it * 512 + tid; const int p = idx & 63, g = (idx >> 6) & 31, dir = (idx >> 11) & 1, b = idx >> 12;
    const int ti = ((l * 2 + dir) * 32 + g) * 64 + p;
    const float are = P->in[I_ARE][ti], aim = P->in[I_AIM][ti];
    const f32x2 lmb = ((const f32x2*)(P->ws + WS_LAM))[ti];
    const float lr = lmb.x, li = lmb.y;
    const float d2 = are * are + aim * aim, qr = ((lr - 1.0f) * are + li * aim) / d2, qi = (li * are - (lr - 1.0f) * aim) / d2;
    float bre[16], bim[16];
#pragma unroll
    for (int c = 0; c < 16; ++c) { const float br = P->in[I_BRE][(size_t)ti * 16 + c], bi = P->in[I_BIM][(size_t)ti * 16 + c]; bre[c] = qr * br - qi * bi; bim[c] = qr * bi + qi * br;
#ifdef DBG_BF16_B
        { const unsigned w = cvt_pk_bf16(bre[c], bim[c]); bre[c] = bf_lo(w); bim[c] = bf_hi(w); }
#endif
#ifdef DBG_USE_BB
        { const bf16* BBt = (const bf16*)(P->ws + WS_BB); const int ldg_ = (l * 2 + dir) * 32 + g;
          bre[c] = __uint_as_float((unsigned)BBt[((size_t)(ldg_ * 2 + 0) * 64 + p) * 16 + c] << 16); bim[c] = __uint_as_float((unsigned)BBt[((size_t)(ldg_ * 2 + 1) * 64 + p) * 16 + c] << 16); }
#endif
    }
    float hr = 0.f, hm = 0.f;
#pragma unroll 1
    for (int tt = 0; tt < 256; ++tt) {
        const int t = dir ? 255 - tt : tt;
        const bf16* src = Z + (size_t)(b * 256 + t) * NCOL + C_SSMIN + 16 * g;
        float u[16]; unpack8(*(const u32x4*)src, u); unpack8(*(const u32x4*)(src + 8), u + 8);
        float br = 0.f, bi = 0.f;
#pragma unroll
        for (int c = 0; c < 16; ++c) { br += bre[c] * u[c]; bi += bim[c] * u[c]; }
        CMUL_ADD(hr, hm, lr, li, br, bi);
    }
    const size_t oi = ((size_t)((b * 2 + l) * 2 + dir) * 32 + g) * 64 + p;
#if defined(DBG_SPLIT_HI) && defined(DBG_SWAP)
    if ((b & 1) == DBG_SPLIT_HI)
#elif defined(DBG_SPLIT_HI)
    if ((b & 1) != DBG_SPLIT_HI)
#endif
    { P->out[O_SRE + oi] = hr; P->out[O_SIM + oi] = hm; }
}
#endif

__device__ __forceinline__ void state_item(KP P, int l, int it, int tid, int lane, int wid) {
    RELOAD_P(P);
    asm volatile("" : "+s"(l)); asm volatile("" : "+v"(tid)); lane = tid & 63; wid = __builtin_amdgcn_readfirstlane(tid >> 6);
    const bf16* Z = (const bf16*)(P->ws + WS_Z);
    const int w = __builtin_amdgcn_readfirstlane(it * 8 + wid);
    const int g = w & 31, dir = (w >> 5) & 1, b = w >> 6;
    const int r32 = lane & 31, hi = lane >> 5;
    const int kA = (r32 & 3) + 4 * (r32 >> 3);
    const int ldg = (l * 2 + dir) * 32 + g;
    const f32x2* LAM = (const f32x2*)(P->ws + WS_LAM);
    const bf16* BB = (const bf16*)(P->ws + WS_BB);
    bf16x8 bfr[2][2]; f32x2 lam[2]; float hr[2] = {0.f, 0.f}, hm[2] = {0.f, 0.f};
#pragma unroll
    for (int pt = 0; pt < 2; ++pt) {
        lam[pt] = LAM[(size_t)ldg * 64 + 32 * pt + r32];
#pragma unroll
        for (int ri = 0; ri < 2; ++ri) bfr[pt][ri] = __builtin_bit_cast(bf16x8, *(const u32x4*)(BB + ((size_t)(ldg * 2 + ri) * 64 + 32 * pt + r32) * 16 + 8 * hi));
    }
    const bf16* zb = Z + (size_t)(b * 256 + kA) * NCOL + C_SSMIN + 16 * g + 8 * hi;
    const f32x16 z16 = (f32x16){0.f, 0.f, 0.f, 0.f, 0.f, 0.f, 0.f, 0.f, 0.f, 0.f, 0.f, 0.f, 0.f, 0.f, 0.f, 0.f};
#pragma unroll 1
    for (int q = 0; q < 16; q += 2) {
        const int j0 = dir ? 15 - q : q, j1 = dir ? 14 - q : q + 1;
        const bf16x8 u0 = __builtin_bit_cast(bf16x8, *(const u32x4*)(zb + (size_t)(16 * j0) * NCOL));
        const bf16x8 u1 = __builtin_bit_cast(bf16x8, *(const u32x4*)(zb + (size_t)(16 * j1) * NCOL));
#pragma unroll
        for (int half = 0; half < 2; ++half) {
            const bf16x8 ux = half ? u1 : u0;
#pragma unroll
            for (int pt = 0; pt < 2; ++pt) {
                const f32x16 xr = MFMA32(ux, bfr[pt][0], z16);
                const f32x16 xi = MFMA32(ux, bfr[pt][1], z16);
                if (dir == 0) {
#pragma unroll
                    for (int r = 0; r < 16; ++r) CMUL_ADD(hr[pt], hm[pt], lam[pt].x, lam[pt].y, xr[r], xi[r]);
                } else {
#pragma unroll
                    for (int r = 15; r >= 0; --r) CMUL_ADD(hr[pt], hm[pt], lam[pt].x, lam[pt].y, xr[r], xi[r]);
                }
            }
        }
    }
    if (hi == 0) {
#pragma unroll
        for (int pt = 0; pt < 2; ++pt) { const size_t oi = ((size_t)((b * 2 + l) * 2 + dir) * 32 + g) * 64 + 32 * pt + r32;
            P->out[O_SRE + oi] = hr[pt]; P->out[O_SIM + oi] = hm[pt]; }
    }
}
#define XB_TMO      128
#define XB_XCNT(j)  (256  + 64 * (j))
#define XB_XSUB(j)  (1280 + 64 * (j))
#define XB_XGEN(j)  (2304 + 64 * (j))
#define XB_TOP      3328
#define XB_TOPGEN   3392
#define XCD_BAR_WORDS 3456
#define XB_SPIN_CAP (1u << 18)

__device__ __forceinline__ unsigned xb_ld(unsigned* p)              { return __hip_atomic_load(p, __ATOMIC_RELAXED, __HIP_MEMORY_SCOPE_AGENT); }
__device__ __forceinline__ unsigned xb_add(unsigned* p, unsigned v) { return __hip_atomic_fetch_add(p, v, __ATOMIC_RELAXED, __HIP_MEMORY_SCOPE_AGENT); }
__device__ __forceinline__ unsigned xb_xcc_id() { return (unsigned)__builtin_amdgcn_s_getreg((3 << 11) | 20) & 0xFu; }
#define XB_SPIN(cond, bar) do { unsigned _sp = 0; while (cond) { __builtin_amdgcn_s_sleep(1); \
    if ((++_sp & 255u) == 0u) { if (xb_ld(&(bar)[XB_TMO])) break; if (_sp > XB_SPIN_CAP) { atomicAdd(&(bar)[XB_TMO], 1u); break; } } } } while (0)

struct XcdBarrier {
    unsigned* bar; unsigned x;
    volatile LAS unsigned* st;
};

__device__ __forceinline__ XcdBarrier xcd_barrier_post(unsigned* bar, volatile LAS unsigned* st) {
    XcdBarrier b; b.bar = bar; b.x = xb_xcc_id(); b.st = st;
    if (threadIdx.x == 0) (void)xb_add(&bar[XB_XCNT(b.x)], 1u);
    return b;
}
__device__ __forceinline__ void xcd_barrier_complete(unsigned* bar, unsigned x, unsigned& nloc, unsigned& nx) {
    const unsigned G = gridDim.x * gridDim.y * gridDim.z;
    unsigned sum, cnt, mine, sp = 0u;
    for (;;) {
        sum = 0u; cnt = 0u; mine = 0u;
#pragma unroll
        for (unsigned j = 0; j < 16; ++j) { const unsigned c = xb_ld(&bar[XB_XCNT(j)]); sum += c; cnt += (c > 0u) ? 1u : 0u; mine = (j == x) ? c : mine; }
        if (sum == G) break;
        __builtin_amdgcn_s_sleep(1);
        if ((++sp & 255u) == 0u) { if (xb_ld(&bar[XB_TMO])) break; if (sp > XB_SPIN_CAP) { atomicAdd(&bar[XB_TMO], 1u); break; } }
    }
    nloc = mine > 0u ? mine : 1u; nx = cnt > 0u ? cnt : 1u;
}

__device__ __forceinline__ void xcd_barrier(const XcdBarrier& b) {
    asm volatile("s_waitcnt vmcnt(0)" ::: "memory");
    __syncthreads();
    if (threadIdx.x == 0) {
        unsigned* bar = b.bar;
        __builtin_amdgcn_s_waitcnt(0);
        unsigned nloc = b.st[0], nx = b.st[1];
        if (nloc == 0u) { xcd_barrier_complete(bar, b.x, nloc, nx); b.st[0] = nloc; b.st[1] = nx; }
        const unsigned old = xb_add(&bar[XB_XSUB(b.x)], 1u);
        const unsigned gen = old / nloc;
        if (old + 1u == (gen + 1u) * nloc) {
            __builtin_amdgcn_fence(__ATOMIC_RELEASE, "agent");
            asm volatile("s_waitcnt vmcnt(0)" ::: "memory");
            const unsigned og = xb_add(&bar[XB_TOP], 1u);
            const unsigned tg = og / nx;
            if (og + 1u == (tg + 1u) * nx) xb_add(&bar[XB_TOPGEN], 1u);
            else XB_SPIN(xb_ld(&bar[XB_TOPGEN]) == tg, bar);
            __builtin_amdgcn_fence(__ATOMIC_ACQUIRE, "agent");
            xb_add(&bar[XB_XGEN(b.x)], 1u);
            asm volatile("s_waitcnt vmcnt(0)" ::: "memory");
        } else {
            XB_SPIN(xb_ld(&bar[XB_XGEN(b.x)]) == gen, bar);
            __builtin_amdgcn_fence(__ATOMIC_ACQUIRE, "agent");
            asm volatile("s_waitcnt vmcnt(0)" ::: "memory");
        }
    }
    __syncthreads();
}


constexpr int CW_XBAR = 32768;
#ifndef REP_SYNC
#define REP_SYNC 1
#endif
#ifndef REP_ATT
#define REP_ATT 1
#endif
#ifndef REP_SSM1
#define REP_SSM1 1
#endif
#ifndef REP_CONV
#define REP_CONV 1
#endif
#ifndef REP_P2
#define REP_P2 1
#endif
#ifndef REP_P3
#define REP_P3 1
#endif
#ifndef REP_P4
#define REP_P4 1
#endif
#ifndef REP_P56
#define REP_P56 1
#endif
__device__ __forceinline__ void grid_sync_all(cg::grid_group& grid) {
    asm volatile("s_waitcnt vmcnt(0) lgkmcnt(0)" ::: "memory");
    grid.sync();
    __builtin_amdgcn_fence(__ATOMIC_ACQUIRE, "agent");
    asm volatile("s_waitcnt vmcnt(0)" ::: "memory");
}
__device__ __forceinline__ int q_next(unsigned* ctr, LAS int* slot, int tid) {
    __syncthreads();
    if (tid == 0) *slot = (int)atomicAdd(ctr, 1u);
    __syncthreads();
    return *slot;
}

__global__ void __launch_bounds__(512, 2) fwd_kernel(Params Pk_unused) {
    KP P = (KP)__builtin_amdgcn_kernarg_segment_ptr();
    extern __shared__ __attribute__((aligned(16))) unsigned char lds_raw[];
    cg::grid_group grid = cg::this_grid();
    LAS unsigned char* lds = (LAS unsigned char*)lds_raw;
    LAS int* qslot = (LAS int*)(lds + 131072 + 1024);
    const int tid = threadIdx.x, lane = tid & 63, wid = __builtin_amdgcn_readfirstlane(tid >> 6);
    volatile LAS unsigned* xst = (volatile LAS unsigned*)(lds + 131072 + 2048);
    if (tid < 2) xst[tid] = 0u;
    __syncthreads();
    const XcdBarrier xbar = xcd_barrier_post((unsigned*)(P->ws + WS_CTL) + CW_XBAR, xst);

#ifndef REP_P0
#define REP_P0 1
#endif
    for (int r0_ = 0; r0_ < REP_P0; ++r0_) { if (r0_) __syncthreads(); p0_prologue(P, lds, tid, lane, wid); }
    for (int rs_ = 0; rs_ < REP_SYNC; ++rs_) xcd_barrier(xbar);
    if (xb_ld(&xbar.bar[XB_TMO]) != 0u) grid.sync();

#pragma unroll 1
    for (int l = 0; l < 2; ++l) {
#ifndef REP_P1
#define REP_P1 1
#endif
        for (int r1_ = 0; r1_ < REP_P1; ++r1_) p1_rows(P, l, lane, wid);
        for (int rs_ = 0; rs_ < REP_SYNC; ++rs_) xcd_barrier(xbar);
#ifndef NO_P2
#pragma unroll 1
        for (int rep_ = 0; rep_ < REP_P2; ++rep_) {
            RELOAD_P(P); unsigned char* ws = P->ws; const unsigned char* wl = ws + WS_W + (size_t)l * W_LAYER_B; bf16* Z = (bf16*)(ws + WS_Z); unsigned* ctl = (unsigned*)(ws + WS_CTL); (void)wl; (void)Z; (void)ctl;
            pg8::Gemm g{(const bf16*)(ws + WS_H), (const bf16*)wl, MTOK, NCOL, DM};
            pg8::WinOrder S{(int)gridDim.x, (int)blockIdx.x};
            pg8::EpiPlain E{Z, NCOL};
            pg8::gemm_phase<pg8::EpiPlain, pg8::WinOrder, true, true>(lds, g, S, E);
        }
#endif
        for (int rs_ = 0; rs_ < REP_SYNC; ++rs_) xcd_barrier(xbar);
#ifndef NO_P3
#pragma unroll 1
        for (int rep_ = 0; rep_ < REP_P3; ++rep_) {
            RELOAD_P(P); unsigned char* ws = P->ws; const unsigned char* wl = ws + WS_W + (size_t)l * W_LAYER_B; bf16* Z = (bf16*)(ws + WS_Z); unsigned* ctl = (unsigned*)(ws + WS_CTL); (void)wl; (void)Z; (void)ctl;
            unsigned* ctr = ctl + 64 * (1 + 2 * l) + 320 * rep_;
            unsigned pre0 = 0u; if (tid == 0) pre0 = atomicAdd(ctr, 1u);
            if (gridDim.x == 256) {
#pragma unroll 1
                for (int k = 0; k < 3; ++k) {
                    int item, gs;
                    if (k < 2) { item = (int)blockIdx.x + 256 * k; gs = wid; }
                    else { if (wid >= 4) break; item = 512 + ((int)blockIdx.x >> 1); gs = ((int)blockIdx.x & 1) * 4 + wid; }
                    ssm_item<1>(P, l, item, lds, tid, lane, wid, gs);
                }
            } else {
                for (int item = (int)blockIdx.x; item < 640; item += (int)gridDim.x) ssm_item<1>(P, l, item, lds, tid, lane, wid, wid);
            }
            for (bool first = true;; first = false) {
                int it;
                if (first) { __syncthreads(); if (tid == 0) *qslot = (int)pre0; __syncthreads(); it = *qslot; } else it = q_next(ctr, qslot, tid);
                if (it >= 1016) break;
                if (it < 64 || (it >= 760 && it < 1016)) {
                    const int ia = it < 64 ? it : it - 696;
                    for (int ra_ = 0; ra_ < REP_ATT; ++ra_) { if (ra_) __syncthreads(); attn_item(P, l, ia, lds, tid, lane, wid); }
                } else if (it < 120) {
                    pg8::Gemm g{(const bf16*)(ws + WS_H), (const bf16*)wl, MTOK, NCOL, DM};
                    pg8::OneUnit S1{1024 + (it - 64)};
                    pg8::EpiPlain E{Z, NCOL};
                    pg8::gemm_phase<pg8::EpiPlain, pg8::OneUnit, true, true>(lds, g, S1, E);
                } else {
                    for (int ra_ = 0; ra_ < REP_CONV; ++ra_) { if (ra_) __syncthreads(); conv_item(P, l, it - 120, lds, tid, lane, wid); }
                }
            }
        }
#endif
        for (int rs_ = 0; rs_ < REP_SYNC; ++rs_) xcd_barrier(xbar);
#ifndef NO_P4
#pragma unroll 1
        for (int rep_ = 0; rep_ < REP_P4; ++rep_) {
            RELOAD_P(P); unsigned char* ws = P->ws; const unsigned char* wl = ws + WS_W + (size_t)l * W_LAYER_B; bf16* Z = (bf16*)(ws + WS_Z); unsigned* ctl = (unsigned*)(ws + WS_CTL); (void)wl; (void)Z; (void)ctl;
            unsigned* ctr = ctl + 64 * (2 + 2 * l) + 320 * rep_;
            (void)ctr;
            if (gridDim.x == 256) {
#pragma unroll 1
                for (int k = 0; k < 3; ++k) {
                    int item, gs;
                    if (k < 2) { item = (int)blockIdx.x + 256 * k; gs = wid; }
                    else { if (wid >= 4) break; item = 512 + ((int)blockIdx.x >> 1); gs = ((int)blockIdx.x & 1) * 4 + wid; }
                    const int it2 = item < 128 ? 512 + item : item - 128;
                    ssm_item<2>(P, l, it2, lds, tid, lane, wid, gs);
                }
            } else {
                for (int item = (int)blockIdx.x; item < 640; item += (int)gridDim.x) { const int it2 = item < 128 ? 512 + item : item - 128; ssm_item<2>(P, l, it2, lds, tid, lane, wid, wid); }
            }
#ifdef DBG_NAIVE_STATE
#pragma unroll 1
            for (int it = blockIdx.x; it < 256; it += gridDim.x) naive_state_item(P, l, it, tid);
#endif
        }
#endif
        for (int rs_ = 0; rs_ < REP_SYNC; ++rs_) xcd_barrier(xbar);
#pragma unroll 1
        for (int rep_ = 0; rep_ < REP_P56; ++rep_) {
            RELOAD_P(P); unsigned char* ws = P->ws; const unsigned char* wl = ws + WS_W + (size_t)l * W_LAYER_B; bf16* Z = (bf16*)(ws + WS_Z);
            const int G = (int)gridDim.x, NB = G >= 200 ? 160 : (G * 5) / 8;
            if ((int)blockIdx.x < NB) {
                pg8::Gemm g{(const bf16*)(ws + WS_ABR), (const bf16*)(wl + W_IN_B + W_GLU_B), 3 * MTOK, 3 * 1024, 512};
                pg8::BranchOrderX S{NB, (int)blockIdx.x};
                pg8::EpiBranch E{(bf16*)(ws + WS_H), Z + C_MERGE, NCOL};
                pg8::gemm_phase<pg8::EpiBranch, pg8::BranchOrderX, true, true>(lds, g, S, E);
            } else {
                pg8::Gemm g{(const bf16*)(ws + WS_YB), (const bf16*)(wl + W_IN_B), MTOK, 1024, 512};
                pg8::GluOrder S{G - NB, (int)blockIdx.x - NB};
                pg8::EpiGlu E{(bf16*)(ws + WS_ABR) + (size_t)MTOK * 512, Z + C_SGATE, NCOL};
                pg8::gemm_phase<pg8::EpiGlu, pg8::GluOrder, true, true>(lds, g, S, E);
            }
        }
        for (int rs_ = 0; rs_ < REP_SYNC; ++rs_) xcd_barrier(xbar);
#pragma unroll 1
        for (int rep_ = 0; rep_ < 1; ++rep_) {
            RELOAD_P(P); unsigned char* ws = P->ws; const unsigned char* wl = ws + WS_W + (size_t)l * W_LAYER_B; bf16* Z = (bf16*)(ws + WS_Z);
            pg8::Gemm g{(const bf16*)(ws + WS_ABR), (const bf16*)(wl + W_IN_B + W_GLU_B), 3 * MTOK, 3 * 1024, 512};
            pg8::BranchOrderY S{(int)gridDim.x, (int)blockIdx.x};
            pg8::EpiBranch E{(bf16*)(ws + WS_H), Z + C_MERGE, NCOL};
            pg8::gemm_phase<pg8::EpiBranch, pg8::BranchOrderY, true, true>(lds, g, S, E);
            if (l == 0 && defer_l1_weights() && blockIdx.x >= 160) convert_weights(P, 1, 1, 160, lds);
        }
        for (int rs_ = 0; rs_ < REP_SYNC; ++rs_) xcd_barrier(xbar);
#ifndef REP_P7L0
#define REP_P7L0 1
#endif
#pragma unroll 1
        for (int rep7_ = 0; rep7_ < (l == 0 ? REP_P7L0 : 1); ++rep7_) {
            RELOAD_P(P); unsigned char* ws = P->ws; const unsigned char* wl = ws + WS_W + (size_t)l * W_LAYER_B; bf16* Z = (bf16*)(ws + WS_Z); unsigned* ctl = (unsigned*)(ws + WS_CTL); (void)wl; (void)Z; (void)ctl;
            pg8::Gemm g{(const bf16*)(ws + WS_H), (const bf16*)(wl + W_IN_B + W_GLU_B + W_BR_B), MTOK, 1024, 1024};
            pg8::StaticOrder S; S.init(MTOK, 1024, (int)gridDim.x, (int)blockIdx.x);
            const float* gate = (const float*)(ws + WS_MODS) + (size_t)l * 3 * 3072 + 2048;
            pg8::EpiResid E{l == 0 ? P->in[I_XP] : P->out, l == 0 ? P->in[I_XS] : P->out + (size_t)MCTX * DM, P->out, gate};
            pg8::gemm_phase<pg8::EpiResid, pg8::StaticOrder, true, true>(lds, g, S, E);
            if (l == 0 && defer_l1_weights() && blockIdx.x >= 160) convert_weights(P, 1, 0, 160, lds);
        }
        if (l == 0) for (int rs_ = 0; rs_ < REP_SYNC; ++rs_) xcd_barrier(xbar);
    }
}

extern "C" void kernel_launch(void* const* d_in, const int* in_sizes, int n_in, void* d_out, int out_size, void* d_ws, size_t ws_size, hipStream_t stream) {
    static int grid = 0;
    if (grid == 0) {
        if (n_in != 31 || ws_size < WS_END) { fprintf(stderr, "kernel_launch: unexpected n_in %d / ws_size %zu (need %zu)\n", n_in, ws_size, (size_t)WS_END); grid = -1; return; }
        int dev = 0, cus = 0, per_cu = 0;
        hipGetDevice(&dev);
        hipDeviceGetAttribute(&cus, hipDeviceAttributeMultiprocessorCount, dev);
        if (hipFuncSetAttribute((const void*)fwd_kernel, hipFuncAttributeMaxDynamicSharedMemorySize, LDS_BYTES) != hipSuccess) { fprintf(stderr, "kernel_launch: hipFuncSetAttribute failed\n"); grid = -1; return; }
        if (hipOccupancyMaxActiveBlocksPerMultiprocessor(&per_cu, (const void*)fwd_kernel, 512, LDS_BYTES) != hipSuccess || per_cu < 1) { fprintf(stderr, "kernel_launch: occupancy query says %d\n", per_cu); (void)hipGetLastError(); per_cu = 1; }
        grid = cus * 1;
    }
    if (grid < 0) return;
    (void)hipMemsetAsync((char*)d_ws + WS_CTL, 0, CTL_ZERO_BYTES, stream);
    Params p{};
    for (int i = 0; i < 31; ++i) p.in[i] = (const float*)d_in[i];
    p.out = (float*)d_out; p.ws = (unsigned char*)d_ws;
    void* args[] = {&p};
    hipError_t e = hipLaunchCooperativeKernel((const void*)fwd_kernel, dim3(grid), dim3(512), args, LDS_BYTES, stream);
    if (e != hipSuccess) fprintf(stderr, "cooperative launch failed: %s (grid %d)\n", hipGetErrorString(e), grid);
}
```

```cpp
#include <hip/hip_runtime.h>
#include <hip/hip_cooperative_groups.h>
#include <cstdio>
#include <cstdint>
#include <cmath>
namespace cg = cooperative_groups;
namespace pg8 {
#define PG8_LAS __attribute__((address_space(3)))
typedef unsigned short bf16_t;
typedef short bf16x8 __attribute__((ext_vector_type(8)));
typedef float f32x4 __attribute__((ext_vector_type(4)));
typedef unsigned u32x4 __attribute__((ext_vector_type(4)));
constexpr int BM = 256, BK = 64, HALF = 128, HTB = HALF * BK * 2  , STAGE_BYTES = 8 * HTB, NXCD = 8, WGM = 8;

__host__ __device__ __forceinline__ int lds_byte(int r, int c) { const int st = (r >> 4) * 2 + (c >> 5), rr = r & 15, cc = c & 31, ob = rr * 64 + cc * 2; return st * 1024 + (ob ^ (((ob >> 9) & 1) << 5)); }
__host__ __device__ __forceinline__ void stage_rc(int b, int& R, int& C) { const int st = b / 1024, sb = b % 1024, swz = sb ^ (((sb >> 9) & 1) << 5); R = (st >> 1) * 16 + swz / 64; C = (st & 1) * 32 + (swz % 64) / 2; }
__host__ __device__ __forceinline__ int perm32(int rho) { const int n = rho >> 4, i = rho & 15; return 8 * (i >> 2) + 4 * n + (i & 3); }

struct Unit { int pm, pn; };
struct Gemm { const bf16_t* A; const bf16_t* Bt; int M, N, K; };

struct StaticOrder {
    int nM, nN, nwg, G, c;
    __host__ __device__ void init(int M, int N, int G_, int c_) { nM = M / BM; nN = N / BM; nwg = nM * nN; G = G_; c = c_; }
    __host__ __device__ bool next(int i, Unit& u) const {
        const long L = (long)i * G + c; if (L >= nwg) return false;
        int wgid = (int)L; { const int q = nwg / NXCD, r = nwg % NXCD, xcd = wgid % NXCD, off = wgid / NXCD; wgid = (xcd < r ? xcd * (q + 1) : r * (q + 1) + (xcd - r) * q) + off; }
        const int nig = WGM * nN, gid = wgid / nig, fm = gid * WGM, gsz = (nM - fm) < WGM ? (nM - fm) : WGM;
        u.pm = fm + ((wgid % nig) % gsz); u.pn = (wgid % nig) / gsz; return true;
    }
    __device__ __forceinline__ void a_ready(const Unit&) const {}
    __device__ __forceinline__ void done(const Unit&) const {}
};

__device__ __forceinline__ unsigned cvt_pk_bf16(float lo, float hi) { unsigned r; asm volatile("v_cvt_pk_bf16_f32 %0, %1, %2" : "=v"(r) : "v"(lo), "v"(hi)); return r; }
typedef float f32x2 __attribute__((ext_vector_type(2)));
typedef unsigned u32x4e __attribute__((ext_vector_type(4)));
__device__ __forceinline__ float bf_lo(unsigned w) { return __uint_as_float(w << 16); }
__device__ __forceinline__ float bf_hi(unsigned w) { return __uint_as_float(w & 0xffff0000u); }
__device__ __forceinline__ float sigm(float x) { return __builtin_amdgcn_rcpf(1.f + __builtin_amdgcn_exp2f(-1.4426950408889634f * x)); }
__device__ __forceinline__ float silu_f(float x) { return x * __builtin_amdgcn_rcpf(1.f + __builtin_amdgcn_exp2f(-1.4426950408889634f * x)); }

struct EpiPlain {
    static constexpr bool PERM = true, AFTER_DRAIN = false;
    bf16_t* O; int ldc;
    __device__ __forceinline__ void operator()(const f32x4 (&acc)[2][2][4][2], const Unit& u, int wr, int wc, int fr, int fq) const {
        const int row0 = u.pm * BM + wr * 64 + fr, col0 = u.pn * BM + wc * 32 + 8 * fq;
#pragma unroll
        for (int ai = 0; ai < 2; ++ai)
#pragma unroll
            for (int m = 0; m < 4; ++m) { bf16_t* rowp = O + (size_t)(row0 + ai * HALF + m * 16) * ldc + col0;
#pragma unroll
                for (int bj = 0; bj < 2; ++bj) { const f32x4 v0 = acc[ai][bj][m][0], v1 = acc[ai][bj][m][1];
                    u32x4e w; w.x = cvt_pk_bf16(v0[0], v0[1]); w.y = cvt_pk_bf16(v0[2], v0[3]); w.z = cvt_pk_bf16(v1[0], v1[1]); w.w = cvt_pk_bf16(v1[2], v1[3]);
                    *(u32x4e*)(rowp + bj * HALF) = w; } }
    }
};
struct EpiGlu {
    static constexpr bool PERM = true, AFTER_DRAIN = false;
    bf16_t* O; const bf16_t* Zg; int ldz;
    __device__ __forceinline__ void operator()(const f32x4 (&acc)[2][2][4][2], const Unit& u, int wr, int wc, int fr, int fq) const {
        const int row0 = u.pm * BM + wr * 64 + fr, oc0 = u.pn * 128 + wc * 32 + 8 * fq;
#pragma unroll
        for (int ai = 0; ai < 2; ++ai)
#pragma unroll
            for (int m = 0; m < 4; ++m) { const int r = row0 + ai * HALF + m * 16;
                const u32x4e gz = *(const u32x4e*)(Zg + (size_t)r * ldz + oc0);
                const f32x4 a0 = acc[ai][0][m][0], a1 = acc[ai][0][m][1], b0 = acc[ai][1][m][0], b1 = acc[ai][1][m][1];
                float o[8];
                o[0] = a0[0] * sigm(b0[0]) * silu_f(bf_lo(gz.x)); o[1] = a0[1] * sigm(b0[1]) * silu_f(bf_hi(gz.x));
                o[2] = a0[2] * sigm(b0[2]) * silu_f(bf_lo(gz.y)); o[3] = a0[3] * sigm(b0[3]) * silu_f(bf_hi(gz.y));
                o[4] = a1[0] * sigm(b1[0]) * silu_f(bf_lo(gz.z)); o[5] = a1[1] * sigm(b1[1]) * silu_f(bf_hi(gz.z));
                o[6] = a1[2] * sigm(b1[2]) * silu_f(bf_lo(gz.w)); o[7] = a1[3] * sigm(b1[3]) * silu_f(bf_hi(gz.w));
                u32x4e w; w.x = cvt_pk_bf16(o[0], o[1]); w.y = cvt_pk_bf16(o[2], o[3]); w.z = cvt_pk_bf16(o[4], o[5]); w.w = cvt_pk_bf16(o[6], o[7]);
                *(u32x4e*)(O + (size_t)r * 512 + oc0) = w; }
    }
};
struct EpiBranch {
    static constexpr bool PERM = true, AFTER_DRAIN = false;
    bf16_t* MIX; const bf16_t* Zm; int ldz;
    __device__ __forceinline__ void operator()(const f32x4 (&acc)[2][2][4][2], const Unit& u, int wr, int wc, int fr, int fq) const {
        const int br = u.pn >> 2, pn = u.pn & 3, pm = u.pm - 40 * br;
        const int row0 = pm * BM + wr * 64 + fr, col0 = pn * BM + wc * 32 + 8 * fq;
#pragma unroll
        for (int ai = 0; ai < 2; ++ai)
#pragma unroll
            for (int m = 0; m < 4; ++m) { const int r = row0 + ai * HALF + m * 16;
#pragma unroll
                for (int bj = 0; bj < 2; ++bj) { const int c = col0 + bj * HALF;
                    const u32x4e gz = *(const u32x4e*)(Zm + (size_t)r * ldz + br * 1024 + c);
                    u32x4e pv = (u32x4e){0u, 0u, 0u, 0u};
                    if (br > 0) pv = *(const u32x4e*)(MIX + (size_t)r * 1024 + c);
                    const f32x4 v0 = acc[ai][bj][m][0], v1 = acc[ai][bj][m][1];
                    float o[8];
                    o[0] = v0[0] * sigm(bf_lo(gz.x)) + bf_lo(pv.x); o[1] = v0[1] * sigm(bf_hi(gz.x)) + bf_hi(pv.x);
                    o[2] = v0[2] * sigm(bf_lo(gz.y)) + bf_lo(pv.y); o[3] = v0[3] * sigm(bf_hi(gz.y)) + bf_hi(pv.y);
                    o[4] = v1[0] * sigm(bf_lo(gz.z)) + bf_lo(pv.z); o[5] = v1[1] * sigm(bf_hi(gz.z)) + bf_hi(pv.z);
                    o[6] = v1[2] * sigm(bf_lo(gz.w)) + bf_lo(pv.w); o[7] = v1[3] * sigm(bf_hi(gz.w)) + bf_hi(pv.w);
                    u32x4e w; w.x = cvt_pk_bf16(o[0], o[1]); w.y = cvt_pk_bf16(o[2], o[3]); w.z = cvt_pk_bf16(o[4], o[5]); w.w = cvt_pk_bf16(o[6], o[7]);
                    *(u32x4e*)(MIX + (size_t)r * 1024 + c) = w; } }
    }
};
struct WinOrder {
    int G, c;
    __device__ __forceinline__ static void unit_of(int W, Unit& u) { const int gid = W / 216, rr = W % 216; u.pm = gid * 8 + (rr & 7); u.pn = rr >> 3; }
    __device__ __forceinline__ bool next(int i, Unit& u) const {
        const int L = i * G + c; if (L >= 1024) return false;
        unit_of((L & 7) * 128 + (L >> 3), u); return true;
    }
    __device__ __forceinline__ void a_ready(const Unit&) const {}
    __device__ __forceinline__ void done(const Unit&) const {}
};
struct OneUnit {
    int W;
    __device__ __forceinline__ bool next(int i, Unit& u) const { if (i > 0) return false; WinOrder::unit_of(W, u); return true; }
    __device__ __forceinline__ void a_ready(const Unit&) const {}
    __device__ __forceinline__ void done(const Unit&) const {}
};
struct BranchOrderX {
    int NB, c;
    __device__ __forceinline__ bool next(int i, Unit& u) const {
        const int tI = (i >> 1) * NB + c, br = (i & 1) * 2; if (tI >= 160) return false;
        u.pm = br * 40 + (tI >> 2); u.pn = br * 4 + (tI & 3); return true;
    }
    __device__ __forceinline__ void a_ready(const Unit&) const {}
    __device__ __forceinline__ void done(const Unit&) const {}
};
struct GluOrder {
    int NG, c;
    __device__ __forceinline__ bool next(int i, Unit& u) const {
        const int tI = i * NG + c; if (tI >= 160) return false;
        u.pm = tI >> 2; u.pn = tI & 3; return true;
    }
    __device__ __forceinline__ void a_ready(const Unit&) const {}
    __device__ __forceinline__ void done(const Unit&) const {}
};
struct BranchOrderY {
    int G, c;
    __device__ __forceinline__ bool next(int i, Unit& u) const {
        const int tI = i * G + c; if (tI >= 160) return false;
        u.pm = 40 + (tI >> 2); u.pn = 4 + (tI & 3); return true;
    }
    __device__ __forceinline__ void a_ready(const Unit&) const {}
    __device__ __forceinline__ void done(const Unit&) const {}
};
struct BranchOrder {
    int G, c;
    __device__ __forceinline__ bool next(int i, Unit& u) const {
        const int tI = (i / 3) * G + c, br = i % 3; if (tI >= 160) return false;
        u.pm = br * 40 + (tI >> 2); u.pn = br * 4 + (tI & 3); return true;
    }
    __device__ __forceinline__ void a_ready(const Unit&) const {}
    __device__ __forceinline__ void done(const Unit&) const {}
};
struct EpiResid {
    static constexpr bool PERM = false, AFTER_DRAIN = false;
    const float* base_ctx; const float* base_lat; float* out; const float* gate;
    __device__ __forceinline__ void operator()(const f32x4 (&acc)[2][2][4][2], const Unit& u, int wr, int wc, int fr, int fq) const {
        const int row0 = u.pm * BM + wr * 64 + fr, col0 = u.pn * BM + wc * 32 + 4 * fq;
        const int cond = u.pm < 32 ? 0 : 1 + ((u.pm - 32) >> 2);
        const float* bp = u.pm < 32 ? base_ctx : base_lat - (size_t)8192 * 1024;
        f32x4 gv[2][2];
#pragma unroll
        for (int bj = 0; bj < 2; ++bj)
#pragma unroll
            for (int n = 0; n < 2; ++n) gv[bj][n] = *(const f32x4*)(gate + cond * 3072 + col0 + bj * HALF + n * 16);
#pragma unroll
        for (int ai = 0; ai < 2; ++ai)
#pragma unroll
            for (int m = 0; m < 4; ++m) { const size_t off = (size_t)(row0 + ai * HALF + m * 16) * 1024 + col0;
#pragma unroll
                for (int bj = 0; bj < 2; ++bj)
#pragma unroll
                    for (int n = 0; n < 2; ++n) { const f32x4 bs = *(const f32x4*)(bp + off + bj * HALF + n * 16);
                        *(f32x4*)(out + off + bj * HALF + n * 16) = bs + gv[bj][n] * acc[ai][bj][m][n]; } }
    }
};
template <class Epi, class Sched, bool ALIGN_EPI = false, bool SP2 = false>
__device__ __forceinline__ void gemm_phase(PG8_LAS unsigned char* lds, const Gemm g, const Sched& S, const Epi& E) {
    int tid_l = threadIdx.x; asm volatile("" : "+v"(tid_l));
    const int tid = tid_l, wid = __builtin_amdgcn_readfirstlane(tid >> 6), lane = tid & 63, wr = wid >> 2, wc = wid & 3, fr = lane & 15, fq = lane >> 4;
    const int K = g.K, nt = K / BK;
    unsigned voffA[2], voffB[2];
#pragma unroll
    for (int i = 0; i < 2; ++i) { int R, C; stage_rc(tid * 16 + i * 8192, R, C); const int Rb = Epi::PERM ? ((R & ~31) + perm32(R & 31)) : R;
        voffA[i] = (unsigned)(R * K + C) * 2u; voffB[i] = (unsigned)(Rb * K + C) * 2u; }
    const size_t kstep = (size_t)(BK * 2);
    const size_t hstep = (size_t)HALF * K * 2;
    const size_t tstep = 2 * hstep;
    const unsigned ldsw = (unsigned)wid * 1024u;
    const int aoff = lds_byte(wr * 64 + fr, fq * 8), boff = lds_byte(wc * 32 + fr, fq * 8);
#define PG8_SA(b, h) (((b) * 2 + (h)) * HTB)
#define PG8_SB(b, h) ((4 + (b) * 2 + (h)) * HTB)
#define PG8_STAGE(bufoff, gbase, voff) do { _Pragma("unroll") for (int _i = 0; _i < 2; ++_i) \
        __builtin_amdgcn_global_load_lds((const unsigned*)((const char*)(gbase) + (voff)[_i]), (PG8_LAS unsigned*)(lds + (bufoff) + ldsw + _i * 8192), 16, 0, 0); } while (0)
#define PG8_LDA(dst, b, h) do { _Pragma("unroll") for (int m = 0; m < 4; ++m) _Pragma("unroll") for (int k = 0; k < 2; ++k) dst[m][k] = *(const PG8_LAS bf16x8*)(lds + PG8_SA(b, h) + aoff + m * 2048 + k * 1024); } while (0)
#define PG8_LDB(dst, b, h) do { _Pragma("unroll") for (int n = 0; n < 2; ++n) _Pragma("unroll") for (int k = 0; k < 2; ++k) dst[n][k] = *(const PG8_LAS bf16x8*)(lds + PG8_SB(b, h) + boff + n * 2048 + k * 1024); } while (0)
#define PG8_MMA(ai, bj, At, Bt) do { __builtin_amdgcn_s_setprio(1); _Pragma("unroll") for (int m = 0; m < 4; ++m) _Pragma("unroll") for (int n = 0; n < 2; ++n) _Pragma("unroll") for (int k = 0; k < 2; ++k) \
        acc[ai][bj][m][n] = __builtin_amdgcn_mfma_f32_16x16x32_bf16(Bt[n][k], At[m][k], acc[ai][bj][m][n], 0, 0, 0); __builtin_amdgcn_s_setprio(0); } while (0)
#define PG8_WAIT_V(n) asm volatile("s_waitcnt vmcnt(" #n ")" ::: "memory")
#define PG8_WAIT_L(n) asm volatile("s_waitcnt lgkmcnt(" #n ")" ::: "memory")
#define PG8_BAR __builtin_amdgcn_s_barrier()
#define PG8_SCHED __builtin_amdgcn_sched_barrier(0)
    Unit cur, nxt; int ui = 0;
    if (!S.next(0, cur)) return;
    f32x4 acc[2][2][4][2];
#pragma unroll
    for (int a = 0; a < 2; ++a)
#pragma unroll
        for (int b = 0; b < 2; ++b)
#pragma unroll
            for (int m = 0; m < 4; ++m)
#pragma unroll
                for (int n = 0; n < 2; ++n) acc[a][b][m][n] = (f32x4){0.f, 0.f, 0.f, 0.f};
    bf16x8 At[4][2], B0[2][2], B1[2][2];
    const char* cA = (const char*)g.A + (size_t)cur.pm * tstep; const char* cB = (const char*)g.Bt + (size_t)cur.pn * tstep;
    S.a_ready(cur);
    if constexpr (SP2) {
        PG8_STAGE(PG8_SB(0, 0), cB, voffB); PG8_STAGE(PG8_SB(0, 1), cB + hstep, voffB); PG8_STAGE(PG8_SA(0, 0), cA, voffA); PG8_STAGE(PG8_SA(0, 1), cA + hstep, voffA);
        if (wr == 1) PG8_BAR;
        PG8_WAIT_V(2); PG8_BAR;
        PG8_STAGE(PG8_SB(1, 0), cB + kstep, voffB); PG8_STAGE(PG8_SA(1, 0), cA + kstep, voffA); PG8_STAGE(PG8_SB(1, 1), cB + hstep + kstep, voffB);
        PG8_WAIT_V(6); PG8_BAR;
    } else {
        PG8_STAGE(PG8_SB(0, 0), cB, voffB); PG8_STAGE(PG8_SA(0, 0), cA, voffA); PG8_STAGE(PG8_SB(0, 1), cB + hstep, voffB); PG8_STAGE(PG8_SA(0, 1), cA + hstep, voffA);
        if (wr == 1) PG8_BAR;
        PG8_WAIT_V(4); PG8_BAR;
        PG8_STAGE(PG8_SB(1, 0), cB + kstep, voffB); PG8_STAGE(PG8_SA(1, 0), cA + kstep, voffA); PG8_STAGE(PG8_SB(1, 1), cB + hstep + kstep, voffB);
        PG8_WAIT_V(6); PG8_BAR;
    }
    for (;;) {
        const bool has_next = S.next(ui + 1, nxt);
        const char* nA = has_next ? (const char*)g.A + (size_t)nxt.pm * tstep : cA; const char* nB = has_next ? (const char*)g.Bt + (size_t)nxt.pn * tstep : cB;
        for (int t = 0; t < nt; t += 2) {
            const bool last = (t == nt - 2);
            const char* a1 = cA + (size_t)(t + 1) * kstep;
            const char* a2 = last ? nA : cA + (size_t)(t + 2) * kstep; const char* b2 = last ? nB : cB + (size_t)(t + 2) * kstep;
            const char* a3 = a2 + kstep; const char* b3 = b2 + kstep;
            if (last && has_next) S.a_ready(nxt);
            if constexpr (SP2) {
            PG8_LDB(B0, 0, 0); PG8_LDB(B1, 0, 1); PG8_SCHED; PG8_LDA(At, 0, 0); PG8_STAGE(PG8_SA(1, 1), a1 + hstep, voffA);
            PG8_WAIT_V(8); PG8_WAIT_L(0); PG8_BAR; PG8_MMA(0, 0, At, B0); PG8_MMA(0, 1, At, B1); PG8_BAR; PG8_SCHED;
            PG8_LDA(At, 0, 1); PG8_STAGE(PG8_SB(0, 0), b2, voffB); PG8_STAGE(PG8_SB(0, 1), b2 + hstep, voffB); PG8_STAGE(PG8_SA(0, 0), a2, voffA);
            PG8_WAIT_V(8); PG8_WAIT_L(0); PG8_BAR; PG8_MMA(1, 0, At, B0); PG8_MMA(1, 1, At, B1); PG8_BAR; PG8_SCHED;
            PG8_LDB(B0, 1, 0); PG8_LDB(B1, 1, 1); PG8_SCHED; PG8_LDA(At, 1, 0); PG8_STAGE(PG8_SA(0, 1), a2 + hstep, voffA);
            PG8_WAIT_V(8); PG8_WAIT_L(0); PG8_BAR; PG8_MMA(0, 0, At, B0); PG8_MMA(0, 1, At, B1); PG8_BAR; PG8_SCHED;
            PG8_LDA(At, 1, 1); PG8_STAGE(PG8_SB(1, 0), b3, voffB); PG8_STAGE(PG8_SB(1, 1), b3 + hstep, voffB); PG8_STAGE(PG8_SA(1, 0), a3, voffA);
            PG8_WAIT_V(8); PG8_WAIT_L(0); PG8_BAR; PG8_MMA(1, 0, At, B0); PG8_MMA(1, 1, At, B1); PG8_BAR; PG8_SCHED;
            } else {
            PG8_LDB(B0, 0, 0); PG8_SCHED; PG8_LDA(At, 0, 0); PG8_STAGE(PG8_SA(1, 1), a1 + hstep, voffA);
            PG8_WAIT_L(8); PG8_BAR; PG8_WAIT_L(0); PG8_MMA(0, 0, At, B0); PG8_BAR; PG8_SCHED;
            PG8_LDB(B1, 0, 1); PG8_STAGE(PG8_SB(0, 0), b2, voffB);
            PG8_BAR; PG8_WAIT_L(0); PG8_MMA(0, 1, At, B1); PG8_BAR;
            PG8_LDA(At, 0, 1); PG8_STAGE(PG8_SA(0, 0), a2, voffA);
            PG8_BAR; PG8_WAIT_L(0); PG8_MMA(1, 0, At, B0); PG8_BAR; PG8_SCHED;
            PG8_STAGE(PG8_SB(0, 1), b2 + hstep, voffB);
            PG8_WAIT_V(6); PG8_BAR; PG8_MMA(1, 1, At, B1); PG8_BAR;
            PG8_LDB(B0, 1, 0); PG8_SCHED; PG8_LDA(At, 1, 0); PG8_STAGE(PG8_SA(0, 1), a2 + hstep, voffA);
            PG8_WAIT_L(8); PG8_BAR; PG8_WAIT_L(0); PG8_MMA(0, 0, At, B0); PG8_BAR; PG8_SCHED;
            PG8_LDB(B1, 1, 1); PG8_STAGE(PG8_SB(1, 0), b3, voffB);
            PG8_BAR; PG8_WAIT_L(0); PG8_MMA(0, 1, At, B1); PG8_BAR;
            PG8_LDA(At, 1, 1); PG8_STAGE(PG8_SA(1, 0), a3, voffA);
            PG8_BAR; PG8_WAIT_L(0); PG8_MMA(1, 0, At, B0); PG8_BAR; PG8_SCHED;
            PG8_STAGE(PG8_SB(1, 1), b3 + hstep, voffB);
            PG8_WAIT_V(6); PG8_BAR; PG8_MMA(1, 1, At, B1); PG8_BAR;
            }
        }
        if constexpr (ALIGN_EPI) { if (wr == 0) PG8_BAR; }
        if constexpr (!Epi::AFTER_DRAIN) { E(acc, cur, wr, wc, fr, fq); S.done(cur); }
        if (!has_next) break;
#pragma unroll
        for (int a = 0; a < 2; ++a)
#pragma unroll
            for (int b = 0; b < 2; ++b)
#pragma unroll
                for (int m = 0; m < 4; ++m)
#pragma unroll
                    for (int n = 0; n < 2; ++n) acc[a][b][m][n] = (f32x4){0.f, 0.f, 0.f, 0.f};
        cur = nxt; cA = nA; cB = nB; ++ui;
        if constexpr (ALIGN_EPI) { if (wr == 1) PG8_BAR; }
    }
    PG8_WAIT_V(0);
    if constexpr (!ALIGN_EPI) { if (wr == 0) PG8_BAR; }
    PG8_BAR;
    if constexpr (Epi::AFTER_DRAIN) { E.fused(acc, cur, wr, wc, fr, fq, lds, wid, lane); S.done(cur); }
#undef PG8_SA
#undef PG8_SB
#undef PG8_STAGE
#undef PG8_LDA
#undef PG8_LDB
#undef PG8_MMA
#undef PG8_WAIT_V
#undef PG8_WAIT_L
#undef PG8_BAR
#undef PG8_SCHED
}
}

#define LAS __attribute__((address_space(3)))
typedef unsigned short bf16;
typedef unsigned u32x4 __attribute__((ext_vector_type(4)));
typedef unsigned u32x2 __attribute__((ext_vector_type(2)));
typedef float f32x4 __attribute__((ext_vector_type(4)));
typedef float f32x2 __attribute__((ext_vector_type(2)));
typedef float f32x16 __attribute__((ext_vector_type(16)));
typedef short bf16x8 __attribute__((ext_vector_type(8)));
using pg8::cvt_pk_bf16; using pg8::bf_lo; using pg8::bf_hi; using pg8::sigm; using pg8::silu_f;

constexpr int DM = 1024, NCOL = 6912, MTOK = 10240, MCTX = 8192;
constexpr int C_CONVA = 0, C_CONVG = 512, C_CGATE = 1024, C_SSMIN = 1536, C_SGATE = 2048, C_Q = 2560, C_K = 3072, C_V = 3200, C_AGATE = 3328, C_MERGE = 3840;
constexpr float EPS = 1e-6f;
constexpr size_t MiB = (size_t)1 << 20;
constexpr size_t WS_CTL = 0, CTL_ZERO_BYTES = 256 * 1024;
constexpr size_t WS_MODS = 4096;
constexpr size_t WS_ROPE = 1 * MiB;
constexpr size_t WS_LAM = 1 * MiB + 64 * 1024;
constexpr size_t WS_BB = 2 * MiB;
constexpr size_t WS_CT = 3 * MiB;
constexpr size_t WS_E = 4 * MiB;
constexpr size_t WS_W = 10 * MiB;
constexpr size_t W_IN_B = (size_t)NCOL * DM * 2, W_GLU_B = (size_t)1024 * 512 * 2, W_BR_B = (size_t)3 * 1024 * 512 * 2, W_OUT_B = (size_t)1024 * 1024 * 2;
constexpr size_t W_LAYER_B = W_IN_B + W_GLU_B + W_BR_B + W_OUT_B;
constexpr size_t WS_H = 50 * MiB;
constexpr size_t WS_ABR = 70 * MiB;
constexpr size_t WS_YB = 100 * MiB;
constexpr size_t WS_MODSP = WS_YB;
constexpr size_t WS_Z = 110 * MiB;
constexpr size_t WS_END = WS_Z + (size_t)MTOK * NCOL * 2;
static_assert(WS_W + 2 * W_LAYER_B <= WS_H && WS_END <= 256 * MiB, "ws map");
constexpr int LDS_BYTES = 147456;

struct Params { const float* in[31]; float* out; unsigned char* ws; };
typedef const __attribute__((address_space(4))) Params* KP;
#define RELOAD_P(P) asm volatile("" : "+s"(P))
enum { I_XP = 0, I_XS, I_CK, I_CV, I_SRE, I_SIM, I_C, I_CCTX, I_NG, I_WADA, I_BADA, I_WIN, I_DWW, I_DWB, I_LNG, I_LNB, I_WCO, I_ARE, I_AIM, I_LDT, I_BRE, I_BIM, I_CRE, I_CIM, I_SD, I_WGLU, I_WSO, I_QG, I_KG, I_WAO, I_WOUT };
constexpr size_t O_Y = 0, O_CK = 10485760, O_CV = 12582912, O_SRE = 14680064, O_SIM = 14942208;

__device__ __forceinline__ float wave_sum(float v) {
#pragma unroll
    for (int o = 1; o < 64; o <<= 1) v += __shfl_xor(v, o);
    return v;
}
__device__ __forceinline__ void unpack8(const u32x4 w, float* f) {
    f[0] = bf_lo(w.x); f[1] = bf_hi(w.x); f[2] = bf_lo(w.y); f[3] = bf_hi(w.y); f[4] = bf_lo(w.z); f[5] = bf_hi(w.z); f[6] = bf_lo(w.w); f[7] = bf_hi(w.w);
}
__device__ __forceinline__ u32x4 pack8(const float* f) {
    u32x4 w; w.x = cvt_pk_bf16(f[0], f[1]); w.y = cvt_pk_bf16(f[2], f[3]); w.z = cvt_pk_bf16(f[4], f[5]); w.w = cvt_pk_bf16(f[6], f[7]); return w;
}
#define MFMA32(a, b, c) __builtin_amdgcn_mfma_f32_32x32x16_bf16((a), (b), (c), 0, 0, 0)
#define MFMA16(a, b, c) __builtin_amdgcn_mfma_f32_16x16x32_bf16((a), (b), (c), 0, 0, 0)

__device__ __forceinline__ void p0_transpose_item(const float* W, int K, int N, bf16* WT, int glu, LAS float* scr, int item, int lane) {
    const int nblk = N / 32, kb = item / nblk, nb = item % nblk, k0 = 64 * kb, n0 = 32 * nb;
    int d0 = n0;
    if (glu) { const int bj = n0 >> 9, rem = n0 & 511; d0 = 256 * (rem >> 7) + 128 * bj + (rem & 127); }
    float wv[32];
    const float* wsrc = W + (size_t)(k0 + (lane >> 5)) * N + n0 + (lane & 31);
#pragma unroll
    for (int i = 0; i < 32; ++i) wv[i] = wsrc[(size_t)(2 * i) * N];
#pragma unroll
    for (int i = 0; i < 32; ++i) scr[(2 * i + (lane >> 5)) * 33 + (lane & 31)] = wv[i];
    asm volatile("s_waitcnt lgkmcnt(0)" ::: "memory");
    const int c = lane & 7;
#pragma unroll
    for (int j = 0; j < 4; ++j) { const int n = (lane >> 3) + 8 * j; const LAS float* s = scr + (8 * c) * 33 + n;
        u32x4 o; o.x = cvt_pk_bf16(s[0 * 33], s[1 * 33]); o.y = cvt_pk_bf16(s[2 * 33], s[3 * 33]); o.z = cvt_pk_bf16(s[4 * 33], s[5 * 33]); o.w = cvt_pk_bf16(s[6 * 33], s[7 * 33]);
        *(u32x4*)(WT + (size_t)(d0 + n) * K + k0 + 8 * c) = o; }
    asm volatile("s_waitcnt lgkmcnt(0)" ::: "memory");
}

#ifndef REP_P0A
#define REP_P0A 1
#endif
__device__ __forceinline__ void convert_weights(KP P, int l, int part, int first_block, LAS unsigned char* lds) {
    RELOAD_P(P);
    asm volatile("" : "+s"(l));
    int tid_ = threadIdx.x; asm volatile("" : "+v"(tid_));
    const int lane = tid_ & 63, wid = __builtin_amdgcn_readfirstlane(tid_ >> 6);
    const int gw = ((int)blockIdx.x - first_block) * 8 + wid, NGW = ((int)gridDim.x - first_block) * 8;
    LAS float* scr = (LAS float*)(lds + wid * 8448);
    constexpr int I_IN = 16 * 216, I_S = 8 * 32, I_O = 16 * 32;
    unsigned char* wl = P->ws + WS_W + (size_t)l * W_LAYER_B;
    if (part == 0) {
        for (int r = gw; r < I_IN; r += NGW) p0_transpose_item(P->in[I_WIN] + (size_t)l * DM * NCOL, DM, NCOL, (bf16*)wl, 0, scr, r, lane);
    } else {
        for (int it = gw; it < 4 * I_S + I_O; it += NGW) {
            int r = it;
            if (r < I_S) { p0_transpose_item(P->in[I_WGLU] + (size_t)l * 512 * 1024, 512, 1024, (bf16*)(wl + W_IN_B), 1, scr, r, lane); continue; } r -= I_S;
            if (r < I_S) { p0_transpose_item(P->in[I_WCO] + (size_t)l * 512 * 1024, 512, 1024, (bf16*)(wl + W_IN_B + W_GLU_B), 0, scr, r, lane); continue; } r -= I_S;
            if (r < I_S) { p0_transpose_item(P->in[I_WSO] + (size_t)l * 512 * 1024, 512, 1024, (bf16*)(wl + W_IN_B + W_GLU_B) + (size_t)1024 * 512, 0, scr, r, lane); continue; } r -= I_S;
            if (r < I_S) { p0_transpose_item(P->in[I_WAO] + (size_t)l * 512 * 1024, 512, 1024, (bf16*)(wl + W_IN_B + W_GLU_B) + (size_t)2048 * 512, 0, scr, r, lane); continue; } r -= I_S;
            p0_transpose_item(P->in[I_WOUT] + (size_t)l * 1024 * 1024, 1024, 1024, (bf16*)(wl + W_IN_B + W_GLU_B + W_BR_B), 0, scr, r, lane);
        }
    }
}
__device__ __forceinline__ bool defer_l1_weights() { return gridDim.x >= 200; }

__device__ __forceinline__ void p0_prologue(KP P, LAS unsigned char* lds, int tid, int lane, int wid) {
    RELOAD_P(P);
    unsigned char* ws = P->ws;
    {
        const int nl = defer_l1_weights() ? 1 : 2;
#pragma unroll 1
        for (int rep0_ = 0; rep0_ < REP_P0A; ++rep0_)
#pragma unroll 1
        for (int lp = 0; lp < 2 * nl; ++lp) convert_weights(P, lp >> 1, lp & 1, 0, lds);
    }
    __syncthreads();
    for (int it = blockIdx.x; it < 209; it += gridDim.x) {
        if (it < 192) {
            const int l = it / 96, n0 = 32 * (it % 96);
            LAS float* sc = (LAS float*)lds;
            LAS float* red = (LAS float*)(lds + 12288);
            __syncthreads();
            for (int i = tid; i < 3072; i += 512) { const int j = i >> 10, k = i & 1023; const float cv = (j == 0) ? P->in[I_CCTX][k] : P->in[I_C][(j - 1) * 1024 + k]; sc[i] = cv / (1.f + __expf(-cv)); }
            __syncthreads();
            const int ks = tid >> 5, col = tid & 31;
            const float* w = P->in[I_WADA] + ((size_t)l * 1024 + ks * 64) * 3072 + n0 + col;
            float a0 = 0.f, a1 = 0.f, a2 = 0.f;
#pragma unroll 16
            for (int k = 0; k < 64; ++k) { const float wv = w[(size_t)k * 3072]; a0 += sc[ks * 64 + k] * wv; a1 += sc[1024 + ks * 64 + k] * wv; a2 += sc[2048 + ks * 64 + k] * wv; }
            red[(ks * 3 + 0) * 32 + col] = a0; red[(ks * 3 + 1) * 32 + col] = a1; red[(ks * 3 + 2) * 32 + col] = a2;
            __syncthreads();
            if (tid < 96) { const int j = tid >> 5, c2 = tid & 31; float sum = P->in[I_BADA][l * 3072 + n0 + c2];
#pragma unroll
                for (int q = 0; q < 16; ++q) sum += red[(q * 3 + j) * 32 + c2];
                ((float*)(ws + WS_MODS))[(l * 3 + j) * 3072 + n0 + c2] = sum; }
        } else if (it < 208) {
            const int idx = (it - 192) * 512 + tid; const int l = idx >> 12, dir = (idx >> 11) & 1, g = (idx >> 6) & 31, p = idx & 63;
            const double are = (double)P->in[I_ARE][idx], aim = (double)P->in[I_AIM][idx], dt = exp((double)P->in[I_LDT][(l * 2 + dir) * 32 + g]);
            const double mag = exp(are * dt), lr = mag * cos(aim * dt), li = mag * sin(aim * dt);
            ((f32x2*)(ws + WS_LAM))[idx] = (f32x2){(float)lr, (float)li};
            const double d2 = are * are + aim * aim, qr = ((lr - 1.0) * are + li * aim) / d2, qi = (li * are - (lr - 1.0) * aim) / d2;
            float bre[16], bim[16];
#pragma unroll
            for (int c = 0; c < 16; ++c) { const double br = (double)P->in[I_BRE][(size_t)idx * 16 + c], bi = (double)P->in[I_BIM][(size_t)idx * 16 + c]; bre[c] = (float)(qr * br - qi * bi); bim[c] = (float)(qr * bi + qi * br); }
            bf16* bb = (bf16*)(ws + WS_BB);
            u32x4* d_re = (u32x4*)(bb + ((size_t)(((l * 2 + dir) * 32 + g) * 2 + 0) * 64 + p) * 16);
            u32x4* d_im = (u32x4*)(bb + ((size_t)(((l * 2 + dir) * 32 + g) * 2 + 1) * 64 + p) * 16);
            d_re[0] = pack8(bre); d_re[1] = pack8(bre + 8); d_im[0] = pack8(bim); d_im[1] = pack8(bim + 8);
            bf16* ct = (bf16*)(ws + WS_CT);
#pragma unroll
            for (int cc = 0; cc < 16; ++cc) { const size_t ci = ((size_t)((l * 2 + dir) * 32 + g) * 16 + cc) * 64 + p;
                const float cre = P->in[I_CRE][ci], cim = P->in[I_CIM][ci];
                *(unsigned*)(ct + ((size_t)(((l * 32 + g) * 2 + dir) * 16 + cc) * 128 + 2 * p)) = cvt_pk_bf16(cre, -cim); }
        } else {
            for (int idx = tid; idx < 1024; idx += 512) { const int pos = idx >> 4, j = idx & 15;
                const double inv = exp(-(double)j / 16.0 * log(10000.0)), ang = (double)pos * inv;
                ((f32x2*)(ws + WS_ROPE))[idx] = (f32x2){(float)cos(ang), (float)sin(ang)}; }
        }
    }
}


__device__ __forceinline__ void p1_rows(KP P, int l, int lane, int wid) {
    RELOAD_P(P);
    const float* mods = (const float*)(P->ws + WS_MODS) + (size_t)l * 3 * 3072;
    const float* ng = P->in[I_NG] + l * DM;
    bf16* H = (bf16*)(P->ws + WS_H);
    const int gw = blockIdx.x * 8 + wid, NGW = gridDim.x * 8;
    for (int m = gw; m < MTOK; m += NGW) {
        const float* xr = (l == 0) ? (m < MCTX ? P->in[I_XP] + (size_t)m * DM : P->in[I_XS] + (size_t)(m - MCTX) * DM) : P->out + (size_t)m * DM;
        const int cond = m < MCTX ? 0 : 1 + ((m - MCTX) >> 10);
        const float* sh = mods + cond * 3072; const float* sc = sh + 1024;
        f32x4 v[4]; float s = 0.f;
#pragma unroll
        for (int j = 0; j < 4; ++j) { v[j] = *(const f32x4*)(xr + 4 * lane + 256 * j); s += (v[j].x * v[j].x + v[j].y * v[j].y) + (v[j].z * v[j].z + v[j].w * v[j].w); }
        const float rstd = rsqrtf(wave_sum(s) * (1.f / DM) + EPS);
#pragma unroll
        for (int j = 0; j < 4; ++j) { const int c = 4 * lane + 256 * j;
            const f32x4 g4 = *(const f32x4*)(ng + c), sc4 = *(const f32x4*)(sc + c), sh4 = *(const f32x4*)(sh + c);
            const f32x4 o = v[j] * rstd * g4 * (sc4 + 1.f) + sh4;
            u32x2 w; w.x = cvt_pk_bf16(o.x, o.y); w.y = cvt_pk_bf16(o.z, o.w);
            *(u32x2*)(H + (size_t)m * DM + c) = w; }
    }
}

constexpr int KS_PITCH = 144, VT_PITCH = 528, VT_OFF = 256 * KS_PITCH;
__device__ __forceinline__ int crow(int r, int hi) { return (r & 3) + 8 * (r >> 2) + 4 * hi; }
__device__ __forceinline__ float max3f(float a, float b, float c) { float r; asm("v_max3_f32 %0, %1, %2, %3" : "=v"(r) : "v"(a), "v"(b), "v"(c)); return r; }
__device__ __forceinline__ void attn_item(KP P, int l, int it, LAS unsigned char* lds, int tid, int lane, int wid) {
    RELOAD_P(P);
    asm volatile("" : "+s"(l)); asm volatile("" : "+v"(tid)); lane = tid & 63; wid = __builtin_amdgcn_readfirstlane(tid >> 6);
    const bf16* Z = (const bf16*)(P->ws + WS_Z);
    bf16* OA = (bf16*)(P->ws + WS_ABR) + (size_t)2 * MTOK * 512;
    const f32x2* rope = (const f32x2*)(P->ws + WS_ROPE);
    const bool lat = it < 64;
    int b, kvh, qb;
    if (lat) { b = it >> 5; kvh = (it >> 4) & 1; qb = it & 15; } else { const int j = it - 64; b = j >> 3; kvh = (j >> 2) & 1; qb = j & 3; }
    const int rowbase = lat ? MCTX + b * 1024 : b * 256;
    const int nkt = lat ? 5 : 1;
    const int r32 = lane & 31, hi = lane >> 5;
    const int h = 4 * kvh + (wid & 3);
    const int tq = qb * 64 + 32 * (wid >> 2) + r32;
    const int qrow = rowbase + tq;
    bf16x8 qf[4];
    {
        float qv[4][8]; float ss = 0.f;
        const bf16* zq = Z + (size_t)qrow * NCOL + C_Q + 64 * h + 8 * hi;
#pragma unroll
        for (int d0 = 0; d0 < 4; ++d0) { const u32x4 w = *(const u32x4*)(zq + 16 * d0); unpack8(w, qv[d0]);
#pragma unroll
            for (int i = 0; i < 8; ++i) ss += qv[d0][i] * qv[d0][i]; }
        ss += __shfl_xor(ss, 32);
        const float rs = rsqrtf(ss * (1.f / 64.f) + EPS);
        const float* qg = P->in[I_QG] + l * 64 + 8 * hi;
#pragma unroll
        for (int d0 = 0; d0 < 4; ++d0)
#pragma unroll
            for (int i = 0; i < 8; ++i) qv[d0][i] *= rs * qg[16 * d0 + i];
        if (lat) {
            const int prow = tq >> 6, pcol = tq & 63;
#pragma unroll
            for (int i = 0; i < 8; ++i) { const int j = 8 * hi + i;
                const f32x2 a = rope[prow * 16 + j]; float x1 = qv[0][i], x2 = qv[1][i]; qv[0][i] = x1 * a.x - x2 * a.y; qv[1][i] = x1 * a.y + x2 * a.x;
                const f32x2 c = rope[pcol * 16 + j]; x1 = qv[2][i]; x2 = qv[3][i]; qv[2][i] = x1 * c.x - x2 * c.y; qv[3][i] = x1 * c.y + x2 * c.x; }
        }
        const float qs = 0.125f * 1.4426950408889634f;
#pragma unroll
        for (int d0 = 0; d0 < 4; ++d0) {
#pragma unroll
            for (int i = 0; i < 8; ++i) qv[d0][i] *= qs;
            qf[d0] = __builtin_bit_cast(bf16x8, pack8(qv[d0])); }
    }
    constexpr float ATT_THR = 8.f;
    float mhat = 0.f, lrun = 0.f;
    f32x16 negm;
#pragma unroll
    for (int r = 0; r < 16; ++r) negm[r] = 0.f;
    f32x16 o0, o1;
#pragma unroll
    for (int r = 0; r < 16; ++r) { o0[r] = 0.f; o1[r] = 0.f; }
    for (int kt = 0; kt < nkt; ++kt) {
        __syncthreads();
        {
            const int key = tid >> 1, half = tid & 1;
            float kx[32];
            const bool from_z = (!lat) || kt < 4;
            if (from_z) {
                const int t = kt * 256 + key;
                const bf16* src = Z + (size_t)(rowbase + t) * NCOL + C_K + 64 * kvh + 32 * half;
                float ss = 0.f;
#pragma unroll
                for (int q = 0; q < 4; ++q) { const u32x4 w = *(const u32x4*)(src + 8 * q); unpack8(w, kx + 8 * q); }
#pragma unroll
                for (int i = 0; i < 32; ++i) ss += kx[i] * kx[i];
                ss += __shfl_xor(ss, 1);
                const float rs = rsqrtf(ss * (1.f / 64.f) + EPS);
                const float* kg = P->in[I_KG] + l * 64 + 32 * half;
#pragma unroll
                for (int i = 0; i < 32; ++i) kx[i] *= rs * kg[i];
                if (!lat && qb == 0) { float* dst = P->out + O_CK + ((size_t)((b * 2 + l) * 256 + key) * 2 + kvh) * 64 + 32 * half;
#pragma unroll
                    for (int q = 0; q < 8; ++q) *(f32x4*)(dst + 4 * q) = (f32x4){kx[4 * q], kx[4 * q + 1], kx[4 * q + 2], kx[4 * q + 3]}; }
                if (lat) { const int pos = half ? (t & 63) : (t >> 6);
#pragma unroll
                    for (int j = 0; j < 16; ++j) { const f32x2 a = rope[pos * 16 + j]; const float x1 = kx[j], x2 = kx[16 + j]; kx[j] = x1 * a.x - x2 * a.y; kx[16 + j] = x1 * a.y + x2 * a.x; } }
            } else {
                const float* src = P->in[I_CK] + ((size_t)((b * 2 + l) * 256 + key) * 2 + kvh) * 64 + 32 * half;
#pragma unroll
                for (int q = 0; q < 8; ++q) { const f32x4 w = *(const f32x4*)(src + 4 * q); kx[4 * q] = w.x; kx[4 * q + 1] = w.y; kx[4 * q + 2] = w.z; kx[4 * q + 3] = w.w; }
            }
            LAS u32x4* kd = (LAS u32x4*)(lds + key * KS_PITCH + 64 * half);
#pragma unroll
            for (int q = 0; q < 4; ++q) kd[q] = pack8(kx + 8 * q);
            if (from_z) {
                const int t = kt * 256 + key;
                const bf16* src = Z + (size_t)(rowbase + t) * NCOL + C_V + 64 * kvh + 32 * half;
#pragma unroll
                for (int q = 0; q < 4; ++q) { const u32x4 w = *(const u32x4*)(src + 8 * q); unpack8(w, kx + 8 * q); }
                if (!lat && qb == 0) { float* dst = P->out + O_CV + ((size_t)((b * 2 + l) * 256 + key) * 2 + kvh) * 64 + 32 * half;
#pragma unroll
                    for (int q = 0; q < 8; ++q) *(f32x4*)(dst + 4 * q) = (f32x4){kx[4 * q], kx[4 * q + 1], kx[4 * q + 2], kx[4 * q + 3]}; }
            } else {
                const float* src = P->in[I_CV] + ((size_t)((b * 2 + l) * 256 + key) * 2 + kvh) * 64 + 32 * half;
#pragma unroll
                for (int q = 0; q < 8; ++q) { const f32x4 w = *(const f32x4*)(src + 4 * q); kx[4 * q] = w.x; kx[4 * q + 1] = w.y; kx[4 * q + 2] = w.z; kx[4 * q + 3] = w.w; }
            }
            const int pos = (key & ~15) | ((key & 4) << 1) | ((key & 8) >> 1) | (key & 3);
            LAS bf16* vd = (LAS bf16*)(lds + VT_OFF + (32 * half) * VT_PITCH + 2 * pos);
#pragma unroll
            for (int i = 0; i < 32; i += 2) { const unsigned w = cvt_pk_bf16(kx[i], kx[i + 1]);
                vd[(size_t)i * (VT_PITCH / 2)] = (bf16)(w & 0xffffu); vd[(size_t)(i + 1) * (VT_PITCH / 2)] = (bf16)(w >> 16); }
        }
        __syncthreads();
#pragma unroll 1
        for (int st = 0; st < 4; ++st) {
            f32x16 p0 = negm, p1 = negm;
            const LAS unsigned char* kb = lds + (64 * st + r32) * KS_PITCH + 16 * hi;
#pragma unroll
            for (int d0 = 0; d0 < 4; ++d0) {
                const bf16x8 a0 = *(const LAS bf16x8*)(kb + 32 * d0);
                const bf16x8 a1 = *(const LAS bf16x8*)(kb + 32 * KS_PITCH + 32 * d0);
                p0 = MFMA32(a0, qf[d0], p0); p1 = MFMA32(a1, qf[d0], p1);
            }
            asm volatile("s_nop 15\n\ts_nop 7" : "+v"(p0), "+v"(p1));
            float tm;
            { float a = max3f(p0[0], p0[1], p1[0]), b2 = max3f(p0[2], p0[3], p1[1]); a = max3f(a, p1[2], p1[3]);
#pragma unroll
              for (int r = 4; r < 16; r += 4) { a = max3f(a, p0[r], p0[r + 1]); b2 = max3f(b2, p0[r + 2], p0[r + 3]); a = max3f(a, p1[r], p1[r + 1]); b2 = max3f(b2, p1[r + 2], p1[r + 3]); }
              tm = max3f(a, b2, b2); }
            { const float other = __shfl_xor(tm, 32); tm = max3f(tm, other, other); }
            if (__any(fabsf(tm) > ATT_THR)) {
                const float dl = fabsf(tm) > ATT_THR ? tm : 0.f;
                mhat += dl;
                const float f = __builtin_amdgcn_exp2f(-dl);
#pragma unroll
                for (int r = 0; r < 16; ++r) { p0[r] -= dl; p1[r] -= dl; negm[r] = -mhat; o0[r] *= f; o1[r] *= f; }
                lrun *= f;
            }
            float ps = 0.f;
#pragma unroll
            for (int r = 0; r < 16; ++r) { p0[r] = __builtin_amdgcn_exp2f(p0[r]); p1[r] = __builtin_amdgcn_exp2f(p1[r]); ps += p0[r] + p1[r]; }
            lrun += ps;
            bf16x8 pb[4];
            { float t8[8];
#pragma unroll
              for (int J = 0; J < 4; ++J) {
#pragma unroll
                  for (int i = 0; i < 8; ++i) t8[i] = (J < 2) ? p0[8 * (J & 1) + i] : p1[8 * (J & 1) + i];
                  pb[J] = __builtin_bit_cast(bf16x8, pack8(t8)); } }
            const LAS unsigned char* vb = lds + VT_OFF + r32 * VT_PITCH + 2 * (64 * st + 8 * hi);
#pragma unroll
            for (int J = 0; J < 4; ++J) {
                const bf16x8 v0 = *(const LAS bf16x8*)(vb + 32 * J);
                const bf16x8 v1 = *(const LAS bf16x8*)(vb + 32 * VT_PITCH + 32 * J);
                o0 = MFMA32(v0, pb[J], o0); o1 = MFMA32(v1, pb[J], o1);
            }
        }
    }
    lrun += __shfl_xor(lrun, 32);
    const float inv = 1.f / lrun;
    const bf16* zg = Z + (size_t)qrow * NCOL + C_AGATE + 64 * h;
    bf16* od = OA + (size_t)qrow * 512 + 64 * h;
#pragma unroll
    for (int dt = 0; dt < 2; ++dt)
#pragma unroll
        for (int rq = 0; rq < 4; ++rq) { const int d = 32 * dt + 8 * rq + 4 * hi;
            const u32x2 gw = *(const u32x2*)(zg + d);
            float v[4];
#pragma unroll
            for (int i = 0; i < 4; ++i) v[i] = (dt ? o1[4 * rq + i] : o0[4 * rq + i]) * inv;
            v[0] *= silu_f(bf_lo(gw.x)); v[1] *= silu_f(bf_hi(gw.x)); v[2] *= silu_f(bf_lo(gw.y)); v[3] *= silu_f(bf_hi(gw.y));
            u32x2 w; w.x = cvt_pk_bf16(v[0], v[1]); w.y = cvt_pk_bf16(v[2], v[3]);
            *(u32x2*)(od + d) = w; }
}

__device__ __forceinline__ float fsigm(float x) { return __builtin_amdgcn_rcpf(1.f + __builtin_amdgcn_exp2f(-1.4426950408889634f * x)); }
__device__ __forceinline__ void conv_item(KP P, int l, int it, LAS unsigned char* lds, int tid, int lane, int wid) {
    RELOAD_P(P);
    asm volatile("" : "+s"(l)); asm volatile("" : "+v"(tid)); lane = tid & 63; wid = __builtin_amdgcn_readfirstlane(tid >> 6);
    const bf16* Z = (const bf16*)(P->ws + WS_Z);
    bf16* YA = (bf16*)(P->ws + WS_ABR);
    int rowbase, L, t0;
    if (it < 512) { rowbase = (it >> 4) * 256; L = 256; t0 = 16 * (it & 15); } else { const int j = it - 512; rowbase = MCTX + (j >> 6) * 1024; L = 1024; t0 = 16 * (j & 63); }
    LAS float* yb = (LAS float*)lds;
    LAS float* sb = (LAS float*)(lds + 47 * 512 * 4);
    LAS float* st = (LAS float*)(lds + 47 * 512 * 4 + 16 * 516 * 4);
    u32x4 la[6], lg[6];
#pragma unroll
    for (int i = 0; i < 6; ++i) {
        const int e = tid + 512 * i, rr = e >> 6, ch = e & 63, t = t0 - 15 + rr;
        la[i] = (u32x4){0u, 0u, 0u, 0u}; lg[i] = (u32x4){0u, 0u, 0u, 0u};
        if (rr < 47 && t >= 0 && t < L) { const bf16* src = Z + (size_t)(rowbase + t) * NCOL + 8 * ch; la[i] = *(const u32x4*)(src + C_CONVA); lg[i] = *(const u32x4*)(src + C_CONVG); }
    }
    const int c = tid;
    float w[32];
    const float* wp = P->in[I_DWW] + (size_t)l * 31 * 512 + c;
#pragma unroll
    for (int k = 0; k < 31; ++k) w[k] = wp[k * 512];
    w[31] = 0.f;
    const float bias = P->in[I_DWB][l * 512 + c], lgam = P->in[I_LNG][l * 512 + c], lbet = P->in[I_LNB][l * 512 + c];
    bf16 gt[16];
#pragma unroll
    for (int t = 0; t < 16; ++t) gt[t] = Z[(size_t)(rowbase + t0 + t) * NCOL + C_CGATE + c];
#pragma unroll
    for (int i = 0; i < 6; ++i) {
        const int e = tid + 512 * i, rr = e >> 6, ch = e & 63;
        if (rr < 47) {
            float a[8], g[8]; unpack8(la[i], a); unpack8(lg[i], g);
#pragma unroll
            for (int q = 0; q < 8; ++q) a[q] *= fsigm(g[q]);
            LAS f32x4* d = (LAS f32x4*)(yb + rr * 512 + 8 * ch);
            d[0] = (f32x4){a[0], a[1], a[2], a[3]}; d[1] = (f32x4){a[4], a[5], a[6], a[7]};
        }
    }
    __syncthreads();
    float acc[16];
#pragma unroll
    for (int t = 0; t < 16; ++t) acc[t] = bias;
#pragma unroll
    for (int kb = 0; kb < 32; kb += 8) {
        const LAS float* yp = yb + kb * 512 + c;
        float rows[23];
#pragma unroll
        for (int j = 0; j < 23; ++j) rows[j] = yp[j * 512];
#pragma unroll
        for (int t = 0; t < 16; ++t)
#pragma unroll
            for (int i = 0; i < 8; ++i) acc[t] += w[kb + i] * rows[t + i];
    }
#pragma unroll
    for (int t = 0; t < 16; ++t) sb[t * 516 + c] = acc[t];
    __syncthreads();
    {
        const int t = tid >> 5, j = tid & 31;
        const LAS f32x4* q = (const LAS f32x4*)(sb + t * 516 + 16 * j);
        float s1 = 0.f, s2 = 0.f;
#pragma unroll
        for (int i = 0; i < 4; ++i) { const f32x4 v = q[i]; s1 += (v.x + v.y) + (v.z + v.w); s2 += (v.x * v.x + v.y * v.y) + (v.z * v.z + v.w * v.w); }
#pragma unroll
        for (int o = 1; o < 32; o <<= 1) { s1 += __shfl_xor(s1, o); s2 += __shfl_xor(s2, o); }
        if (j == 0) { const float mean = s1 * (1.f / 512.f); const float var = fmaxf(s2 * (1.f / 512.f) - mean * mean, 0.f); st[2 * t] = mean; st[2 * t + 1] = rsqrtf(var + EPS); }
    }
    __syncthreads();
#pragma unroll
    for (int t = 0; t < 16; ++t) {
        const float y = (acc[t] - st[2 * t]) * st[2 * t + 1] * lgam + lbet;
        const float gate = __uint_as_float((unsigned)gt[t] << 16);
        const float o = (y * fsigm(y)) * (gate * fsigm(gate));
        YA[(size_t)(rowbase + t0 + t) * 512 + c] = (bf16)(cvt_pk_bf16(o, o) & 0xffffu);
    }
}

constexpr int HS_PITCH = 272, HS_S = 16 * HS_PITCH, HS_WAVE = 2 * HS_S;
struct SsmIdx { int lat, b, rg, go, NR; };
__device__ __forceinline__ SsmIdx ssm_decode(int it) {
    SsmIdx s;
    if (it < 512) { s.lat = 0; s.b = it >> 4; s.rg = (it >> 2) & 3; s.go = it & 3; s.NR = 4; }
    else { const int j = it - 512; s.lat = 1; s.b = j >> 6; s.rg = (j >> 2) & 15; s.go = j & 3; s.NR = 16; }
    return s;
}
#define CMUL_ADD(hr, hi_, lr, li, br, bi) do { const float _tr = __builtin_fmaf(-(li), (hi_), (br)), _ti = __builtin_fmaf((li), (hr), (bi)); const float _nr = __builtin_fmaf((lr), (hr), _tr), _ni = __builtin_fmaf((lr), (hi_), _ti); (hr) = _nr; (hi_) = _ni; } while (0)

template <int PASS>
__device__ __forceinline__ void ssm_item(KP P, int l, int it, LAS unsigned char* lds, int tid, int lane, int wid, int gsel) {
    RELOAD_P(P);
    asm volatile("" : "+s"(l)); asm volatile("" : "+v"(tid)); lane = tid & 63; wid = __builtin_amdgcn_readfirstlane(tid >> 6);
    const bf16* Z = (const bf16*)(P->ws + WS_Z);
    const SsmIdx S = ssm_decode(it);
    const int g = 8 * S.go + gsel;
    const int r32 = lane & 31, hi = lane >> 5;
    const int rb = S.lat ? MCTX + S.b * 1024 : S.b * 256;
    const int kA = (r32 & 3) + 4 * (r32 >> 3);
    const int t_start = 64 * S.rg;
    const int sr_base = S.lat ? 128 + S.b * 16 : S.b * 4;
    const bf16* zu = Z + (size_t)(rb + t_start + kA) * NCOL + C_SSMIN + 16 * g + 8 * hi;
    bf16x8 uf[4];
    if (PASS == 2) {
#pragma unroll
        for (int j = 0; j < 4; ++j) uf[j] = __builtin_bit_cast(bf16x8, *(const u32x4*)(zu + (size_t)(16 * j) * NCOL));
    }
    f32x2* E = (f32x2*)(P->ws + WS_E);
    const f32x2* LAM = (const f32x2*)(P->ws + WS_LAM);
    const bf16* BB = (const bf16*)(P->ws + WS_BB);
    const bf16* CT = (const bf16*)(P->ws + WS_CT);
    LAS unsigned char* hs = lds + wid * HS_WAVE;
    f32x4 yacc[4];
    if (PASS == 2) {
#pragma unroll
        for (int j = 0; j < 4; ++j) yacc[j] = (f32x4){0.f, 0.f, 0.f, 0.f};
    }
#pragma unroll
    for (int dir = 0; dir < 2; ++dir) {
        const int ldg = (l * 2 + dir) * 32 + g;
        bf16x8 bfr[2][2];
        f32x2 lam[2];
#pragma unroll
        for (int pt = 0; pt < 2; ++pt) {
            lam[pt] = LAM[(size_t)ldg * 64 + 32 * pt + r32];
#pragma unroll
            for (int ri = 0; ri < 2; ++ri) bfr[pt][ri] = __builtin_bit_cast(bf16x8, *(const u32x4*)(BB + ((size_t)(ldg * 2 + ri) * 64 + 32 * pt + r32) * 16 + 8 * hi));
        }
        float hr[2], hm[2];
        bf16x8 ctf[4];
        if (PASS == 1) { hr[0] = hr[1] = hm[0] = hm[1] = 0.f; }
        else {
            const int q4 = lane >> 4, cc = lane & 15;
#pragma unroll
            for (int kk = 0; kk < 4; ++kk) ctf[kk] = __builtin_bit_cast(bf16x8, *(const u32x4*)(CT + ((size_t)((l * 32 + g) * 2 + dir) * 16 + cc) * 128 + 32 * kk + 8 * q4));
#pragma unroll
            for (int pt = 0; pt < 2; ++pt) {
                float l64r = lam[pt].x, l64i = lam[pt].y;
#pragma unroll
                for (int q = 0; q < 6; ++q) { const float nr = l64r * l64r - l64i * l64i, ni = 2.f * l64r * l64i; l64r = nr; l64i = ni; }
                float cr = 0.f, ci = 0.f;
                if (S.lat) { const size_t si = ((size_t)((S.b * 2 + l) * 2 + dir) * 32 + g) * 64 + 32 * pt + r32; cr = P->in[I_SRE][si]; ci = P->in[I_SIM][si]; }
                {
                    const int n_it = dir == 0 ? S.rg : S.NR - 1 - S.rg;
                    const f32x2* Eb = E + ((size_t)(sr_base * 32 + g) * 2 + dir) * 64 + 32 * pt + r32;
                    for (int i0 = 0; i0 < n_it; i0 += 4) {
                        f32x2 e4[4];
#pragma unroll
                        for (int k = 0; k < 4; ++k) { const int i = min(i0 + k, n_it - 1); const int ri = dir == 0 ? i : S.NR - 1 - i; e4[k] = Eb[(size_t)ri * 4096]; }
#pragma unroll
                        for (int k = 0; k < 4; ++k) { const bool ok = i0 + k < n_it; const float nr = __builtin_fmaf(l64r, cr, __builtin_fmaf(-l64i, ci, e4[k].x)), ni = __builtin_fmaf(l64r, ci, __builtin_fmaf(l64i, cr, e4[k].y)); cr = ok ? nr : cr; ci = ok ? ni : ci; }
                    }
                }
                hr[pt] = cr; hm[pt] = ci;
            }
        }
#pragma unroll (PASS == 2 ? 4 : 1)
        for (int jj = 0; jj < 4; ++jj) {
            const int j = dir ? 3 - jj : jj;
            bf16x8 ufj;
            if (PASS == 2) ufj = uf[j]; else ufj = __builtin_bit_cast(bf16x8, *(const u32x4*)(zu + (size_t)(16 * j) * NCOL));
            const f32x16 zero16 = (f32x16){0.f, 0.f, 0.f, 0.f, 0.f, 0.f, 0.f, 0.f, 0.f, 0.f, 0.f, 0.f, 0.f, 0.f, 0.f, 0.f};
#pragma unroll
            for (int pt = 0; pt < 2; ++pt) {
                const f32x16 are = MFMA32(ufj, bfr[pt][0], zero16);
                const f32x16 aim = MFMA32(ufj, bfr[pt][1], zero16);
                LAS unsigned* hw = (LAS unsigned*)(hs + hi * HS_S + 4 * (32 * pt + r32));
#pragma unroll
                for (int rr = 0; rr < 16; ++rr) { const int r = dir ? 15 - rr : rr;
                    CMUL_ADD(hr[pt], hm[pt], lam[pt].x, lam[pt].y, are[r], aim[r]);
                    if (PASS == 2) hw[r * (HS_PITCH / 4)] = cvt_pk_bf16(hr[pt], hm[pt]); }
                __builtin_amdgcn_sched_barrier(0);
            }
            if (PASS == 2) {
                const int q4 = lane >> 4, n = lane & 15;
#pragma unroll
                for (int kk = 0; kk < 4; ++kk) { const bf16x8 hb = *(const LAS bf16x8*)(hs + n * HS_PITCH + 64 * kk + 16 * q4);
                    yacc[j] = MFMA16(ctf[kk], hb, yacc[j]); }
            }
        }
        if (hi == 0) {
            if (PASS == 1) {
#pragma unroll
                for (int pt = 0; pt < 2; ++pt) E[((size_t)((sr_base + S.rg) * 32 + g) * 2 + dir) * 64 + 32 * pt + r32] = (f32x2){hr[pt], hm[pt]};
            } else if (!S.lat && ((dir == 0 && S.rg == 3) || (dir == 1 && S.rg == 0))) {
#pragma unroll
                for (int pt = 0; pt < 2; ++pt) { const size_t oi = ((size_t)((S.b * 2 + l) * 2 + dir) * 32 + g) * 64 + 32 * pt + r32;
                    P->out[O_SRE + oi] = hr[pt]; P->out[O_SIM + oi] = hm[pt]; }
            }
        }
    }
    if (PASS == 2) {
        bf16* YB = (bf16*)(P->ws + WS_YB);
        const int q4 = lane >> 4, n = lane & 15;
        const f32x4 dv = *(const f32x4*)(P->in[I_SD] + l * 512 + 16 * g + 4 * q4);
#pragma unroll
        for (int j = 0; j < 4; ++j) {
            const size_t row = (size_t)(rb + t_start + 16 * j + n);
            const u32x2 uw = *(const u32x2*)(Z + row * NCOL + C_SSMIN + 16 * g + 4 * q4);
            float y[4];
            y[0] = yacc[j][0] + dv.x * bf_lo(uw.x); y[1] = yacc[j][1] + dv.y * bf_hi(uw.x); y[2] = yacc[j][2] + dv.z * bf_lo(uw.y); y[3] = yacc[j][3] + dv.w * bf_hi(uw.y);
#pragma unroll
            for (int i = 0; i < 4; ++i) { const float x = y[i]; y[i] = x * sigm(1.5957691216057308f * (x + 0.044715f * x * x * x)); }
            u32x2 w; w.x = cvt_pk_bf16(y[0], y[1]); w.y = cvt_pk_bf16(y[2], y[3]);
            *(u32x2*)(YB + row * 512 + 16 * g + 4 * q4) = w;
        }
    }
}

#ifdef DBG_NAIVE_STATE
__device__ __forceinline__ void naive_state_item(KP P, int l, int it, int tid) {
    RELOAD_P(P);
    asm volatile("" : "+s"(l)); asm volatile("" : "+v"(tid));
    const bf16* Z = (const bf16*)(P->ws + WS_Z);
    const int idx = it * 512 + tid; const int p = idx & 63, g = (idx >> 6) & 31, dir = (idx >> 11) & 1, b = idx >> 12;
    const int ti = ((l * 2 + dir) * 32 + g) * 64 + p;
    const float are = P->in[I_ARE][ti], aim = P->in[I_AIM][ti];
    const f32x2 lmb = ((const f32x2*)(P->ws + WS_LAM))[ti];
    const float lr = lmb.x, li = lmb.y;
    const float d2 = are * are + aim * aim, qr = ((lr - 1.0f) * are + li * aim) / d2, qi = (li * are - (lr - 1.0f) * aim) / d2;
    float bre[16], bim[16];
#pragma unroll
    for (int c = 0; c < 16; ++c) { const float br = P->in[I_BRE][(size_t)ti * 16 + c], bi = P->in[I_BIM][(size_t)ti * 16 + c]; bre[c] = qr * br - qi * bi; bim[c] = qr * bi + qi * br;
#ifdef DBG_BF16_B
        { const unsigned w = cvt_pk_bf16(bre[c], bim[c]); bre[c] = bf_lo(w); bim[c] = bf_hi(w); }
#endif
#ifdef DBG_USE_BB
        { const bf16* BBt = (const bf16*)(P->ws + WS_BB); const int ldg_ = (l * 2 + dir) * 32 + g;
          bre[c] = __uint_as_float((unsigned)BBt[((size_t)(ldg_ * 2 + 0) * 64 + p) * 16 + c] << 16); bim[c] = __uint_as_float((unsigned)BBt[((size_t)(ldg_ * 2 + 1) * 64 + p) * 16 + c] << 16); }
#endif
    }
    float hr = 0.f, hm = 0.f;
#pragma unroll 1
    for (int tt = 0; tt < 256; ++tt) {
        const int t = dir ? 255 - tt : tt;
        const bf16* src = Z + (size_t)(b * 256 + t) * NCOL + C_SSMIN + 16 * g;
        float u[16]; unpack8(*(const u32x4*)src, u); unpack8(*(const u32x4*)(src + 8), u + 8);
        float br = 0.f, bi = 0.f;
#pragma unroll
        for (int c = 0; c < 16; ++c) { br += bre[c] * u[c]; bi += bim[c] * u[c]; }
        CMUL_ADD(hr, hm, lr, li, br, bi);
    }
    const size_t oi = ((size_t)((b * 2 + l) * 2 + dir) * 32 + g) * 64 + p;
#if defined(DBG_SPLIT_HI) && defined(DBG_SWAP)
    if ((b & 1) == DBG_SPLIT_HI)
#elif defined(DBG_SPLIT_HI)
    if ((b & 1) != DBG_SPLIT_HI)
#endif
    { P->out[O_SRE + oi] = hr; P->out[O_SIM + oi] = hm; }
}
#endif

__device__ __forceinline__ void state_item(KP P, int l, int it, int tid, int lane, int wid) {
    RELOAD_P(P);
    asm volatile("" : "+s"(l)); asm volatile("" : "+v"(tid)); lane = tid & 63; wid = __builtin_amdgcn_readfirstlane(tid >> 6);
    const bf16* Z = (const bf16*)(P->ws + WS_Z);
    const int w = __builtin_amdgcn_readfirstlane(it * 8 + wid);
    const int g = w & 31, dir = (w >> 5) & 1, b = w >> 6;
    const int r32 = lane & 31, hi = lane >> 5;
    const int kA = (r32 & 3) + 4 * (r32 >> 3);
    const int ldg = (l * 2 + dir) * 32 + g;
    const f32x2* LAM = (const f32x2*)(P->ws + WS_LAM);
    const bf16* BB = (const bf16*)(P->ws + WS_BB);
    bf16x8 bfr[2][2]; f32x2 lam[2]; float hr[2] = {0.f, 0.f}, hm[2] = {0.f, 0.f};
#pragma unroll
    for (int pt = 0; pt < 2; ++pt) {
        lam[pt] = LAM[(size_t)ldg * 64 + 32 * pt + r32];
#pragma unroll
        for (int ri = 0; ri < 2; ++ri) bfr[pt][ri] = __builtin_bit_cast(bf16x8, *(const u32x4*)(BB + ((size_t)(ldg * 2 + ri) * 64 + 32 * pt + r32) * 16 + 8 * hi));
    }
    const bf16* zb = Z + (size_t)(b * 256 + kA) * NCOL + C_SSMIN + 16 * g + 8 * hi;
    const f32x16 z16 = (f32x16){0.f, 0.f, 0.f, 0.f, 0.f, 0.f, 0.f, 0.f, 0.f, 0.f, 0.f, 0.f, 0.f, 0.f, 0.f, 0.f};
#pragma unroll 1
    for (int q = 0; q < 16; q += 2) {
        const int j0 = dir ? 15 - q : q, j1 = dir ? 14 - q : q + 1;
        const bf16x8 u0 = __builtin_bit_cast(bf16x8, *(const u32x4*)(zb + (size_t)(16 * j0) * NCOL));
        const bf16x8 u1 = __builtin_bit_cast(bf16x8, *(const u32x4*)(zb + (size_t)(16 * j1) * NCOL));
#pragma unroll
        for (int half = 0; half < 2; ++half) {
            const bf16x8 ux = half ? u1 : u0;
#pragma unroll
            for (int pt = 0; pt < 2; ++pt) {
                const f32x16 xr = MFMA32(ux, bfr[pt][0], z16);
                const f32x16 xi = MFMA32(ux, bfr[pt][1], z16);
                if (dir == 0) {
#pragma unroll
                    for (int r = 0; r < 16; ++r) CMUL_ADD(hr[pt], hm[pt], lam[pt].x, lam[pt].y, xr[r], xi[r]);
                } else {
#pragma unroll
                    for (int r = 15; r >= 0; --r) CMUL_ADD(hr[pt], hm[pt], lam[pt].x, lam[pt].y, xr[r], xi[r]);
                }
            }
        }
    }
    if (hi == 0) {
#pragma unroll
        for (int pt = 0; pt < 2; ++pt) { const size_t oi = ((size_t)((b * 2 + l) * 2 + dir) * 32 + g) * 64 + 32 * pt + r32;
            P->out[O_SRE + oi] = hr[pt]; P->out[O_SIM + oi] = hm[pt]; }
    }
}
#define XB_TMO      128
#define XB_XCNT(j)  (256  + 64 * (j))
#define XB_XSUB(j)  (1280 + 64 * (j))
#define XB_XGEN(j)  (2304 + 64 * (j))
#define XB_TOP      3328
#define XB_TOPGEN   3392
#define XCD_BAR_WORDS 3456
#define XB_SPIN_CAP (1u << 18)

__device__ __forceinline__ unsigned xb_ld(unsigned* p)              { return __hip_atomic_load(p, __ATOMIC_RELAXED, __HIP_MEMORY_SCOPE_AGENT); }
__device__ __forceinline__ unsigned xb_add(unsigned* p, unsigned v) { return __hip_atomic_fetch_add(p, v, __ATOMIC_RELAXED, __HIP_MEMORY_SCOPE_AGENT); }
__device__ __forceinline__ unsigned xb_xcc_id() { return (unsigned)__builtin_amdgcn_s_getreg((3 << 11) | 20) & 0xFu; }
#define XB_SPIN(cond, bar) do { unsigned _sp = 0; while (cond) { __builtin_amdgcn_s_sleep(1); \
    if ((++_sp & 255u) == 0u) { if (xb_ld(&(bar)[XB_TMO])) break; if (_sp > XB_SPIN_CAP) { atomicAdd(&(bar)[XB_TMO], 1u); break; } } } } while (0)

struct XcdBarrier {
    unsigned* bar; unsigned x;
    volatile LAS unsigned* st;
};

__device__ __forceinline__ XcdBarrier xcd_barrier_post(unsigned* bar, volatile LAS unsigned* st) {
    XcdBarrier b; b.bar = bar; b.x = xb_xcc_id(); b.st = st;
    if (threadIdx.x == 0) (void)xb_add(&bar[XB_XCNT(b.x)], 1u);
    return b;
}
__device__ __forceinline__ void xcd_barrier_complete(unsigned* bar, unsigned x, unsigned& nloc, unsigned& nx) {
    const unsigned G = gridDim.x * gridDim.y * gridDim.z;
    unsigned sum, cnt, mine, sp = 0u;
    for (;;) {
        sum = 0u; cnt = 0u; mine = 0u;
#pragma unroll
        for (unsigned j = 0; j < 16; ++j) { const unsigned c = xb_ld(&bar[XB_XCNT(j)]); sum += c; cnt += (c > 0u) ? 1u : 0u; mine = (j == x) ? c : mine; }
        if (sum == G) break;
        __builtin_amdgcn_s_sleep(1);
        if ((++sp & 255u) == 0u) { if (xb_ld(&bar[XB_TMO])) break; if (sp > XB_SPIN_CAP) { atomicAdd(&bar[XB_TMO], 1u); break; } }
    }
    nloc = mine > 0u ? mine : 1u; nx = cnt > 0u ? cnt : 1u;
}

__device__ __forceinline__ void xcd_barrier(const XcdBarrier& b) {
    asm volatile("s_waitcnt vmcnt(0)" ::: "memory");
    __syncthreads();
    if (threadIdx.x == 0) {
        unsigned* bar = b.bar;
        __builtin_amdgcn_s_waitcnt(0);
        unsigned nloc = b.st[0], nx = b.st[1];
        if (nloc == 0u) { xcd_barrier_complete(bar, b.x, nloc, nx); b.st[0] = nloc; b.st[1] = nx; }
        const unsigned old = xb_add(&bar[XB_XSUB(b.x)], 1u);
        const unsigned gen = old / nloc;
        if (old + 1u == (gen + 1u) * nloc) {
            __builtin_amdgcn_fence(__ATOMIC_RELEASE, "agent");
            asm volatile("s_waitcnt vmcnt(0)" ::: "memory");
            const unsigned og = xb_add(&bar[XB_TOP], 1u);
            const unsigned tg = og / nx;
            if (og + 1u == (tg + 1u) * nx) xb_add(&bar[XB_TOPGEN], 1u);
            else XB_SPIN(xb_ld(&bar[XB_TOPGEN]) == tg, bar);
            __builtin_amdgcn_fence(__ATOMIC_ACQUIRE, "agent");
            xb_add(&bar[XB_XGEN(b.x)], 1u);
            asm volatile("s_waitcnt vmcnt(0)" ::: "memory");
        } else {
            XB_SPIN(xb_ld(&bar[XB_XGEN(b.x)]) == gen, bar);
            __builtin_amdgcn_fence(__ATOMIC_ACQUIRE, "agent");
            asm volatile("s_waitcnt vmcnt(0)" ::: "memory");
        }
    }
    __syncthreads();
}


constexpr int CW_XBAR = 32768;
#ifndef REP_SYNC
#define REP_SYNC 1
#endif
#ifndef REP_ATT
#define REP_ATT 1
#endif
#ifndef REP_SSM1
#define REP_SSM1 1
#endif
#ifndef REP_CONV
#define REP_CONV 1
#endif
#ifndef REP_P2
#define REP_P2 1
#endif
#ifndef REP_P3
#define REP_P3 1
#endif
#ifndef REP_P4
#define REP_P4 1
#endif
#ifndef REP_P56
#define REP_P56 1
#endif
__device__ __forceinline__ void grid_sync_all(cg::grid_group& grid) {
    asm volatile("s_waitcnt vmcnt(0) lgkmcnt(0)" ::: "memory");
    grid.sync();
    __builtin_amdgcn_fence(__ATOMIC_ACQUIRE, "agent");
    asm volatile("s_waitcnt vmcnt(0)" ::: "memory");
}
__device__ __forceinline__ int q_next(unsigned* ctr, LAS int* slot, int tid) {
    __syncthreads();
    if (tid == 0) *slot = (int)atomicAdd(ctr, 1u);
    __syncthreads();
    return *slot;
}

__global__ void __launch_bounds__(512, 2) fwd_kernel(Params Pk_unused) {
    KP P = (KP)__builtin_amdgcn_kernarg_segment_ptr();
    extern __shared__ __attribute__((aligned(16))) unsigned char lds_raw[];
    cg::grid_group grid = cg::this_grid();
    LAS unsigned char* lds = (LAS unsigned char*)lds_raw;
    LAS int* qslot = (LAS int*)(lds + 131072 + 1024);
    const int tid = threadIdx.x, lane = tid & 63, wid = __builtin_amdgcn_readfirstlane(tid >> 6);
    volatile LAS unsigned* xst = (volatile LAS unsigned*)(lds + 131072 + 2048);
    if (tid < 2) xst[tid] = 0u;
    __syncthreads();
    const XcdBarrier xbar = xcd_barrier_post((unsigned*)(P->ws + WS_CTL) + CW_XBAR, xst);

#ifndef REP_P0
#define REP_P0 1
#endif
    for (int r0_ = 0; r0_ < REP_P0; ++r0_) { if (r0_) __syncthreads(); p0_prologue(P, lds, tid, lane, wid); }
    for (int rs_ = 0; rs_ < REP_SYNC; ++rs_) xcd_barrier(xbar);
    if (xb_ld(&xbar.bar[XB_TMO]) != 0u) grid.sync();

#pragma unroll 1
    for (int l = 0; l < 2; ++l) {
#ifndef REP_P1
#define REP_P1 1
#endif
        for (int r1_ = 0; r1_ < REP_P1; ++r1_) p1_rows(P, l, lane, wid);
        for (int rs_ = 0; rs_ < REP_SYNC; ++rs_) xcd_barrier(xbar);
#ifndef NO_P2
#pragma unroll 1
        for (int rep_ = 0; rep_ < REP_P2; ++rep_) {
            RELOAD_P(P); unsigned char* ws = P->ws; const unsigned char* wl = ws + WS_W + (size_t)l * W_LAYER_B; bf16* Z = (bf16*)(ws + WS_Z); unsigned* ctl = (unsigned*)(ws + WS_CTL); (void)wl; (void)Z; (void)ctl;
            pg8::Gemm g{(const bf16*)(ws + WS_H), (const bf16*)wl, MTOK, NCOL, DM};
            pg8::WinOrder S{(int)gridDim.x, (int)blockIdx.x};
            pg8::EpiPlain E{Z, NCOL};
            pg8::gemm_phase<pg8::EpiPlain, pg8::WinOrder, true, true>(lds, g, S, E);
        }
#endif
        for (int rs_ = 0; rs_ < REP_SYNC; ++rs_) xcd_barrier(xbar);
#ifndef NO_P3
#pragma unroll 1
        for (int rep_ = 0; rep_ < REP_P3; ++rep_) {
            RELOAD_P(P); unsigned char* ws = P->ws; const unsigned char* wl = ws + WS_W + (size_t)l * W_LAYER_B; bf16* Z = (bf16*)(ws + WS_Z); unsigned* ctl = (unsigned*)(ws + WS_CTL); (void)wl; (void)Z; (void)ctl;
            unsigned* ctr = ctl + 64 * (1 + 2 * l) + 320 * rep_;
            unsigned pre0 = 0u; if (tid == 0) pre0 = atomicAdd(ctr, 1u);
            if (gridDim.x == 256) {
#pragma unroll 1
                for (int k = 0; k < 3; ++k) {
                    int item, gs;
                    if (k < 2) { item = (int)blockIdx.x + 256 * k; gs = wid; }
                    else { if (wid >= 4) break; item = 512 + ((int)blockIdx.x >> 1); gs = ((int)blockIdx.x & 1) * 4 + wid; }
                    ssm_item<1>(P, l, item, lds, tid, lane, wid, gs);
                }
            } else {
                for (int item = (int)blockIdx.x; item < 640; item += (int)gridDim.x) ssm_item<1>(P, l, item, lds, tid, lane, wid, wid);
            }
            for (bool first = true;; first = false) {
                int it;
                if (first) { __syncthreads(); if (tid == 0) *qslot = (int)pre0; __syncthreads(); it = *qslot; } else it = q_next(ctr, qslot, tid);
                if (it >= 1016) break;
                if (it < 64 || (it >= 760 && it < 1016)) {
                    const int ia = it < 64 ? it : it - 696;
                    for (int ra_ = 0; ra_ < REP_ATT; ++ra_) { if (ra_) __syncthreads(); attn_item(P, l, ia, lds, tid, lane, wid); }
                } else if (it < 120) {
                    pg8::Gemm g{(const bf16*)(ws + WS_H), (const bf16*)wl, MTOK, NCOL, DM};
                    pg8::OneUnit S1{1024 + (it - 64)};
                    pg8::EpiPlain E{Z, NCOL};
                    pg8::gemm_phase<pg8::EpiPlain, pg8::OneUnit, true, true>(lds, g, S1, E);
                } else {
                    for (int ra_ = 0; ra_ < REP_CONV; ++ra_) { if (ra_) __syncthreads(); conv_item(P, l, it - 120, lds, tid, lane, wid); }
                }
            }
        }
#endif
        for (int rs_ = 0; rs_ < REP_SYNC; ++rs_) xcd_barrier(xbar);
#ifndef NO_P4
#pragma unroll 1
        for (int rep_ = 0; rep_ < REP_P4; ++rep_) {
            RELOAD_P(P); unsigned char* ws = P->ws; const unsigned char* wl = ws + WS_W + (size_t)l * W_LAYER_B; bf16* Z = (bf16*)(ws + WS_Z); unsigned* ctl = (unsigned*)(ws + WS_CTL); (void)wl; (void)Z; (void)ctl;
            unsigned* ctr = ctl + 64 * (2 + 2 * l) + 320 * rep_;
            (void)ctr;
            if (gridDim.x == 256) {
#pragma unroll 1
                for (int k = 0; k < 3; ++k) {
                    int item, gs;
                    if (k < 2) { item = (int)blockIdx.x + 256 * k; gs = wid; }
                    else { if (wid >= 4) break; item = 512 + ((int)blockIdx.x >> 1); gs = ((int)blockIdx.x & 1) * 4 + wid; }
                    const int it2 = item < 128 ? 512 + item : item - 128;
                    ssm_item<2>(P, l, it2, lds, tid, lane, wid, gs);
                }
            } else {
                for (int item = (int)blockIdx.x; item < 640; item += (int)gridDim.x) { const int it2 = item < 128 ? 512 + item : item - 128; ssm_item<2>(P, l, it2, lds, tid, lane, wid, wid); }
            }
#ifdef DBG_NAIVE_STATE
#pragma unroll 1
            for (int it = blockIdx.x; it < 256; it += gridDim.x) naive_state_item(P, l, it, tid);
#endif
        }
#endif
        for (int rs_ = 0; rs_ < REP_SYNC; ++rs_) xcd_barrier(xbar);
#pragma unroll 1
        for (int rep_ = 0; rep_ < REP_P56; ++rep_) {
            RELOAD_P(P); unsigned char* ws = P->ws; const unsigned char* wl = ws + WS_W + (size_t)l * W_LAYER_B; bf16* Z = (bf16*)(ws + WS_Z);
            const int G = (int)gridDim.x, NB = G >= 200 ? 160 : (G * 5) / 8;
            if ((int)blockIdx.x < NB) {
                pg8::Gemm g{(const bf16*)(ws + WS_ABR), (const bf16*)(wl + W_IN_B + W_GLU_B), 3 * MTOK, 3 * 1024, 512};
                pg8::BranchOrderX S{NB, (int)blockIdx.x};
                pg8::EpiBranch E{(bf16*)(ws + WS_H), Z + C_MERGE, NCOL};
                pg8::gemm_phase<pg8::EpiBranch, pg8::BranchOrderX, true, true>(lds, g, S, E);
            } else {
                pg8::Gemm g{(const bf16*)(ws + WS_YB), (const bf16*)(wl + W_IN_B), MTOK, 1024, 512};
                pg8::GluOrder S{G - NB, (int)blockIdx.x - NB};
                pg8::EpiGlu E{(bf16*)(ws + WS_ABR) + (size_t)MTOK * 512, Z + C_SGATE, NCOL};
                pg8::gemm_phase<pg8::EpiGlu, pg8::GluOrder, true, true>(lds, g, S, E);
            }
        }
        for (int rs_ = 0; rs_ < REP_SYNC; ++rs_) xcd_barrier(xbar);
#pragma unroll 1
        for (int rep_ = 0; rep_ < 1; ++rep_) {
            RELOAD_P(P); unsigned char* ws = P->ws; const unsigned char* wl = ws + WS_W + (size_t)l * W_LAYER_B; bf16* Z = (bf16*)(ws + WS_Z);
            pg8::Gemm g{(const bf16*)(ws + WS_ABR), (const bf16*)(wl + W_IN_B + W_GLU_B), 3 * MTOK, 3 * 1024, 512};
            pg8::BranchOrderY S{(int)gridDim.x, (int)blockIdx.x};
            pg8::EpiBranch E{(bf16*)(ws + WS_H), Z + C_MERGE, NCOL};
            pg8::gemm_phase<pg8::EpiBranch, pg8::BranchOrderY, true, true>(lds, g, S, E);
            if (l == 0 && defer_l1_weights() && blockIdx.x >= 160) convert_weights(P, 1, 1, 160, lds);
        }
        for (int rs_ = 0; rs_ < REP_SYNC; ++rs_) xcd_barrier(xbar);
#ifndef REP_P7L0
#define REP_P7L0 1
#endif
#pragma unroll 1
        for (int rep7_ = 0; rep7_ < (l == 0 ? REP_P7L0 : 1); ++rep7_) {
            RELOAD_P(P); unsigned char* ws = P->ws; const unsigned char* wl = ws + WS_W + (size_t)l * W_LAYER_B; bf16* Z = (bf16*)(ws + WS_Z); unsigned* ctl = (unsigned*)(ws + WS_CTL); (void)wl; (void)Z; (void)ctl;
            pg8::Gemm g{(const bf16*)(ws + WS_H), (const bf16*)(wl + W_IN_B + W_GLU_B + W_BR_B), MTOK, 1024, 1024};
            pg8::StaticOrder S; S.init(MTOK, 1024, (int)gridDim.x, (int)blockIdx.x);
            const float* gate = (const float*)(ws + WS_MODS) + (size_t)l * 3 * 3072 + 2048;
            pg8::EpiResid E{l == 0 ? P->in[I_XP] : P->out, l == 0 ? P->in[I_XS] : P->out + (size_t)MCTX * DM, P->out, gate};
            pg8::gemm_phase<pg8::EpiResid, pg8::StaticOrder, true, true>(lds, g, S, E);
            if (l == 0 && defer_l1_weights() && blockIdx.x >= 160) convert_weights(P, 1, 0, 160, lds);
        }
        if (l == 0) for (int rs_ = 0; rs_ < REP_SYNC; ++rs_) xcd_barrier(xbar);
    }
}

extern "C" void kernel_launch(void* const* d_in, const int* in_sizes, int n_in, void* d_out, int out_size, void* d_ws, size_t ws_size, hipStream_t stream) {
    static int grid = 0;
    if (grid == 0) {
        if (n_in != 31 || ws_size < WS_END) { fprintf(stderr, "kernel_launch: unexpected n_in %d / ws_size %zu (need %zu)\n", n_in, ws_size, (size_t)WS_END); grid = -1; return; }
        int dev = 0, cus = 0, per_cu = 0;
        hipGetDevice(&dev);
        hipDeviceGetAttribute(&cus, hipDeviceAttributeMultiprocessorCount, dev);
        if (hipFuncSetAttribute((const void*)fwd_kernel, hipFuncAttributeMaxDynamicSharedMemorySize, LDS_BYTES) != hipSuccess) { fprintf(stderr, "kernel_launch: hipFuncSetAttribute failed\n"); grid = -1; return; }
        if (hipOccupancyMaxActiveBlocksPerMultiprocessor(&per_cu, (const void*)fwd_kernel, 512, LDS_BYTES) != hipSuccess || per_cu < 1) { fprintf(stderr, "kernel_launch: occupancy query says %d\n", per_cu); (void)hipGetLastError(); per_cu = 1; }
        grid = cus * 1;
    }
    if (grid < 0) return;
    (void)hipMemsetAsync((char*)d_ws + WS_CTL, 0, CTL_ZERO_BYTES, stream);
    Params p{};
    for (int i = 0; i < 31; ++i) p.in[i] = (const float*)d_in[i];
    p.out = (float*)d_out; p.ws = (unsigned char*)d_ws;
    void* args[] = {&p};
    hipError_t e = hipLaunchCooperativeKernel((const void*)fwd_kernel, dim3(grid), dim3(512), args, LDS_BYTES, stream);
    if (e != hipSuccess) fprintf(stderr, "cooperative launch failed: %s (grid %d)\n", hipGetErrorString(e), grid);
}
```

```cpp
#include <hip/hip_runtime.h>
#include <hip/hip_cooperative_groups.h>
#include <cstdio>
#include <cstdint>
#include <cmath>
namespace cg = cooperative_groups;
namespace pg8 {
#define PG8_LAS __attribute__((address_space(3)))
typedef unsigned short bf16_t;
typedef short bf16x8 __attribute__((ext_vector_type(8)));
typedef float f32x4 __attribute__((ext_vector_type(4)));
typedef unsigned u32x4 __attribute__((ext_vector_type(4)));
constexpr int BM = 256, BK = 64, HALF = 128, HTB = HALF * BK * 2  , STAGE_BYTES = 8 * HTB, NXCD = 8, WGM = 8;

__host__ __device__ __forceinline__ int lds_byte(int r, int c) { const int st = (r >> 4) * 2 + (c >> 5), rr = r & 15, cc = c & 31, ob = rr * 64 + cc * 2; return st * 1024 + (ob ^ (((ob >> 9) & 1) << 5)); }
__host__ __device__ __forceinline__ void stage_rc(int b, int& R, int& C) { const int st = b / 1024, sb = b % 1024, swz = sb ^ (((sb >> 9) & 1) << 5); R = (st >> 1) * 16 + swz / 64; C = (st & 1) * 32 + (swz % 64) / 2; }
__host__ __device__ __forceinline__ int perm32(int rho) { const int n = rho >> 4, i = rho & 15; return 8 * (i >> 2) + 4 * n + (i & 3); }

struct Unit { int pm, pn; };
struct Gemm { const bf16_t* A; const bf16_t* Bt; int M, N, K; };

struct StaticOrder {
    int nM, nN, nwg, G, c;
    __host__ __device__ void init(int M, int N, int G_, int c_) { nM = M / BM; nN = N / BM; nwg = nM * nN; G = G_; c = c_; }
    __host__ __device__ bool next(int i, Unit& u) const {
        const long L = (long)i * G + c; if (L >= nwg) return false;
        int wgid = (int)L; { const int q = nwg / NXCD, r = nwg % NXCD, xcd = wgid % NXCD, off = wgid / NXCD; wgid = (xcd < r ? xcd * (q + 1) : r * (q + 1) + (xcd - r) * q) + off; }
        const int nig = WGM * nN, gid = wgid / nig, fm = gid * WGM, gsz = (nM - fm) < WGM ? (nM - fm) : WGM;
        u.pm = fm + ((wgid % nig) % gsz); u.pn = (wgid % nig) / gsz; return true;
    }
    __device__ __forceinline__ void a_ready(const Unit&) const {}
    __device__ __forceinline__ void done(const Unit&) const {}
};

__device__ __forceinline__ unsigned cvt_pk_bf16(float lo, float hi) { unsigned r; asm volatile("v_cvt_pk_bf16_f32 %0, %1, %2" : "=v"(r) : "v"(lo), "v"(hi)); return r; }
typedef float f32x2 __attribute__((ext_vector_type(2)));
typedef unsigned u32x4e __attribute__((ext_vector_type(4)));
__device__ __forceinline__ float bf_lo(unsigned w) { return __uint_as_float(w << 16); }
__device__ __forceinline__ float bf_hi(unsigned w) { return __uint_as_float(w & 0xffff0000u); }
__device__ __forceinline__ float sigm(float x) { return __builtin_amdgcn_rcpf(1.f + __builtin_amdgcn_exp2f(-1.4426950408889634f * x)); }
__device__ __forceinline__ float silu_f(float x) { return x * __builtin_amdgcn_rcpf(1.f + __builtin_amdgcn_exp2f(-1.4426950408889634f * x)); }
__device__ __forceinline__ float glu3(float a, float b, float g) { return a * g * __builtin_amdgcn_rcpf((1.f + __builtin_amdgcn_exp2f(-1.4426950408889634f * b)) * (1.f + __builtin_amdgcn_exp2f(-1.4426950408889634f * g))); }

struct EpiPlain {
    static constexpr bool PERM = true, AFTER_DRAIN = false;
    bf16_t* O; int ldc;
    __device__ __forceinline__ void operator()(const f32x4 (&acc)[2][2][4][2], const Unit& u, int wr, int wc, int fr, int fq) const {
        const int row0 = u.pm * BM + wr * 64 + fr, col0 = u.pn * BM + wc * 32 + 8 * fq;
#pragma unroll
        for (int ai = 0; ai < 2; ++ai)
#pragma unroll
            for (int m = 0; m < 4; ++m) { bf16_t* rowp = O + (size_t)(row0 + ai * HALF + m * 16) * ldc + col0;
#pragma unroll
                for (int bj = 0; bj < 2; ++bj) { const f32x4 v0 = acc[ai][bj][m][0], v1 = acc[ai][bj][m][1];
                    u32x4e w; w.x = cvt_pk_bf16(v0[0], v0[1]); w.y = cvt_pk_bf16(v0[2], v0[3]); w.z = cvt_pk_bf16(v1[0], v1[1]); w.w = cvt_pk_bf16(v1[2], v1[3]);
                    *(u32x4e*)(rowp + bj * HALF) = w; } }
    }
};
struct EpiGlu {
    static constexpr bool PERM = true, AFTER_DRAIN = false;
    bf16_t* O; const bf16_t* Zg; int ldz;
    __device__ __forceinline__ void operator()(const f32x4 (&acc)[2][2][4][2], const Unit& u, int wr, int wc, int fr, int fq) const {
        const int row0 = u.pm * BM + wr * 64 + fr, oc0 = u.pn * 128 + wc * 32 + 8 * fq;
#pragma unroll
        for (int ai = 0; ai < 2; ++ai)
#pragma unroll
            for (int m = 0; m < 4; ++m) { const int r = row0 + ai * HALF + m * 16;
                const u32x4e gz = *(const u32x4e*)(Zg + (size_t)r * ldz + oc0);
                const f32x4 a0 = acc[ai][0][m][0], a1 = acc[ai][0][m][1], b0 = acc[ai][1][m][0], b1 = acc[ai][1][m][1];
                float o[8];
                o[0] = glu3(a0[0], b0[0], bf_lo(gz.x)); o[1] = glu3(a0[1], b0[1], bf_hi(gz.x));
                o[2] = glu3(a0[2], b0[2], bf_lo(gz.y)); o[3] = glu3(a0[3], b0[3], bf_hi(gz.y));
                o[4] = glu3(a1[0], b1[0], bf_lo(gz.z)); o[5] = glu3(a1[1], b1[1], bf_hi(gz.z));
                o[6] = glu3(a1[2], b1[2], bf_lo(gz.w)); o[7] = glu3(a1[3], b1[3], bf_hi(gz.w));
                u32x4e w; w.x = cvt_pk_bf16(o[0], o[1]); w.y = cvt_pk_bf16(o[2], o[3]); w.z = cvt_pk_bf16(o[4], o[5]); w.w = cvt_pk_bf16(o[6], o[7]);
                *(u32x4e*)(O + (size_t)r * 512 + oc0) = w; }
    }
};
struct EpiBranch {
    static constexpr bool PERM = true, AFTER_DRAIN = false;
    bf16_t* MIX; const bf16_t* Zm; int ldz;
    __device__ __forceinline__ void operator()(const f32x4 (&acc)[2][2][4][2], const Unit& u, int wr, int wc, int fr, int fq) const {
        const int br = u.pn >> 2, pn = u.pn & 3, pm = u.pm - 40 * br;
        const int row0 = pm * BM + wr * 64 + fr, col0 = pn * BM + wc * 32 + 8 * fq;
#pragma unroll
        for (int ai = 0; ai < 2; ++ai)
#pragma unroll
            for (int m = 0; m < 4; ++m) { const int r = row0 + ai * HALF + m * 16;
#pragma unroll
                for (int bj = 0; bj < 2; ++bj) { const int c = col0 + bj * HALF;
                    const u32x4e gz = *(const u32x4e*)(Zm + (size_t)r * ldz + br * 1024 + c);
                    u32x4e pv = (u32x4e){0u, 0u, 0u, 0u};
                    if (br > 0) pv = *(const u32x4e*)(MIX + (size_t)r * 1024 + c);
                    const f32x4 v0 = acc[ai][bj][m][0], v1 = acc[ai][bj][m][1];
                    float o[8];
                    o[0] = v0[0] * sigm(bf_lo(gz.x)) + bf_lo(pv.x); o[1] = v0[1] * sigm(bf_hi(gz.x)) + bf_hi(pv.x);
                    o[2] = v0[2] * sigm(bf_lo(gz.y)) + bf_lo(pv.y); o[3] = v0[3] * sigm(bf_hi(gz.y)) + bf_hi(pv.y);
                    o[4] = v1[0] * sigm(bf_lo(gz.z)) + bf_lo(pv.z); o[5] = v1[1] * sigm(bf_hi(gz.z)) + bf_hi(pv.z);
                    o[6] = v1[2] * sigm(bf_lo(gz.w)) + bf_lo(pv.w); o[7] = v1[3] * sigm(bf_hi(gz.w)) + bf_hi(pv.w);
                    u32x4e w; w.x = cvt_pk_bf16(o[0], o[1]); w.y = cvt_pk_bf16(o[2], o[3]); w.z = cvt_pk_bf16(o[4], o[5]); w.w = cvt_pk_bf16(o[6], o[7]);
                    *(u32x4e*)(MIX + (size_t)r * 1024 + c) = w; } }
    }
};
struct WinOrder {
    int G, c;
    __device__ __forceinline__ static void unit_of(int W, Unit& u) { const int gid = W / 216, rr = W % 216; u.pm = gid * 8 + (rr & 7); u.pn = rr >> 3; }
    __device__ __forceinline__ bool next(int i, Unit& u) const {
        const int L = i * G + c; if (L >= 1024) return false;
        unit_of((L & 7) * 128 + (L >> 3), u); return true;
    }
    __device__ __forceinline__ void a_ready(const Unit&) const {}
    __device__ __forceinline__ void done(const Unit&) const {}
};
struct OneUnit {
    int W;
    __device__ __forceinline__ bool next(int i, Unit& u) const { if (i > 0) return false; WinOrder::unit_of(W, u); return true; }
    __device__ __forceinline__ void a_ready(const Unit&) const {}
    __device__ __forceinline__ void done(const Unit&) const {}
};
struct BranchOrderX {
    int NB, c;
    __device__ __forceinline__ bool next(int i, Unit& u) const {
        const int tI = (i >> 1) * NB + c, br = (i & 1) * 2; if (tI >= 160) return false;
        u.pm = br * 40 + (tI >> 2); u.pn = br * 4 + (tI & 3); return true;
    }
    __device__ __forceinline__ void a_ready(const Unit&) const {}
    __device__ __forceinline__ void done(const Unit&) const {}
};
struct GluOrder {
    int NG, c;
    __device__ __forceinline__ bool next(int i, Unit& u) const {
        const int tI = i * NG + c; if (tI >= 160) return false;
        u.pm = tI >> 2; u.pn = tI & 3; return true;
    }
    __device__ __forceinline__ void a_ready(const Unit&) const {}
    __device__ __forceinline__ void done(const Unit&) const {}
};
struct BranchOrderY {
    int G, c;
    __device__ __forceinline__ bool next(int i, Unit& u) const {
        const int tI = i * G + c; if (tI >= 160) return false;
        u.pm = 40 + (tI >> 2); u.pn = 4 + (tI & 3); return true;
    }
    __device__ __forceinline__ void a_ready(const Unit&) const {}
    __device__ __forceinline__ void done(const Unit&) const {}
};
struct BranchOrder {
    int G, c;
    __device__ __forceinline__ bool next(int i, Unit& u) const {
        const int tI = (i / 3) * G + c, br = i % 3; if (tI >= 160) return false;
        u.pm = br * 40 + (tI >> 2); u.pn = br * 4 + (tI & 3); return true;
    }
    __device__ __forceinline__ void a_ready(const Unit&) const {}
    __device__ __forceinline__ void done(const Unit&) const {}
};
struct EpiResid {
    static constexpr bool PERM = false, AFTER_DRAIN = false;
    const float* base_ctx; const float* base_lat; float* out; const float* gate;
    __device__ __forceinline__ void operator()(const f32x4 (&acc)[2][2][4][2], const Unit& u, int wr, int wc, int fr, int fq) const {
        const int row0 = u.pm * BM + wr * 64 + fr, col0 = u.pn * BM + wc * 32 + 4 * fq;
        const int cond = u.pm < 32 ? 0 : 1 + ((u.pm - 32) >> 2);
        const float* bp = u.pm < 32 ? base_ctx : base_lat - (size_t)8192 * 1024;
        f32x4 gv[2][2];
#pragma unroll
        for (int bj = 0; bj < 2; ++bj)
#pragma unroll
            for (int n = 0; n < 2; ++n) gv[bj][n] = *(const f32x4*)(gate + cond * 3072 + col0 + bj * HALF + n * 16);
#pragma unroll
        for (int ai = 0; ai < 2; ++ai)
#pragma unroll
            for (int m = 0; m < 4; ++m) { const size_t off = (size_t)(row0 + ai * HALF + m * 16) * 1024 + col0;
#pragma unroll
                for (int bj = 0; bj < 2; ++bj)
#pragma unroll
                    for (int n = 0; n < 2; ++n) { const f32x4 bs = *(const f32x4*)(bp + off + bj * HALF + n * 16);
                        *(f32x4*)(out + off + bj * HALF + n * 16) = bs + gv[bj][n] * acc[ai][bj][m][n]; } }
    }
};
template <class Epi, class Sched, bool ALIGN_EPI = false, bool SP2 = false>
__device__ __forceinline__ void gemm_phase(PG8_LAS unsigned char* lds, const Gemm g, const Sched& S, const Epi& E) {
    int tid_l = threadIdx.x; asm volatile("" : "+v"(tid_l));
    const int tid = tid_l, wid = __builtin_amdgcn_readfirstlane(tid >> 6), lane = tid & 63, wr = wid >> 2, wc = wid & 3, fr = lane & 15, fq = lane >> 4;
    const int K = g.K, nt = K / BK;
    unsigned voffA[2], voffB[2];
#pragma unroll
    for (int i = 0; i < 2; ++i) { int R, C; stage_rc(tid * 16 + i * 8192, R, C); const int Rb = Epi::PERM ? ((R & ~31) + perm32(R & 31)) : R;
        voffA[i] = (unsigned)(R * K + C) * 2u; voffB[i] = (unsigned)(Rb * K + C) * 2u; }
    const size_t kstep = (size_t)(BK * 2);
    const size_t hstep = (size_t)HALF * K * 2;
    const size_t tstep = 2 * hstep;
    const unsigned ldsw = (unsigned)wid * 1024u;
    const int aoff = lds_byte(wr * 64 + fr, fq * 8), boff = lds_byte(wc * 32 + fr, fq * 8);
#define PG8_SA(b, h) (((b) * 2 + (h)) * HTB)
#define PG8_SB(b, h) ((4 + (b) * 2 + (h)) * HTB)
#define PG8_STAGE(bufoff, gbase, voff) do { _Pragma("unroll") for (int _i = 0; _i < 2; ++_i) \
        __builtin_amdgcn_global_load_lds((const unsigned*)((const char*)(gbase) + (voff)[_i]), (PG8_LAS unsigned*)(lds + (bufoff) + ldsw + _i * 8192), 16, 0, 0); } while (0)
#define PG8_LDA(dst, b, h) do { _Pragma("unroll") for (int m = 0; m < 4; ++m) _Pragma("unroll") for (int k = 0; k < 2; ++k) dst[m][k] = *(const PG8_LAS bf16x8*)(lds + PG8_SA(b, h) + aoff + m * 2048 + k * 1024); } while (0)
#define PG8_LDB(dst, b, h) do { _Pragma("unroll") for (int n = 0; n < 2; ++n) _Pragma("unroll") for (int k = 0; k < 2; ++k) dst[n][k] = *(const PG8_LAS bf16x8*)(lds + PG8_SB(b, h) + boff + n * 2048 + k * 1024); } while (0)
#define PG8_MMA(ai, bj, At, Bt) do { __builtin_amdgcn_s_setprio(1); _Pragma("unroll") for (int m = 0; m < 4; ++m) _Pragma("unroll") for (int n = 0; n < 2; ++n) _Pragma("unroll") for (int k = 0; k < 2; ++k) \
        acc[ai][bj][m][n] = __builtin_amdgcn_mfma_f32_16x16x32_bf16(Bt[n][k], At[m][k], acc[ai][bj][m][n], 0, 0, 0); __builtin_amdgcn_s_setprio(0); } while (0)
#define PG8_WAIT_V(n) asm volatile("s_waitcnt vmcnt(" #n ")" ::: "memory")
#define PG8_WAIT_L(n) asm volatile("s_waitcnt lgkmcnt(" #n ")" ::: "memory")
#define PG8_BAR __builtin_amdgcn_s_barrier()
#define PG8_SCHED __builtin_amdgcn_sched_barrier(0)
    Unit cur, nxt; int ui = 0;
    if (!S.next(0, cur)) return;
    f32x4 acc[2][2][4][2];
#pragma unroll
    for (int a = 0; a < 2; ++a)
#pragma unroll
        for (int b = 0; b < 2; ++b)
#pragma unroll
            for (int m = 0; m < 4; ++m)
#pragma unroll
                for (int n = 0; n < 2; ++n) acc[a][b][m][n] = (f32x4){0.f, 0.f, 0.f, 0.f};
    bf16x8 At[4][2], B0[2][2], B1[2][2];
    const char* cA = (const char*)g.A + (size_t)cur.pm * tstep; const char* cB = (const char*)g.Bt + (size_t)cur.pn * tstep;
    S.a_ready(cur);
    if constexpr (SP2) {
        PG8_STAGE(PG8_SB(0, 0), cB, voffB); PG8_STAGE(PG8_SB(0, 1), cB + hstep, voffB); PG8_STAGE(PG8_SA(0, 0), cA, voffA); PG8_STAGE(PG8_SA(0, 1), cA + hstep, voffA);
        if (wr == 1) PG8_BAR;
        PG8_WAIT_V(2); PG8_BAR;
        PG8_STAGE(PG8_SB(1, 0), cB + kstep, voffB); PG8_STAGE(PG8_SA(1, 0), cA + kstep, voffA); PG8_STAGE(PG8_SB(1, 1), cB + hstep + kstep, voffB);
        PG8_WAIT_V(6); PG8_BAR;
    } else {
        PG8_STAGE(PG8_SB(0, 0), cB, voffB); PG8_STAGE(PG8_SA(0, 0), cA, voffA); PG8_STAGE(PG8_SB(0, 1), cB + hstep, voffB); PG8_STAGE(PG8_SA(0, 1), cA + hstep, voffA);
        if (wr == 1) PG8_BAR;
        PG8_WAIT_V(4); PG8_BAR;
        PG8_STAGE(PG8_SB(1, 0), cB + kstep, voffB); PG8_STAGE(PG8_SA(1, 0), cA + kstep, voffA); PG8_STAGE(PG8_SB(1, 1), cB + hstep + kstep, voffB);
        PG8_WAIT_V(6); PG8_BAR;
    }
    for (;;) {
        const bool has_next = S.next(ui + 1, nxt);
        const char* nA = has_next ? (const char*)g.A + (size_t)nxt.pm * tstep : cA; const char* nB = has_next ? (const char*)g.Bt + (size_t)nxt.pn * tstep : cB;
        for (int t = 0; t < nt; t += 2) {
            const bool last = (t == nt - 2);
            const char* a1 = cA + (size_t)(t + 1) * kstep;
            const char* a2 = last ? nA : cA + (size_t)(t + 2) * kstep; const char* b2 = last ? nB : cB + (size_t)(t + 2) * kstep;
            const char* a3 = a2 + kstep; const char* b3 = b2 + kstep;
            if (last && has_next) S.a_ready(nxt);
            if constexpr (SP2) {
            PG8_LDB(B0, 0, 0); PG8_LDB(B1, 0, 1); PG8_SCHED; PG8_LDA(At, 0, 0); PG8_STAGE(PG8_SA(1, 1), a1 + hstep, voffA);
            PG8_WAIT_V(8); PG8_WAIT_L(0); PG8_BAR; PG8_MMA(0, 0, At, B0); PG8_MMA(0, 1, At, B1); PG8_BAR; PG8_SCHED;
            PG8_LDA(At, 0, 1); PG8_STAGE(PG8_SB(0, 0), b2, voffB); PG8_STAGE(PG8_SB(0, 1), b2 + hstep, voffB); PG8_STAGE(PG8_SA(0, 0), a2, voffA);
            PG8_WAIT_V(8); PG8_WAIT_L(0); PG8_BAR; PG8_MMA(1, 0, At, B0); PG8_MMA(1, 1, At, B1); PG8_BAR; PG8_SCHED;
            PG8_LDB(B0, 1, 0); PG8_LDB(B1, 1, 1); PG8_SCHED; PG8_LDA(At, 1, 0); PG8_STAGE(PG8_SA(0, 1), a2 + hstep, voffA);
            PG8_WAIT_V(8); PG8_WAIT_L(0); PG8_BAR; PG8_MMA(0, 0, At, B0); PG8_MMA(0, 1, At, B1); PG8_BAR; PG8_SCHED;
            PG8_LDA(At, 1, 1); PG8_STAGE(PG8_SB(1, 0), b3, voffB); PG8_STAGE(PG8_SB(1, 1), b3 + hstep, voffB); PG8_STAGE(PG8_SA(1, 0), a3, voffA);
            PG8_WAIT_V(8); PG8_WAIT_L(0); PG8_BAR; PG8_MMA(1, 0, At, B0); PG8_MMA(1, 1, At, B1); PG8_BAR; PG8_SCHED;
            } else {
            PG8_LDB(B0, 0, 0); PG8_SCHED; PG8_LDA(At, 0, 0); PG8_STAGE(PG8_SA(1, 1), a1 + hstep, voffA);
            PG8_WAIT_L(8); PG8_BAR; PG8_WAIT_L(0); PG8_MMA(0, 0, At, B0); PG8_BAR; PG8_SCHED;
            PG8_LDB(B1, 0, 1); PG8_STAGE(PG8_SB(0, 0), b2, voffB);
            PG8_BAR; PG8_WAIT_L(0); PG8_MMA(0, 1, At, B1); PG8_BAR;
            PG8_LDA(At, 0, 1); PG8_STAGE(PG8_SA(0, 0), a2, voffA);
            PG8_BAR; PG8_WAIT_L(0); PG8_MMA(1, 0, At, B0); PG8_BAR; PG8_SCHED;
            PG8_STAGE(PG8_SB(0, 1), b2 + hstep, voffB);
            PG8_WAIT_V(6); PG8_BAR; PG8_MMA(1, 1, At, B1); PG8_BAR;
            PG8_LDB(B0, 1, 0); PG8_SCHED; PG8_LDA(At, 1, 0); PG8_STAGE(PG8_SA(0, 1), a2 + hstep, voffA);
            PG8_WAIT_L(8); PG8_BAR; PG8_WAIT_L(0); PG8_MMA(0, 0, At, B0); PG8_BAR; PG8_SCHED;
            PG8_LDB(B1, 1, 1); PG8_STAGE(PG8_SB(1, 0), b3, voffB);
            PG8_BAR; PG8_WAIT_L(0); PG8_MMA(0, 1, At, B1); PG8_BAR;
            PG8_LDA(At, 1, 1); PG8_STAGE(PG8_SA(1, 0), a3, voffA);
            PG8_BAR; PG8_WAIT_L(0); PG8_MMA(1, 0, At, B0); PG8_BAR; PG8_SCHED;
            PG8_STAGE(PG8_SB(1, 1), b3 + hstep, voffB);
            PG8_WAIT_V(6); PG8_BAR; PG8_MMA(1, 1, At, B1); PG8_BAR;
            }
        }
        if constexpr (ALIGN_EPI) { if (wr == 0) PG8_BAR; }
        if constexpr (!Epi::AFTER_DRAIN) { E(acc, cur, wr, wc, fr, fq); S.done(cur); }
        if (!has_next) break;
#pragma unroll
        for (int a = 0; a < 2; ++a)
#pragma unroll
            for (int b = 0; b < 2; ++b)
#pragma unroll
                for (int m = 0; m < 4; ++m)
#pragma unroll
                    for (int n = 0; n < 2; ++n) acc[a][b][m][n] = (f32x4){0.f, 0.f, 0.f, 0.f};
        cur = nxt; cA = nA; cB = nB; ++ui;
        if constexpr (ALIGN_EPI) { if (wr == 1) PG8_BAR; }
    }
    PG8_WAIT_V(0);
    if constexpr (!ALIGN_EPI) { if (wr == 0) PG8_BAR; }
    PG8_BAR;
    if constexpr (Epi::AFTER_DRAIN) { E.fused(acc, cur, wr, wc, fr, fq, lds, wid, lane); S.done(cur); }
#undef PG8_SA
#undef PG8_SB
#undef PG8_STAGE
#undef PG8_LDA
#undef PG8_LDB
#undef PG8_MMA
#undef PG8_WAIT_V
#undef PG8_WAIT_L
#undef PG8_BAR
#undef PG8_SCHED
}
}

#define LAS __attribute__((address_space(3)))
typedef unsigned short bf16;
typedef unsigned u32x4 __attribute__((ext_vector_type(4)));
typedef unsigned u32x2 __attribute__((ext_vector_type(2)));
typedef float f32x4 __attribute__((ext_vector_type(4)));
typedef float f32x2 __attribute__((ext_vector_type(2)));
typedef float f32x16 __attribute__((ext_vector_type(16)));
typedef short bf16x8 __attribute__((ext_vector_type(8)));
using pg8::cvt_pk_bf16; using pg8::bf_lo; using pg8::bf_hi; using pg8::sigm; using pg8::silu_f;

constexpr int DM = 1024, NCOL = 6912, MTOK = 10240, MCTX = 8192;
constexpr int C_CONVA = 0, C_CONVG = 512, C_CGATE = 1024, C_SSMIN = 1536, C_SGATE = 2048, C_Q = 2560, C_K = 3072, C_V = 3200, C_AGATE = 3328, C_MERGE = 3840;
constexpr float EPS = 1e-6f;
constexpr size_t MiB = (size_t)1 << 20;
constexpr size_t WS_CTL = 0, CTL_ZERO_BYTES = 256 * 1024;
constexpr size_t WS_MODS = 4096;
constexpr size_t WS_ROPE = 1 * MiB;
constexpr size_t WS_LAM = 1 * MiB + 64 * 1024;
constexpr size_t WS_BB = 2 * MiB;
constexpr size_t WS_CT = 3 * MiB;
constexpr size_t WS_E = 4 * MiB;
constexpr size_t WS_W = 10 * MiB;
constexpr size_t W_IN_B = (size_t)NCOL * DM * 2, W_GLU_B = (size_t)1024 * 512 * 2, W_BR_B = (size_t)3 * 1024 * 512 * 2, W_OUT_B = (size_t)1024 * 1024 * 2;
constexpr size_t W_LAYER_B = W_IN_B + W_GLU_B + W_BR_B + W_OUT_B;
constexpr size_t WS_H = 50 * MiB;
constexpr size_t WS_ABR = 70 * MiB;
constexpr size_t WS_YB = 100 * MiB;
constexpr size_t WS_MODSP = WS_YB;
constexpr size_t WS_Z = 110 * MiB;
constexpr size_t WS_END = WS_Z + (size_t)MTOK * NCOL * 2;
static_assert(WS_W + 2 * W_LAYER_B <= WS_H && WS_END <= 256 * MiB, "ws map");
constexpr int LDS_BYTES = 147456;

struct Params { const float* in[31]; float* out; unsigned char* ws; };
typedef const __attribute__((address_space(4))) Params* KP;
#define RELOAD_P(P) asm volatile("" : "+s"(P))
enum { I_XP = 0, I_XS, I_CK, I_CV, I_SRE, I_SIM, I_C, I_CCTX, I_NG, I_WADA, I_BADA, I_WIN, I_DWW, I_DWB, I_LNG, I_LNB, I_WCO, I_ARE, I_AIM, I_LDT, I_BRE, I_BIM, I_CRE, I_CIM, I_SD, I_WGLU, I_WSO, I_QG, I_KG, I_WAO, I_WOUT };
constexpr size_t O_Y = 0, O_CK = 10485760, O_CV = 12582912, O_SRE = 14680064, O_SIM = 14942208;

__device__ __forceinline__ float wave_sum(float v) {
#pragma unroll
    for (int o = 1; o < 64; o <<= 1) v += __shfl_xor(v, o);
    return v;
}
__device__ __forceinline__ void unpack8(const u32x4 w, float* f) {
    f[0] = bf_lo(w.x); f[1] = bf_hi(w.x); f[2] = bf_lo(w.y); f[3] = bf_hi(w.y); f[4] = bf_lo(w.z); f[5] = bf_hi(w.z); f[6] = bf_lo(w.w); f[7] = bf_hi(w.w);
}
__device__ __forceinline__ u32x4 pack8(const float* f) {
    u32x4 w; w.x = cvt_pk_bf16(f[0], f[1]); w.y = cvt_pk_bf16(f[2], f[3]); w.z = cvt_pk_bf16(f[4], f[5]); w.w = cvt_pk_bf16(f[6], f[7]); return w;
}
#define MFMA32(a, b, c) __builtin_amdgcn_mfma_f32_32x32x16_bf16((a), (b), (c), 0, 0, 0)
#define MFMA16(a, b, c) __builtin_amdgcn_mfma_f32_16x16x32_bf16((a), (b), (c), 0, 0, 0)

__device__ __forceinline__ void p0_transpose_item(const float* W, int K, int N, bf16* WT, int glu, LAS float* scr, int item, int lane) {
    const int nblk = N / 32, kb = item / nblk, nb = item % nblk, k0 = 64 * kb, n0 = 32 * nb;
    int d0 = n0;
    if (glu) { const int bj = n0 >> 9, rem = n0 & 511; d0 = 256 * (rem >> 7) + 128 * bj + (rem & 127); }
    float wv[32];
    const float* wsrc = W + (size_t)(k0 + (lane >> 5)) * N + n0 + (lane & 31);
#pragma unroll
    for (int i = 0; i < 32; ++i) wv[i] = wsrc[(size_t)(2 * i) * N];
#pragma unroll
    for (int i = 0; i < 32; ++i) scr[(2 * i + (lane >> 5)) * 33 + (lane & 31)] = wv[i];
    asm volatile("s_waitcnt lgkmcnt(0)" ::: "memory");
    const int c = lane & 7;
#pragma unroll
    for (int j = 0; j < 4; ++j) { const int n = (lane >> 3) + 8 * j; const LAS float* s = scr + (8 * c) * 33 + n;
        u32x4 o; o.x = cvt_pk_bf16(s[0 * 33], s[1 * 33]); o.y = cvt_pk_bf16(s[2 * 33], s[3 * 33]); o.z = cvt_pk_bf16(s[4 * 33], s[5 * 33]); o.w = cvt_pk_bf16(s[6 * 33], s[7 * 33]);
        *(u32x4*)(WT + (size_t)(d0 + n) * K + k0 + 8 * c) = o; }
    asm volatile("s_waitcnt lgkmcnt(0)" ::: "memory");
}

#ifndef REP_P0A
#define REP_P0A 1
#endif
__device__ __forceinline__ void convert_weights(KP P, int l, int part, int first_block, LAS unsigned char* lds) {
    RELOAD_P(P);
    asm volatile("" : "+s"(l));
    int tid_ = threadIdx.x; asm volatile("" : "+v"(tid_));
    const int lane = tid_ & 63, wid = __builtin_amdgcn_readfirstlane(tid_ >> 6);
    const int gw = ((int)blockIdx.x - first_block) * 8 + wid, NGW = ((int)gridDim.x - first_block) * 8;
    LAS float* scr = (LAS float*)(lds + wid * 8448);
    constexpr int I_IN = 16 * 216, I_S = 8 * 32, I_O = 16 * 32;
    unsigned char* wl = P->ws + WS_W + (size_t)l * W_LAYER_B;
    if (part == 0) {
        for (int r = gw; r < I_IN; r += NGW) p0_transpose_item(P->in[I_WIN] + (size_t)l * DM * NCOL, DM, NCOL, (bf16*)wl, 0, scr, r, lane);
    } else {
        for (int it = gw; it < 4 * I_S + I_O; it += NGW) {
            int r = it;
            if (r < I_S) { p0_transpose_item(P->in[I_WGLU] + (size_t)l * 512 * 1024, 512, 1024, (bf16*)(wl + W_IN_B), 1, scr, r, lane); continue; } r -= I_S;
            if (r < I_S) { p0_transpose_item(P->in[I_WCO] + (size_t)l * 512 * 1024, 512, 1024, (bf16*)(wl + W_IN_B + W_GLU_B), 0, scr, r, lane); continue; } r -= I_S;
            if (r < I_S) { p0_transpose_item(P->in[I_WSO] + (size_t)l * 512 * 1024, 512, 1024, (bf16*)(wl + W_IN_B + W_GLU_B) + (size_t)1024 * 512, 0, scr, r, lane); continue; } r -= I_S;
            if (r < I_S) { p0_transpose_item(P->in[I_WAO] + (size_t)l * 512 * 1024, 512, 1024, (bf16*)(wl + W_IN_B + W_GLU_B) + (size_t)2048 * 512, 0, scr, r, lane); continue; } r -= I_S;
            p0_transpose_item(P->in[I_WOUT] + (size_t)l * 1024 * 1024, 1024, 1024, (bf16*)(wl + W_IN_B + W_GLU_B + W_BR_B), 0, scr, r, lane);
        }
    }
}
__device__ __forceinline__ bool defer_l1_weights() { return gridDim.x >= 200; }

__device__ __forceinline__ void p0_prologue(KP P, LAS unsigned char* lds, int tid, int lane, int wid) {
    RELOAD_P(P);
    unsigned char* ws = P->ws;
    {
        const int nl = defer_l1_weights() ? 1 : 2;
#pragma unroll 1
        for (int rep0_ = 0; rep0_ < REP_P0A; ++rep0_)
#pragma unroll 1
        for (int lp = 0; lp < 2 * nl; ++lp) convert_weights(P, lp >> 1, lp & 1, 0, lds);
    }
    __syncthreads();
    for (int it = blockIdx.x; it < 209; it += gridDim.x) {
        if (it < 192) {
            const int l = it / 96, n0 = 32 * (it % 96);
            LAS float* sc = (LAS float*)lds;
            LAS float* red = (LAS float*)(lds + 12288);
            __syncthreads();
            for (int i = tid; i < 3072; i += 512) { const int j = i >> 10, k = i & 1023; const float cv = (j == 0) ? P->in[I_CCTX][k] : P->in[I_C][(j - 1) * 1024 + k]; sc[i] = cv / (1.f + __expf(-cv)); }
            __syncthreads();
            const int ks = tid >> 5, col = tid & 31;
            const float* w = P->in[I_WADA] + ((size_t)l * 1024 + ks * 64) * 3072 + n0 + col;
            float a0 = 0.f, a1 = 0.f, a2 = 0.f;
#pragma unroll 16
            for (int k = 0; k < 64; ++k) { const float wv = w[(size_t)k * 3072]; a0 += sc[ks * 64 + k] * wv; a1 += sc[1024 + ks * 64 + k] * wv; a2 += sc[2048 + ks * 64 + k] * wv; }
            red[(ks * 3 + 0) * 32 + col] = a0; red[(ks * 3 + 1) * 32 + col] = a1; red[(ks * 3 + 2) * 32 + col] = a2;
            __syncthreads();
            if (tid < 96) { const int j = tid >> 5, c2 = tid & 31; float sum = P->in[I_BADA][l * 3072 + n0 + c2];
#pragma unroll
                for (int q = 0; q < 16; ++q) sum += red[(q * 3 + j) * 32 + c2];
                ((float*)(ws + WS_MODS))[(l * 3 + j) * 3072 + n0 + c2] = sum; }
        } else if (it < 208) {
            const int idx = (it - 192) * 512 + tid; const int l = idx >> 12, dir = (idx >> 11) & 1, g = (idx >> 6) & 31, p = idx & 63;
            const double are = (double)P->in[I_ARE][idx], aim = (double)P->in[I_AIM][idx], dt = exp((double)P->in[I_LDT][(l * 2 + dir) * 32 + g]);
            const double mag = exp(are * dt), lr = mag * cos(aim * dt), li = mag * sin(aim * dt);
            ((f32x2*)(ws + WS_LAM))[idx] = (f32x2){(float)lr, (float)li};
            const double d2 = are * are + aim * aim, qr = ((lr - 1.0) * are + li * aim) / d2, qi = (li * are - (lr - 1.0) * aim) / d2;
            float bre[16], bim[16];
#pragma unroll
            for (int c = 0; c < 16; ++c) { const double br = (double)P->in[I_BRE][(size_t)idx * 16 + c], bi = (double)P->in[I_BIM][(size_t)idx * 16 + c]; bre[c] = (float)(qr * br - qi * bi); bim[c] = (float)(qr * bi + qi * br); }
            bf16* bb = (bf16*)(ws + WS_BB);
            u32x4* d_re = (u32x4*)(bb + ((size_t)(((l * 2 + dir) * 32 + g) * 2 + 0) * 64 + p) * 16);
            u32x4* d_im = (u32x4*)(bb + ((size_t)(((l * 2 + dir) * 32 + g) * 2 + 1) * 64 + p) * 16);
            d_re[0] = pack8(bre); d_re[1] = pack8(bre + 8); d_im[0] = pack8(bim); d_im[1] = pack8(bim + 8);
            bf16* ct = (bf16*)(ws + WS_CT);
#pragma unroll
            for (int cc = 0; cc < 16; ++cc) { const size_t ci = ((size_t)((l * 2 + dir) * 32 + g) * 16 + cc) * 64 + p;
                const float cre = P->in[I_CRE][ci], cim = P->in[I_CIM][ci];
                *(unsigned*)(ct + ((size_t)(((l * 32 + g) * 2 + dir) * 16 + cc) * 128 + 2 * p)) = cvt_pk_bf16(cre, -cim); }
        } else {
            for (int idx = tid; idx < 1024; idx += 512) { const int pos = idx >> 4, j = idx & 15;
                const double inv = exp(-(double)j / 16.0 * log(10000.0)), ang = (double)pos * inv;
                ((f32x2*)(ws + WS_ROPE))[idx] = (f32x2){(float)cos(ang), (float)sin(ang)}; }
        }
    }
}


__device__ __forceinline__ void p1_rows(KP P, int l, int lane, int wid) {
    RELOAD_P(P);
    const float* mods = (const float*)(P->ws + WS_MODS) + (size_t)l * 3 * 3072;
    const float* ng = P->in[I_NG] + l * DM;
    bf16* H = (bf16*)(P->ws + WS_H);
    const int gw = blockIdx.x * 8 + wid, NGW = gridDim.x * 8;
    for (int m = gw; m < MTOK; m += NGW) {
        const float* xr = (l == 0) ? (m < MCTX ? P->in[I_XP] + (size_t)m * DM : P->in[I_XS] + (size_t)(m - MCTX) * DM) : P->out + (size_t)m * DM;
        const int cond = m < MCTX ? 0 : 1 + ((m - MCTX) >> 10);
        const float* sh = mods + cond * 3072; const float* sc = sh + 1024;
        f32x4 v[4]; float s = 0.f;
#pragma unroll
        for (int j = 0; j < 4; ++j) { v[j] = *(const f32x4*)(xr + 4 * lane + 256 * j); s += (v[j].x * v[j].x + v[j].y * v[j].y) + (v[j].z * v[j].z + v[j].w * v[j].w); }
        const float rstd = rsqrtf(wave_sum(s) * (1.f / DM) + EPS);
#pragma unroll
        for (int j = 0; j < 4; ++j) { const int c = 4 * lane + 256 * j;
            const f32x4 g4 = *(const f32x4*)(ng + c), sc4 = *(const f32x4*)(sc + c), sh4 = *(const f32x4*)(sh + c);
            const f32x4 o = v[j] * rstd * g4 * (sc4 + 1.f) + sh4;
            u32x2 w; w.x = cvt_pk_bf16(o.x, o.y); w.y = cvt_pk_bf16(o.z, o.w);
            *(u32x2*)(H + (size_t)m * DM + c) = w; }
    }
}

constexpr int KS_PITCH = 144, VT_PITCH = 528, VT_OFF = 256 * KS_PITCH;
__device__ __forceinline__ int crow(int r, int hi) { return (r & 3) + 8 * (r >> 2) + 4 * hi; }
__device__ __forceinline__ float max3f(float a, float b, float c) { float r; asm("v_max3_f32 %0, %1, %2, %3" : "=v"(r) : "v"(a), "v"(b), "v"(c)); return r; }
__device__ __forceinline__ void attn_item(KP P, int l, int it, LAS unsigned char* lds, int tid, int lane, int wid) {
    RELOAD_P(P);
    asm volatile("" : "+s"(l)); asm volatile("" : "+v"(tid)); lane = tid & 63; wid = __builtin_amdgcn_readfirstlane(tid >> 6);
    const bf16* Z = (const bf16*)(P->ws + WS_Z);
    bf16* OA = (bf16*)(P->ws + WS_ABR) + (size_t)2 * MTOK * 512;
    const f32x2* rope = (const f32x2*)(P->ws + WS_ROPE);
    const bool lat = it < 64;
    int b, kvh, qb;
    if (lat) { b = it >> 5; kvh = (it >> 4) & 1; qb = it & 15; } else { const int j = it - 64; b = j >> 3; kvh = (j >> 2) & 1; qb = j & 3; }
    const int rowbase = lat ? MCTX + b * 1024 : b * 256;
    const int nkt = lat ? 5 : 1;
    const int r32 = lane & 31, hi = lane >> 5;
    const int h = 4 * kvh + (wid & 3);
    const int tq = qb * 64 + 32 * (wid >> 2) + r32;
    const int qrow = rowbase + tq;
    bf16x8 qf[4];
    {
        float qv[4][8]; float ss = 0.f;
        const bf16* zq = Z + (size_t)qrow * NCOL + C_Q + 64 * h + 8 * hi;
#pragma unroll
        for (int d0 = 0; d0 < 4; ++d0) { const u32x4 w = *(const u32x4*)(zq + 16 * d0); unpack8(w, qv[d0]);
#pragma unroll
            for (int i = 0; i < 8; ++i) ss += qv[d0][i] * qv[d0][i]; }
        ss += __shfl_xor(ss, 32);
        const float rs = rsqrtf(ss * (1.f / 64.f) + EPS);
        const float* qg = P->in[I_QG] + l * 64 + 8 * hi;
#pragma unroll
        for (int d0 = 0; d0 < 4; ++d0)
#pragma unroll
            for (int i = 0; i < 8; ++i) qv[d0][i] *= rs * qg[16 * d0 + i];
        if (lat) {
            const int prow = tq >> 6, pcol = tq & 63;
#pragma unroll
            for (int i = 0; i < 8; ++i) { const int j = 8 * hi + i;
                const f32x2 a = rope[prow * 16 + j]; float x1 = qv[0][i], x2 = qv[1][i]; qv[0][i] = x1 * a.x - x2 * a.y; qv[1][i] = x1 * a.y + x2 * a.x;
                const f32x2 c = rope[pcol * 16 + j]; x1 = qv[2][i]; x2 = qv[3][i]; qv[2][i] = x1 * c.x - x2 * c.y; qv[3][i] = x1 * c.y + x2 * c.x; }
        }
        const float qs = 0.125f * 1.4426950408889634f;
#pragma unroll
        for (int d0 = 0; d0 < 4; ++d0) {
#pragma unroll
            for (int i = 0; i < 8; ++i) qv[d0][i] *= qs;
            qf[d0] = __builtin_bit_cast(bf16x8, pack8(qv[d0])); }
    }
    constexpr float ATT_THR = 8.f;
    float mhat = 0.f, lrun = 0.f;
    f32x16 negm;
#pragma unroll
    for (int r = 0; r < 16; ++r) negm[r] = 0.f;
    f32x16 o0, o1;
#pragma unroll
    for (int r = 0; r < 16; ++r) { o0[r] = 0.f; o1[r] = 0.f; }
    for (int kt = 0; kt < nkt; ++kt) {
        __syncthreads();
        {
            const int key = tid >> 1, half = tid & 1;
            float kx[32];
            const bool from_z = (!lat) || kt < 4;
            if (from_z) {
                const int t = kt * 256 + key;
                const bf16* src = Z + (size_t)(rowbase + t) * NCOL + C_K + 64 * kvh + 32 * half;
                float ss = 0.f;
#pragma unroll
                for (int q = 0; q < 4; ++q) { const u32x4 w = *(const u32x4*)(src + 8 * q); unpack8(w, kx + 8 * q); }
#pragma unroll
                for (int i = 0; i < 32; ++i) ss += kx[i] * kx[i];
                ss += __shfl_xor(ss, 1);
                const float rs = rsqrtf(ss * (1.f / 64.f) + EPS);
                const float* kg = P->in[I_KG] + l * 64 + 32 * half;
#pragma unroll
                for (int i = 0; i < 32; ++i) kx[i] *= rs * kg[i];
                if (!lat && qb == 0) { float* dst = P->out + O_CK + ((size_t)((b * 2 + l) * 256 + key) * 2 + kvh) * 64 + 32 * half;
#pragma unroll
                    for (int q = 0; q < 8; ++q) *(f32x4*)(dst + 4 * q) = (f32x4){kx[4 * q], kx[4 * q + 1], kx[4 * q + 2], kx[4 * q + 3]}; }
                if (lat) { const int pos = half ? (t & 63) : (t >> 6);
#pragma unroll
                    for (int j = 0; j < 16; ++j) { const f32x2 a = rope[pos * 16 + j]; const float x1 = kx[j], x2 = kx[16 + j]; kx[j] = x1 * a.x - x2 * a.y; kx[16 + j] = x1 * a.y + x2 * a.x; } }
            } else {
                const float* src = P->in[I_CK] + ((size_t)((b * 2 + l) * 256 + key) * 2 + kvh) * 64 + 32 * half;
#pragma unroll
                for (int q = 0; q < 8; ++q) { const f32x4 w = *(const f32x4*)(src + 4 * q); kx[4 * q] = w.x; kx[4 * q + 1] = w.y; kx[4 * q + 2] = w.z; kx[4 * q + 3] = w.w; }
            }
            LAS u32x4* kd = (LAS u32x4*)(lds + key * KS_PITCH + 64 * half);
#pragma unroll
            for (int q = 0; q < 4; ++q) kd[q] = pack8(kx + 8 * q);
            if (from_z) {
                const int t = kt * 256 + key;
                const bf16* src = Z + (size_t)(rowbase + t) * NCOL + C_V + 64 * kvh + 32 * half;
#pragma unroll
                for (int q = 0; q < 4; ++q) { const u32x4 w = *(const u32x4*)(src + 8 * q); unpack8(w, kx + 8 * q); }
                if (!lat && qb == 0) { float* dst = P->out + O_CV + ((size_t)((b * 2 + l) * 256 + key) * 2 + kvh) * 64 + 32 * half;
#pragma unroll
                    for (int q = 0; q < 8; ++q) *(f32x4*)(dst + 4 * q) = (f32x4){kx[4 * q], kx[4 * q + 1], kx[4 * q + 2], kx[4 * q + 3]}; }
            } else {
                const float* src = P->in[I_CV] + ((size_t)((b * 2 + l) * 256 + key) * 2 + kvh) * 64 + 32 * half;
#pragma unroll
                for (int q = 0; q < 8; ++q) { const f32x4 w = *(const f32x4*)(src + 4 * q); kx[4 * q] = w.x; kx[4 * q + 1] = w.y; kx[4 * q + 2] = w.z; kx[4 * q + 3] = w.w; }
            }
            const int pos = (key & ~15) | ((key & 4) << 1) | ((key & 8) >> 1) | (key & 3);
            LAS bf16* vd = (LAS bf16*)(lds + VT_OFF + (32 * half) * VT_PITCH + 2 * pos);
#pragma unroll
            for (int i = 0; i < 32; i += 2) { const unsigned w = cvt_pk_bf16(kx[i], kx[i + 1]);
                vd[(size_t)i * (VT_PITCH / 2)] = (bf16)(w & 0xffffu); vd[(size_t)(i + 1) * (VT_PITCH / 2)] = (bf16)(w >> 16); }
        }
        __syncthreads();
#pragma unroll 1
        for (int st = 0; st < 4; ++st) {
            f32x16 p0 = negm, p1 = negm;
            const LAS unsigned char* kb = lds + (64 * st + r32) * KS_PITCH + 16 * hi;
#pragma unroll
            for (int d0 = 0; d0 < 4; ++d0) {
                const bf16x8 a0 = *(const LAS bf16x8*)(kb + 32 * d0);
                const bf16x8 a1 = *(const LAS bf16x8*)(kb + 32 * KS_PITCH + 32 * d0);
                p0 = MFMA32(a0, qf[d0], p0); p1 = MFMA32(a1, qf[d0], p1);
            }
            asm volatile("s_nop 15\n\ts_nop 7" : "+v"(p0), "+v"(p1));
            float tm;
            { float a = max3f(p0[0], p0[1], p1[0]), b2 = max3f(p0[2], p0[3], p1[1]); a = max3f(a, p1[2], p1[3]);
#pragma unroll
              for (int r = 4; r < 16; r += 4) { a = max3f(a, p0[r], p0[r + 1]); b2 = max3f(b2, p0[r + 2], p0[r + 3]); a = max3f(a, p1[r], p1[r + 1]); b2 = max3f(b2, p1[r + 2], p1[r + 3]); }
              tm = max3f(a, b2, b2); }
            { const float other = __shfl_xor(tm, 32); tm = max3f(tm, other, other); }
            if (__any(fabsf(tm) > ATT_THR)) {
                const float dl = fabsf(tm) > ATT_THR ? tm : 0.f;
                mhat += dl;
                const float f = __builtin_amdgcn_exp2f(-dl);
#pragma unroll
                for (int r = 0; r < 16; ++r) { p0[r] -= dl; p1[r] -= dl; negm[r] = -mhat; o0[r] *= f; o1[r] *= f; }
                lrun *= f;
            }
            float ps = 0.f;
#pragma unroll
            for (int r = 0; r < 16; ++r) { p0[r] = __builtin_amdgcn_exp2f(p0[r]); p1[r] = __builtin_amdgcn_exp2f(p1[r]); ps += p0[r] + p1[r]; }
            lrun += ps;
            bf16x8 pb[4];
            { float t8[8];
#pragma unroll
              for (int J = 0; J < 4; ++J) {
#pragma unroll
                  for (int i = 0; i < 8; ++i) t8[i] = (J < 2) ? p0[8 * (J & 1) + i] : p1[8 * (J & 1) + i];
                  pb[J] = __builtin_bit_cast(bf16x8, pack8(t8)); } }
            const LAS unsigned char* vb = lds + VT_OFF + r32 * VT_PITCH + 2 * (64 * st + 8 * hi);
#pragma unroll
            for (int J = 0; J < 4; ++J) {
                const bf16x8 v0 = *(const LAS bf16x8*)(vb + 32 * J);
                const bf16x8 v1 = *(const LAS bf16x8*)(vb + 32 * VT_PITCH + 32 * J);
                o0 = MFMA32(v0, pb[J], o0); o1 = MFMA32(v1, pb[J], o1);
            }
        }
    }
    lrun += __shfl_xor(lrun, 32);
    const float inv = 1.f / lrun;
    const bf16* zg = Z + (size_t)qrow * NCOL + C_AGATE + 64 * h;
    bf16* od = OA + (size_t)qrow * 512 + 64 * h;
#pragma unroll
    for (int dt = 0; dt < 2; ++dt)
#pragma unroll
        for (int rq = 0; rq < 4; ++rq) { const int d = 32 * dt + 8 * rq + 4 * hi;
            const u32x2 gw = *(const u32x2*)(zg + d);
            float v[4];
#pragma unroll
            for (int i = 0; i < 4; ++i) v[i] = (dt ? o1[4 * rq + i] : o0[4 * rq + i]) * inv;
            v[0] *= silu_f(bf_lo(gw.x)); v[1] *= silu_f(bf_hi(gw.x)); v[2] *= silu_f(bf_lo(gw.y)); v[3] *= silu_f(bf_hi(gw.y));
            u32x2 w; w.x = cvt_pk_bf16(v[0], v[1]); w.y = cvt_pk_bf16(v[2], v[3]);
            *(u32x2*)(od + d) = w; }
}

__device__ __forceinline__ float fsigm(float x) { return __builtin_amdgcn_rcpf(1.f + __builtin_amdgcn_exp2f(-1.4426950408889634f * x)); }
__device__ __forceinline__ void conv_item(KP P, int l, int it, LAS unsigned char* lds, int tid, int lane, int wid) {
    RELOAD_P(P);
    asm volatile("" : "+s"(l)); asm volatile("" : "+v"(tid)); lane = tid & 63; wid = __builtin_amdgcn_readfirstlane(tid >> 6);
    const bf16* Z = (const bf16*)(P->ws + WS_Z);
    bf16* YA = (bf16*)(P->ws + WS_ABR);
    int rowbase, L, t0;
    if (it < 512) { rowbase = (it >> 4) * 256; L = 256; t0 = 16 * (it & 15); } else { const int j = it - 512; rowbase = MCTX + (j >> 6) * 1024; L = 1024; t0 = 16 * (j & 63); }
    LAS float* yb = (LAS float*)lds;
    LAS float* sb = (LAS float*)(lds + 47 * 512 * 4);
    LAS float* st = (LAS float*)(lds + 47 * 512 * 4 + 16 * 516 * 4);
    u32x4 la[6], lg[6];
#pragma unroll
    for (int i = 0; i < 6; ++i) {
        const int e = tid + 512 * i, rr = e >> 6, ch = e & 63, t = t0 - 15 + rr;
        la[i] = (u32x4){0u, 0u, 0u, 0u}; lg[i] = (u32x4){0u, 0u, 0u, 0u};
        if (rr < 47 && t >= 0 && t < L) { const bf16* src = Z + (size_t)(rowbase + t) * NCOL + 8 * ch; la[i] = *(const u32x4*)(src + C_CONVA); lg[i] = *(const u32x4*)(src + C_CONVG); }
    }
    const int c = tid;
    float w[32];
    const float* wp = P->in[I_DWW] + (size_t)l * 31 * 512 + c;
#pragma unroll
    for (int k = 0; k < 31; ++k) w[k] = wp[k * 512];
    w[31] = 0.f;
    const float bias = P->in[I_DWB][l * 512 + c], lgam = P->in[I_LNG][l * 512 + c], lbet = P->in[I_LNB][l * 512 + c];
    bf16 gt[16];
#pragma unroll
    for (int t = 0; t < 16; ++t) gt[t] = Z[(size_t)(rowbase + t0 + t) * NCOL + C_CGATE + c];
#pragma unroll
    for (int i = 0; i < 6; ++i) {
        const int e = tid + 512 * i, rr = e >> 6, ch = e & 63;
        if (rr < 47) {
            float a[8], g[8]; unpack8(la[i], a); unpack8(lg[i], g);
#pragma unroll
            for (int q = 0; q < 8; ++q) a[q] *= fsigm(g[q]);
            LAS f32x4* d = (LAS f32x4*)(yb + rr * 512 + 8 * ch);
            d[0] = (f32x4){a[0], a[1], a[2], a[3]}; d[1] = (f32x4){a[4], a[5], a[6], a[7]};
        }
    }
    __syncthreads();
    float acc[16];
#pragma unroll
    for (int t = 0; t < 16; ++t) acc[t] = bias;
#pragma unroll
    for (int kb = 0; kb < 32; kb += 8) {
        const LAS float* yp = yb + kb * 512 + c;
        float rows[23];
#pragma unroll
        for (int j = 0; j < 23; ++j) rows[j] = yp[j * 512];
#pragma unroll
        for (int t = 0; t < 16; ++t)
#pragma unroll
            for (int i = 0; i < 8; ++i) acc[t] += w[kb + i] * rows[t + i];
    }
#pragma unroll
    for (int t = 0; t < 16; ++t) sb[t * 516 + c] = acc[t];
    __syncthreads();
    {
        const int t = tid >> 5, j = tid & 31;
        const LAS f32x4* q = (const LAS f32x4*)(sb + t * 516 + 16 * j);
        float s1 = 0.f, s2 = 0.f;
#pragma unroll
        for (int i = 0; i < 4; ++i) { const f32x4 v = q[i]; s1 += (v.x + v.y) + (v.z + v.w); s2 += (v.x * v.x + v.y * v.y) + (v.z * v.z + v.w * v.w); }
#pragma unroll
        for (int o = 1; o < 32; o <<= 1) { s1 += __shfl_xor(s1, o); s2 += __shfl_xor(s2, o); }
        if (j == 0) { const float mean = s1 * (1.f / 512.f); const float var = fmaxf(s2 * (1.f / 512.f) - mean * mean, 0.f); st[2 * t] = mean; st[2 * t + 1] = rsqrtf(var + EPS); }
    }
    __syncthreads();
#pragma unroll
    for (int t = 0; t < 16; ++t) {
        const float y = (acc[t] - st[2 * t]) * st[2 * t + 1] * lgam + lbet;
        const float gate = __uint_as_float((unsigned)gt[t] << 16);
        const float o = y * gate * __builtin_amdgcn_rcpf((1.f + __builtin_amdgcn_exp2f(-1.4426950408889634f * y)) * (1.f + __builtin_amdgcn_exp2f(-1.4426950408889634f * gate)));
        YA[(size_t)(rowbase + t0 + t) * 512 + c] = (bf16)(cvt_pk_bf16(o, o) & 0xffffu);
    }
}

constexpr int HS_PITCH = 272, HS_S = 16 * HS_PITCH, HS_WAVE = 2 * HS_S;
struct SsmIdx { int lat, b, rg, go, NR; };
__device__ __forceinline__ SsmIdx ssm_decode(int it) {
    SsmIdx s;
    if (it < 512) { s.lat = 0; s.b = it >> 4; s.rg = (it >> 2) & 3; s.go = it & 3; s.NR = 4; }
    else { const int j = it - 512; s.lat = 1; s.b = j >> 6; s.rg = (j >> 2) & 15; s.go = j & 3; s.NR = 16; }
    return s;
}
#define CMUL_ADD(hr, hi_, lr, li, br, bi) do { const float _tr = __builtin_fmaf(-(li), (hi_), (br)), _ti = __builtin_fmaf((li), (hr), (bi)); const float _nr = __builtin_fmaf((lr), (hr), _tr), _ni = __builtin_fmaf((lr), (hi_), _ti); (hr) = _nr; (hi_) = _ni; } while (0)

template <int PASS>
__device__ __forceinline__ void ssm_item(KP P, int l, int it, LAS unsigned char* lds, int tid, int lane, int wid, int gsel) {
    RELOAD_P(P);
    asm volatile("" : "+s"(l)); asm volatile("" : "+v"(tid)); lane = tid & 63; wid = __builtin_amdgcn_readfirstlane(tid >> 6);
    const bf16* Z = (const bf16*)(P->ws + WS_Z);
    const SsmIdx S = ssm_decode(it);
    const int g = 8 * S.go + gsel;
    const int r32 = lane & 31, hi = lane >> 5;
    const int rb = S.lat ? MCTX + S.b * 1024 : S.b * 256;
    const int kA = (r32 & 3) + 4 * (r32 >> 3);
    const int t_start = 64 * S.rg;
    const int sr_base = S.lat ? 128 + S.b * 16 : S.b * 4;
    const bf16* zu = Z + (size_t)(rb + t_start + kA) * NCOL + C_SSMIN + 16 * g + 8 * hi;
    bf16x8 uf[4];
    if (PASS == 2) {
#pragma unroll
        for (int j = 0; j < 4; ++j) uf[j] = __builtin_bit_cast(bf16x8, *(const u32x4*)(zu + (size_t)(16 * j) * NCOL));
    }
    f32x2* E = (f32x2*)(P->ws + WS_E);
    const f32x2* LAM = (const f32x2*)(P->ws + WS_LAM);
    const bf16* BB = (const bf16*)(P->ws + WS_BB);
    const bf16* CT = (const bf16*)(P->ws + WS_CT);
    LAS unsigned char* hs = lds + wid * HS_WAVE;
    f32x4 yacc[4];
    if (PASS == 2) {
#pragma unroll
        for (int j = 0; j < 4; ++j) yacc[j] = (f32x4){0.f, 0.f, 0.f, 0.f};
    }
#pragma unroll
    for (int dir = 0; dir < 2; ++dir) {
        const int ldg = (l * 2 + dir) * 32 + g;
        bf16x8 bfr[2][2];
        f32x2 lam[2];
#pragma unroll
        for (int pt = 0; pt < 2; ++pt) {
            lam[pt] = LAM[(size_t)ldg * 64 + 32 * pt + r32];
#pragma unroll
            for (int ri = 0; ri < 2; ++ri) bfr[pt][ri] = __builtin_bit_cast(bf16x8, *(const u32x4*)(BB + ((size_t)(ldg * 2 + ri) * 64 + 32 * pt + r32) * 16 + 8 * hi));
        }
        float hr[2], hm[2];
        bf16x8 ctf[4];
        if (PASS == 1) { hr[0] = hr[1] = hm[0] = hm[1] = 0.f; }
        else {
            const int q4 = lane >> 4, cc = lane & 15;
#pragma unroll
            for (int kk = 0; kk < 4; ++kk) ctf[kk] = __builtin_bit_cast(bf16x8, *(const u32x4*)(CT + ((size_t)((l * 32 + g) * 2 + dir) * 16 + cc) * 128 + 32 * kk + 8 * q4));
#pragma unroll
            for (int pt = 0; pt < 2; ++pt) {
                float l64r = lam[pt].x, l64i = lam[pt].y;
#pragma unroll
                for (int q = 0; q < 6; ++q) { const float nr = l64r * l64r - l64i * l64i, ni = 2.f * l64r * l64i; l64r = nr; l64i = ni; }
                float cr = 0.f, ci = 0.f;
                if (S.lat) { const size_t si = ((size_t)((S.b * 2 + l) * 2 + dir) * 32 + g) * 64 + 32 * pt + r32; cr = P->in[I_SRE][si]; ci = P->in[I_SIM][si]; }
                {
                    const int n_it = dir == 0 ? S.rg : S.NR - 1 - S.rg;
                    const f32x2* Eb = E + ((size_t)(sr_base * 32 + g) * 2 + dir) * 64 + 32 * pt + r32;
                    for (int i0 = 0; i0 < n_it; i0 += 4) {
                        f32x2 e4[4];
#pragma unroll
                        for (int k = 0; k < 4; ++k) { const int i = min(i0 + k, n_it - 1); const int ri = dir == 0 ? i : S.NR - 1 - i; e4[k] = Eb[(size_t)ri * 4096]; }
#pragma unroll
                        for (int k = 0; k < 4; ++k) { const bool ok = i0 + k < n_it; const float nr = __builtin_fmaf(l64r, cr, __builtin_fmaf(-l64i, ci, e4[k].x)), ni = __builtin_fmaf(l64r, ci, __builtin_fmaf(l64i, cr, e4[k].y)); cr = ok ? nr : cr; ci = ok ? ni : ci; }
                    }
                }
                hr[pt] = cr; hm[pt] = ci;
            }
        }
#pragma unroll (PASS == 2 ? 4 : 1)
        for (int jj = 0; jj < 4; ++jj) {
            const int j = dir ? 3 - jj : jj;
            bf16x8 ufj;
            if (PASS == 2) ufj = uf[j]; else ufj = __builtin_bit_cast(bf16x8, *(const u32x4*)(zu + (size_t)(16 * j) * NCOL));
            const f32x16 zero16 = (f32x16){0.f, 0.f, 0.f, 0.f, 0.f, 0.f, 0.f, 0.f, 0.f, 0.f, 0.f, 0.f, 0.f, 0.f, 0.f, 0.f};
#pragma unroll
            for (int pt = 0; pt < 2; ++pt) {
                const f32x16 are = MFMA32(ufj, bfr[pt][0], zero16);
                const f32x16 aim = MFMA32(ufj, bfr[pt][1], zero16);
                LAS unsigned* hw = (LAS unsigned*)(hs + hi * HS_S + 4 * (32 * pt + r32));
#pragma unroll
                for (int rr = 0; rr < 16; ++rr) { const int r = dir ? 15 - rr : rr;
                    CMUL_ADD(hr[pt], hm[pt], lam[pt].x, lam[pt].y, are[r], aim[r]);
                    if (PASS == 2) hw[r * (HS_PITCH / 4)] = cvt_pk_bf16(hr[pt], hm[pt]); }
                __builtin_amdgcn_sched_barrier(0);
            }
            if (PASS == 2) {
                const int q4 = lane >> 4, n = lane & 15;
#pragma unroll
                for (int kk = 0; kk < 4; ++kk) { const bf16x8 hb = *(const LAS bf16x8*)(hs + n * HS_PITCH + 64 * kk + 16 * q4);
                    yacc[j] = MFMA16(ctf[kk], hb, yacc[j]); }
            }
        }
        if (hi == 0) {
            if (PASS == 1) {
#pragma unroll
                for (int pt = 0; pt < 2; ++pt) E[((size_t)((sr_base + S.rg) * 32 + g) * 2 + dir) * 64 + 32 * pt + r32] = (f32x2){hr[pt], hm[pt]};
            } else if (!S.lat && ((dir == 0 && S.rg == 3) || (dir == 1 && S.rg == 0))) {
#pragma unroll
                for (int pt = 0; pt < 2; ++pt) { const size_t oi = ((size_t)((S.b * 2 + l) * 2 + dir) * 32 + g) * 64 + 32 * pt + r32;
                    P->out[O_SRE + oi] = hr[pt]; P->out[O_SIM + oi] = hm[pt]; }
            }
        }
    }
    if (PASS == 2) {
        bf16* YB = (bf16*)(P->ws + WS_YB);
        const int q4 = lane >> 4, n = lane & 15;
        const f32x4 dv = *(const f32x4*)(P->in[I_SD] + l * 512 + 16 * g + 4 * q4);
#pragma unroll
        for (int j = 0; j < 4; ++j) {
            const size_t row = (size_t)(rb + t_start + 16 * j + n);
            const u32x2 uw = *(const u32x2*)(Z + row * NCOL + C_SSMIN + 16 * g + 4 * q4);
            float y[4];
            y[0] = yacc[j][0] + dv.x * bf_lo(uw.x); y[1] = yacc[j][1] + dv.y * bf_hi(uw.x); y[2] = yacc[j][2] + dv.z * bf_lo(uw.y); y[3] = yacc[j][3] + dv.w * bf_hi(uw.y);
#pragma unroll
            for (int i = 0; i < 4; ++i) { const float x = y[i]; y[i] = x * sigm(1.5957691216057308f * (x + 0.044715f * x * x * x)); }
            u32x2 w; w.x = cvt_pk_bf16(y[0], y[1]); w.y = cvt_pk_bf16(y[2], y[3]);
            *(u32x2*)(YB + row * 512 + 16 * g + 4 * q4) = w;
        }
    }
}

#ifdef DBG_NAIVE_STATE
__device__ __forceinline__ void naive_state_item(KP P, int l, int it, int tid) {
    RELOAD_P(P);
    asm volatile("" : "+s"(l)); asm volatile("" : "+v"(tid));
    const bf16* Z = (const bf16*)(P->ws + WS_Z);
    const int idx = it * 512 + tid; const int p = idx & 63, g = (idx >> 6) & 31, dir = (idx >> 11) & 1, b = idx >> 12;
    const int ti = ((l * 2 + dir) * 32 + g) * 64 + p;
    const float are = P->in[I_ARE][ti], aim = P->in[I_AIM][ti];
    const f32x2 lmb = ((const f32x2*)(P->ws + WS_LAM))[ti];
    const float lr = lmb.x, li = lmb.y;
    const float d2 = are * are + aim * aim, qr = ((lr - 1.0f) * are + li * aim) / d2, qi = (li * are - (lr - 1.0f) * aim) / d2;
    float bre[16], bim[16];
#pragma unroll
    for (int c = 0; c < 16; ++c) { const float br = P->in[I_BRE][(size_t)ti * 16 + c], bi = P->in[I_BIM][(size_t)ti * 16 + c]; bre[c] = qr * br - qi * bi; bim[c] = qr * bi + qi * br;
#ifdef DBG_BF16_B
        { const unsigned w = cvt_pk_bf16(bre[c], bim[c]); bre[c] = bf_lo(w); bim[c] = bf_hi(w); }
#endif
#ifdef DBG_USE_BB
        { const bf16* BBt = (const bf16*)(P->ws + WS_BB); const int ldg_ = (l * 2 + dir) * 32 + g;
          bre[c] = __uint_as_float((unsigned)BBt[((size_t)(ldg_ * 2 + 0) * 64 + p) * 16 + c] << 16); bim[c] = __uint_as_float((unsigned)BBt[((size_t)(ldg_ * 2 + 1) * 64 + p) * 16 + c] << 16); }
#endif
    }
    float hr = 0.f, hm = 0.f;
#pragma unroll 1
    for (int tt = 0; tt < 256; ++tt) {
        const int t = dir ? 255 - tt : tt;
        const bf16* src = Z + (size_t)(b * 256 + t) * NCOL + C_SSMIN + 16 * g;
        float u[16]; unpack8(*(const u32x4*)src, u); unpack8(*(const u32x4*)(src + 8), u + 8);
        float br = 0.f, bi = 0.f;
#pragma unroll
        for (int c = 0; c < 16; ++c) { br += bre[c] * u[c]; bi += bim[c] * u[c]; }
        CMUL_ADD(hr, hm, lr, li, br, bi);
    }
    const size_t oi = ((size_t)((b * 2 + l) * 2 + dir) * 32 + g) * 64 + p;
#if defined(DBG_SPLIT_HI) && defined(DBG_SWAP)
    if ((b & 1) == DBG_SPLIT_HI)
#elif defined(DBG_SPLIT_HI)
    if ((b & 1) != DBG_SPLIT_HI)
#endif
    { P->out[O_SRE + oi] = hr; P->out[O_SIM + oi] = hm; }
}
#endif

__device__ __forceinline__ void state_item(KP P, int l, int it, int tid, int lane, int wid) {
    RELOAD_P(P);
    asm volatile("" : "+s"(l)); asm volatile("" : "+v"(tid)); lane = tid & 63; wid = __builtin_amdgcn_readfirstlane(tid >> 6);
    const bf16* Z = (const bf16*)(P->ws + WS_Z);
    const int w = __builtin_amdgcn_readfirstlane(it * 8 + wid);
    const int g = w & 31, dir = (w >> 5) & 1, b = w >> 6;
    const int r32 = lane & 31, hi = lane >> 5;
    const int kA = (r32 & 3) + 4 * (r32 >> 3);
    const int ldg = (l * 2 + dir) * 32 + g;
    const f32x2* LAM = (const f32x2*)(P->ws + WS_LAM);
    const bf16* BB = (const bf16*)(P->ws + WS_BB);
    bf16x8 bfr[2][2]; f32x2 lam[2]; float hr[2] = {0.f, 0.f}, hm[2] = {0.f, 0.f};
#pragma unroll
    for (int pt = 0; pt < 2; ++pt) {
        lam[pt] = LAM[(size_t)ldg * 64 + 32 * pt + r32];
#pragma unroll
        for (int ri = 0; ri < 2; ++ri) bfr[pt][ri] = __builtin_bit_cast(bf16x8, *(const u32x4*)(BB + ((size_t)(ldg * 2 + ri) * 64 + 32 * pt + r32) * 16 + 8 * hi));
    }
    const bf16* zb = Z + (size_t)(b * 256 + kA) * NCOL + C_SSMIN + 16 * g + 8 * hi;
    const f32x16 z16 = (f32x16){0.f, 0.f, 0.f, 0.f, 0.f, 0.f, 0.f, 0.f, 0.f, 0.f, 0.f, 0.f, 0.f, 0.f, 0.f, 0.f};
#pragma unroll 1
    for (int q = 0; q < 16; q += 2) {
        const int j0 = dir ? 15 - q : q, j1 = dir ? 14 - q : q + 1;
        const bf16x8 u0 = __builtin_bit_cast(bf16x8, *(const u32x4*)(zb + (size_t)(16 * j0) * NCOL));
        const bf16x8 u1 = __builtin_bit_cast(bf16x8, *(const u32x4*)(zb + (size_t)(16 * j1) * NCOL));
#pragma unroll
        for (int half = 0; half < 2; ++half) {
            const bf16x8 ux = half ? u1 : u0;
#pragma unroll
            for (int pt = 0; pt < 2; ++pt) {
                const f32x16 xr = MFMA32(ux, bfr[pt][0], z16);
                const f32x16 xi = MFMA32(ux, bfr[pt][1], z16);
                if (dir == 0) {
#pragma unroll
                    for (int r = 0; r < 16; ++r) CMUL_ADD(hr[pt], hm[pt], lam[pt].x, lam[pt].y, xr[r], xi[r]);
                } else {
#pragma unroll
                    for (int r = 15; r >= 0; --r) CMUL_ADD(hr[pt], hm[pt], lam[pt].x, lam[pt].y, xr[r], xi[r]);
                }
            }
        }
    }
    if (hi == 0) {
#pragma unroll
        for (int pt = 0; pt < 2; ++pt) { const size_t oi = ((size_t)((b * 2 + l) * 2 + dir) * 32 + g) * 64 + 32 * pt + r32;
            P->out[O_SRE + oi] = hr[pt]; P->out[O_SIM + oi] = hm[pt]; }
    }
}
#define XB_TMO      128
#define XB_XCNT(j)  (256  + 64 * (j))
#define XB_XSUB(j)  (1280 + 64 * (j))
#define XB_XGEN(j)  (2304 + 64 * (j))
#define XB_TOP      3328
#define XB_TOPGEN   3392
#define XCD_BAR_WORDS 3456
#define XB_SPIN_CAP (1u << 18)

__device__ __forceinline__ unsigned xb_ld(unsigned* p)              { return __hip_atomic_load(p, __ATOMIC_RELAXED, __HIP_MEMORY_SCOPE_AGENT); }
__device__ __forceinline__ unsigned xb_add(unsigned* p, unsigned v) { return __hip_atomic_fetch_add(p, v, __ATOMIC_RELAXED, __HIP_MEMORY_SCOPE_AGENT); }
__device__ __forceinline__ unsigned xb_xcc_id() { return (unsigned)__builtin_amdgcn_s_getreg((3 << 11) | 20) & 0xFu; }
#define XB_SPIN(cond, bar) do { unsigned _sp = 0; while (cond) { __builtin_amdgcn_s_sleep(1); \
    if ((++_sp & 255u) == 0u) { if (xb_ld(&(bar)[XB_TMO])) break; if (_sp > XB_SPIN_CAP) { atomicAdd(&(bar)[XB_TMO], 1u); break; } } } } while (0)

struct XcdBarrier {
    unsigned* bar; unsigned x;
    volatile LAS unsigned* st;
};

__device__ __forceinline__ XcdBarrier xcd_barrier_post(unsigned* bar, volatile LAS unsigned* st) {
    XcdBarrier b; b.bar = bar; b.x = xb_xcc_id(); b.st = st;
    if (threadIdx.x == 0) (void)xb_add(&bar[XB_XCNT(b.x)], 1u);
    return b;
}
__device__ __forceinline__ void xcd_barrier_complete(unsigned* bar, unsigned x, unsigned& nloc, unsigned& nx) {
    const unsigned G = gridDim.x * gridDim.y * gridDim.z;
    unsigned sum, cnt, mine, sp = 0u;
    for (;;) {
        sum = 0u; cnt = 0u; mine = 0u;
#pragma unroll
        for (unsigned j = 0; j < 16; ++j) { const unsigned c = xb_ld(&bar[XB_XCNT(j)]); sum += c; cnt += (c > 0u) ? 1u : 0u; mine = (j == x) ? c : mine; }
        if (sum == G) break;
        __builtin_amdgcn_s_sleep(1);
        if ((++sp & 255u) == 0u) { if (xb_ld(&bar[XB_TMO])) break; if (sp > XB_SPIN_CAP) { atomicAdd(&bar[XB_TMO], 1u); break; } }
    }
    nloc = mine > 0u ? mine : 1u; nx = cnt > 0u ? cnt : 1u;
}

__device__ __forceinline__ void xcd_barrier(const XcdBarrier& b) {
    asm volatile("s_waitcnt vmcnt(0)" ::: "memory");
    __syncthreads();
    if (threadIdx.x == 0) {
        unsigned* bar = b.bar;
        __builtin_amdgcn_s_waitcnt(0);
        unsigned nloc = b.st[0], nx = b.st[1];
        if (nloc == 0u) { xcd_barrier_complete(bar, b.x, nloc, nx); b.st[0] = nloc; b.st[1] = nx; }
        const unsigned old = xb_add(&bar[XB_XSUB(b.x)], 1u);
        const unsigned gen = old / nloc;
        if (old + 1u == (gen + 1u) * nloc) {
            __builtin_amdgcn_fence(__ATOMIC_RELEASE, "agent");
            asm volatile("s_waitcnt vmcnt(0)" ::: "memory");
            const unsigned og = xb_add(&bar[XB_TOP], 1u);
            const unsigned tg = og / nx;
            if (og + 1u == (tg + 1u) * nx) xb_add(&bar[XB_TOPGEN], 1u);
            else XB_SPIN(xb_ld(&bar[XB_TOPGEN]) == tg, bar);
            __builtin_amdgcn_fence(__ATOMIC_ACQUIRE, "agent");
            xb_add(&bar[XB_XGEN(b.x)], 1u);
            asm volatile("s_waitcnt vmcnt(0)" ::: "memory");
        } else {
            XB_SPIN(xb_ld(&bar[XB_XGEN(b.x)]) == gen, bar);
            __builtin_amdgcn_fence(__ATOMIC_ACQUIRE, "agent");
            asm volatile("s_waitcnt vmcnt(0)" ::: "memory");
        }
    }
    __syncthreads();
}


constexpr int CW_XBAR = 32768;
#ifndef REP_SYNC
#define REP_SYNC 1
#endif
#ifndef REP_ATT
#define REP_ATT 1
#endif
#ifndef REP_SSM1
#define REP_SSM1 1
#endif
#ifndef REP_CONV
#define REP_CONV 1
#endif
#ifndef REP_P2
#define REP_P2 1
#endif
#ifndef REP_P3
#define REP_P3 1
#endif
#ifndef REP_P4
#define REP_P4 1
#endif
#ifndef REP_P56
#define REP_P56 1
#endif
__device__ __forceinline__ void grid_sync_all(cg::grid_group& grid) {
    asm volatile("s_waitcnt vmcnt(0) lgkmcnt(0)" ::: "memory");
    grid.sync();
    __builtin_amdgcn_fence(__ATOMIC_ACQUIRE, "agent");
    asm volatile("s_waitcnt vmcnt(0)" ::: "memory");
}
__device__ __forceinline__ int q_next(unsigned* ctr, LAS int* slot, int tid) {
    __syncthreads();
    if (tid == 0) *slot = (int)atomicAdd(ctr, 1u);
    __syncthreads();
    return *slot;
}

__global__ void __launch_bounds__(512, 2) fwd_kernel(Params Pk_unused) {
    KP P = (KP)__builtin_amdgcn_kernarg_segment_ptr();
    extern __shared__ __attribute__((aligned(16))) unsigned char lds_raw[];
    cg::grid_group grid = cg::this_grid();
    LAS unsigned char* lds = (LAS unsigned char*)lds_raw;
    LAS int* qslot = (LAS int*)(lds + 131072 + 1024);
    const int tid = threadIdx.x, lane = tid & 63, wid = __builtin_amdgcn_readfirstlane(tid >> 6);
    volatile LAS unsigned* xst = (volatile LAS unsigned*)(lds + 131072 + 2048);
    if (tid < 2) xst[tid] = 0u;
    __syncthreads();
    const XcdBarrier xbar = xcd_barrier_post((unsigned*)(P->ws + WS_CTL) + CW_XBAR, xst);

#ifndef REP_P0
#define REP_P0 1
#endif
    for (int r0_ = 0; r0_ < REP_P0; ++r0_) { if (r0_) __syncthreads(); p0_prologue(P, lds, tid, lane, wid); }
    for (int rs_ = 0; rs_ < REP_SYNC; ++rs_) xcd_barrier(xbar);
    if (xb_ld(&xbar.bar[XB_TMO]) != 0u) grid.sync();

#pragma unroll 1
    for (int l = 0; l < 2; ++l) {
#ifndef REP_P1
#define REP_P1 1
#endif
        for (int r1_ = 0; r1_ < REP_P1; ++r1_) p1_rows(P, l, lane, wid);
        for (int rs_ = 0; rs_ < REP_SYNC; ++rs_) xcd_barrier(xbar);
#ifndef NO_P2
#pragma unroll 1
        for (int rep_ = 0; rep_ < REP_P2; ++rep_) {
            RELOAD_P(P); unsigned char* ws = P->ws; const unsigned char* wl = ws + WS_W + (size_t)l * W_LAYER_B; bf16* Z = (bf16*)(ws + WS_Z); unsigned* ctl = (unsigned*)(ws + WS_CTL); (void)wl; (void)Z; (void)ctl;
            pg8::Gemm g{(const bf16*)(ws + WS_H), (const bf16*)wl, MTOK, NCOL, DM};
            pg8::WinOrder S{(int)gridDim.x, (int)blockIdx.x};
            pg8::EpiPlain E{Z, NCOL};
            pg8::gemm_phase<pg8::EpiPlain, pg8::WinOrder, true, true>(lds, g, S, E);
        }
#endif
        for (int rs_ = 0; rs_ < REP_SYNC; ++rs_) xcd_barrier(xbar);
#ifndef NO_P3
#pragma unroll 1
        for (int rep_ = 0; rep_ < REP_P3; ++rep_) {
            RELOAD_P(P); unsigned char* ws = P->ws; const unsigned char* wl = ws + WS_W + (size_t)l * W_LAYER_B; bf16* Z = (bf16*)(ws + WS_Z); unsigned* ctl = (unsigned*)(ws + WS_CTL); (void)wl; (void)Z; (void)ctl;
            unsigned* ctr = ctl + 64 * (1 + 2 * l) + 320 * rep_;
            unsigned pre0 = 0u; if (tid == 0) pre0 = atomicAdd(ctr, 1u);
            if (gridDim.x == 256) {
#pragma unroll 1
                for (int k = 0; k < 3; ++k) {
                    int item, gs;
                    if (k < 2) { item = (int)blockIdx.x + 256 * k; gs = wid; }
                    else { if (wid >= 4) break; item = 512 + ((int)blockIdx.x >> 1); gs = ((int)blockIdx.x & 1) * 4 + wid; }
                    ssm_item<1>(P, l, item, lds, tid, lane, wid, gs);
                }
            } else {
                for (int item = (int)blockIdx.x; item < 640; item += (int)gridDim.x) ssm_item<1>(P, l, item, lds, tid, lane, wid, wid);
            }
            for (bool first = true;; first = false) {
                int it;
                if (first) { __syncthreads(); if (tid == 0) *qslot = (int)pre0; __syncthreads(); it = *qslot; } else it = q_next(ctr, qslot, tid);
                if (it >= 1016) break;
                if (it < 64 || (it >= 760 && it < 1016)) {
                    const int ia = it < 64 ? it : it - 696;
                    for (int ra_ = 0; ra_ < REP_ATT; ++ra_) { if (ra_) __syncthreads(); attn_item(P, l, ia, lds, tid, lane, wid); }
                } else if (it < 120) {
                    pg8::Gemm g{(const bf16*)(ws + WS_H), (const bf16*)wl, MTOK, NCOL, DM};
                    pg8::OneUnit S1{1024 + (it - 64)};
                    pg8::EpiPlain E{Z, NCOL};
                    pg8::gemm_phase<pg8::EpiPlain, pg8::OneUnit, true, true>(lds, g, S1, E);
                } else {
                    for (int ra_ = 0; ra_ < REP_CONV; ++ra_) { if (ra_) __syncthreads(); conv_item(P, l, it - 120, lds, tid, lane, wid); }
                }
            }
        }
#endif
        for (int rs_ = 0; rs_ < REP_SYNC; ++rs_) xcd_barrier(xbar);
#ifndef NO_P4
#pragma unroll 1
        for (int rep_ = 0; rep_ < REP_P4; ++rep_) {
            RELOAD_P(P); unsigned char* ws = P->ws; const unsigned char* wl = ws + WS_W + (size_t)l * W_LAYER_B; bf16* Z = (bf16*)(ws + WS_Z); unsigned* ctl = (unsigned*)(ws + WS_CTL); (void)wl; (void)Z; (void)ctl;
            unsigned* ctr = ctl + 64 * (2 + 2 * l) + 320 * rep_;
            (void)ctr;
            if (gridDim.x == 256) {
#pragma unroll 1
                for (int k = 0; k < 3; ++k) {
                    int item, gs;
                    if (k < 2) { item = (int)blockIdx.x + 256 * k; gs = wid; }
                    else { if (wid >= 4) break; item = 512 + ((int)blockIdx.x >> 1); gs = ((int)blockIdx.x & 1) * 4 + wid; }
                    const int it2 = item < 128 ? 512 + item : item - 128;
                    ssm_item<2>(P, l, it2, lds, tid, lane, wid, gs);
                }
            } else {
                for (int item = (int)blockIdx.x; item < 640; item += (int)gridDim.x) { const int it2 = item < 128 ? 512 + item : item - 128; ssm_item<2>(P, l, it2, lds, tid, lane, wid, wid); }
            }
#ifdef DBG_NAIVE_STATE
#pragma unroll 1
            for (int it = blockIdx.x; it < 256; it += gridDim.x) naive_state_item(P, l, it, tid);
#endif
        }
#endif
        for (int rs_ = 0; rs_ < REP_SYNC; ++rs_) xcd_barrier(xbar);
#pragma unroll 1
        for (int rep_ = 0; rep_ < REP_P56; ++rep_) {
            RELOAD_P(P); unsigned char* ws = P->ws; const unsigned char* wl = ws + WS_W + (size_t)l * W_LAYER_B; bf16* Z = (bf16*)(ws + WS_Z);
            const int G = (int)gridDim.x, NB = G >= 200 ? 160 : (G * 5) / 8;
            if ((int)blockIdx.x < NB) {
                pg8::Gemm g{(const bf16*)(ws + WS_ABR), (const bf16*)(wl + W_IN_B + W_GLU_B), 3 * MTOK, 3 * 1024, 512};
                pg8::BranchOrderX S{NB, (int)blockIdx.x};
                pg8::EpiBranch E{(bf16*)(ws + WS_H), Z + C_MERGE, NCOL};
                pg8::gemm_phase<pg8::EpiBranch, pg8::BranchOrderX, true, true>(lds, g, S, E);
            } else {
                pg8::Gemm g{(const bf16*)(ws + WS_YB), (const bf16*)(wl + W_IN_B), MTOK, 1024, 512};
                pg8::GluOrder S{G - NB, (int)blockIdx.x - NB};
                pg8::EpiGlu E{(bf16*)(ws + WS_ABR) + (size_t)MTOK * 512, Z + C_SGATE, NCOL};
                pg8::gemm_phase<pg8::EpiGlu, pg8::GluOrder, true, true>(lds, g, S, E);
            }
        }
        for (int rs_ = 0; rs_ < REP_SYNC; ++rs_) xcd_barrier(xbar);
#pragma unroll 1
        for (int rep_ = 0; rep_ < 1; ++rep_) {
            RELOAD_P(P); unsigned char* ws = P->ws; const unsigned char* wl = ws + WS_W + (size_t)l * W_LAYER_B; bf16* Z = (bf16*)(ws + WS_Z);
            pg8::Gemm g{(const bf16*)(ws + WS_ABR), (const bf16*)(wl + W_IN_B + W_GLU_B), 3 * MTOK, 3 * 1024, 512};
            pg8::BranchOrderY S{(int)gridDim.x, (int)blockIdx.x};
            pg8::EpiBranch E{(bf16*)(ws + WS_H), Z + C_MERGE, NCOL};
            pg8::gemm_phase<pg8::EpiBranch, pg8::BranchOrderY, true, true>(lds, g, S, E);
            if (l == 0 && defer_l1_weights() && blockIdx.x >= 160) convert_weights(P, 1, 1, 160, lds);
        }
        for (int rs_ = 0; rs_ < REP_SYNC; ++rs_) xcd_barrier(xbar);
#ifndef REP_P7L0
#define REP_P7L0 1
#endif
#pragma unroll 1
        for (int rep7_ = 0; rep7_ < (l == 0 ? REP_P7L0 : 1); ++rep7_) {
            RELOAD_P(P); unsigned char* ws = P->ws; const unsigned char* wl = ws + WS_W + (size_t)l * W_LAYER_B; bf16* Z = (bf16*)(ws + WS_Z); unsigned* ctl = (unsigned*)(ws + WS_CTL); (void)wl; (void)Z; (void)ctl;
            pg8::Gemm g{(const bf16*)(ws + WS_H), (const bf16*)(wl + W_IN_B + W_GLU_B + W_BR_B), MTOK, 1024, 1024};
            pg8::StaticOrder S; S.init(MTOK, 1024, (int)gridDim.x, (int)blockIdx.x);
            const float* gate = (const float*)(ws + WS_MODS) + (size_t)l * 3 * 3072 + 2048;
            pg8::EpiResid E{l == 0 ? P->in[I_XP] : P->out, l == 0 ? P->in[I_XS] : P->out + (size_t)MCTX * DM, P->out, gate};
            pg8::gemm_phase<pg8::EpiResid, pg8::StaticOrder, true, true>(lds, g, S, E);
            if (l == 0 && defer_l1_weights() && blockIdx.x >= 160) convert_weights(P, 1, 0, 160, lds);
        }
        if (l == 0) for (int rs_ = 0; rs_ < REP_SYNC; ++rs_) xcd_barrier(xbar);
    }
}

extern "C" void kernel_launch(void* const* d_in, const int* in_sizes, int n_in, void* d_out, int out_size, void* d_ws, size_t ws_size, hipStream_t stream) {
    static int grid = 0;
    if (grid == 0) {
        if (n_in != 31 || ws_size < WS_END) { fprintf(stderr, "kernel_launch: unexpected n_in %d / ws_size %zu (need %zu)\n", n_in, ws_size, (size_t)WS_END); grid = -1; return; }
        int dev = 0, cus = 0, per_cu = 0;
        hipGetDevice(&dev);
        hipDeviceGetAttribute(&cus, hipDeviceAttributeMultiprocessorCount, dev);
        if (hipFuncSetAttribute((const void*)fwd_kernel, hipFuncAttributeMaxDynamicSharedMemorySize, LDS_BYTES) != hipSuccess) { fprintf(stderr, "kernel_launch: hipFuncSetAttribute failed\n"); grid = -1; return; }
        if (hipOccupancyMaxActiveBlocksPerMultiprocessor(&per_cu, (const void*)fwd_kernel, 512, LDS_BYTES) != hipSuccess || per_cu < 1) { fprintf(stderr, "kernel_launch: occupancy query says %d\n", per_cu); (void)hipGetLastError(); per_cu = 1; }
        grid = cus * 1;
    }
    if (grid < 0) return;
    (void)hipMemsetAsync((char*)d_ws + WS_CTL, 0, CTL_ZERO_BYTES, stream);
    Params p{};
    for (int i = 0; i < 31; ++i) p.in[i] = (const float*)d_in[i];
    p.out = (float*)d_out; p.ws = (unsigned char*)d_ws;
    void* args[] = {&p};
    hipError_t e = hipLaunchCooperativeKernel((const void*)fwd_kernel, dim3(grid), dim3(512), args, LDS_BYTES, stream);
    if (e != hipSuccess) fprintf(stderr, "cooperative launch failed: %s (grid %d)\n", hipGetErrorString(e), grid);
}
```

```cpp
#include <hip/hip_runtime.h>
#include <hip/hip_cooperative_groups.h>
#include <cstdio>
#include <cstdint>
#include <cmath>
namespace cg = cooperative_groups;
namespace pg8 {
#define PG8_LAS __attribute__((address_space(3)))
typedef unsigned short bf16_t;
typedef short bf16x8 __attribute__((ext_vector_type(8)));
typedef float f32x4 __attribute__((ext_vector_type(4)));
typedef unsigned u32x4 __attribute__((ext_vector_type(4)));
constexpr int BM = 256, BK = 64, HALF = 128, HTB = HALF * BK * 2  , STAGE_BYTES = 8 * HTB, NXCD = 8, WGM = 8;

__host__ __device__ __forceinline__ int lds_byte(int r, int c) { const int st = (r >> 4) * 2 + (c >> 5), rr = r & 15, cc = c & 31, ob = rr * 64 + cc * 2; return st * 1024 + (ob ^ (((ob >> 9) & 1) << 5)); }
__host__ __device__ __forceinline__ void stage_rc(int b, int& R, int& C) { const int st = b / 1024, sb = b % 1024, swz = sb ^ (((sb >> 9) & 1) << 5); R = (st >> 1) * 16 + swz / 64; C = (st & 1) * 32 + (swz % 64) / 2; }
__host__ __device__ __forceinline__ int perm32(int rho) { const int n = rho >> 4, i = rho & 15; return 8 * (i >> 2) + 4 * n + (i & 3); }

struct Unit { int pm, pn; };
struct Gemm { const bf16_t* A; const bf16_t* Bt; int M, N, K; };

struct StaticOrder {
    int nM, nN, nwg, G, c;
    __host__ __device__ void init(int M, int N, int G_, int c_) { nM = M / BM; nN = N / BM; nwg = nM * nN; G = G_; c = c_; }
    __host__ __device__ bool next(int i, Unit& u) const {
        const long L = (long)i * G + c; if (L >= nwg) return false;
        int wgid = (int)L; { const int q = nwg / NXCD, r = nwg % NXCD, xcd = wgid % NXCD, off = wgid / NXCD; wgid = (xcd < r ? xcd * (q + 1) : r * (q + 1) + (xcd - r) * q) + off; }
        const int nig = WGM * nN, gid = wgid / nig, fm = gid * WGM, gsz = (nM - fm) < WGM ? (nM - fm) : WGM;
        u.pm = fm + ((wgid % nig) % gsz); u.pn = (wgid % nig) / gsz; return true;
    }
    __device__ __forceinline__ void a_ready(const Unit&) const {}
    __device__ __forceinline__ void done(const Unit&) const {}
};

__device__ __forceinline__ unsigned cvt_pk_bf16(float lo, float hi) { unsigned r; asm volatile("v_cvt_pk_bf16_f32 %0, %1, %2" : "=v"(r) : "v"(lo), "v"(hi)); return r; }
typedef float f32x2 __attribute__((ext_vector_type(2)));
typedef unsigned u32x4e __attribute__((ext_vector_type(4)));
__device__ __forceinline__ float bf_lo(unsigned w) { return __uint_as_float(w << 16); }
__device__ __forceinline__ float bf_hi(unsigned w) { return __uint_as_float(w & 0xffff0000u); }
__device__ __forceinline__ float sigm(float x) { return __builtin_amdgcn_rcpf(1.f + __builtin_amdgcn_exp2f(-1.4426950408889634f * x)); }
__device__ __forceinline__ float silu_f(float x) { return x * __builtin_amdgcn_rcpf(1.f + __builtin_amdgcn_exp2f(-1.4426950408889634f * x)); }
__device__ __forceinline__ float glu3(float a, float b, float g) { return a * g * __builtin_amdgcn_rcpf((1.f + __builtin_amdgcn_exp2f(-1.4426950408889634f * b)) * (1.f + __builtin_amdgcn_exp2f(-1.4426950408889634f * g))); }

struct EpiPlain {
    static constexpr bool PERM = true, AFTER_DRAIN = false;
    bf16_t* O; int ldc;
    __device__ __forceinline__ void operator()(const f32x4 (&acc)[2][2][4][2], const Unit& u, int wr, int wc, int fr, int fq) const {
        const int row0 = u.pm * BM + wr * 64 + fr, col0 = u.pn * BM + wc * 32 + 8 * fq;
#pragma unroll
        for (int ai = 0; ai < 2; ++ai)
#pragma unroll
            for (int m = 0; m < 4; ++m) { bf16_t* rowp = O + (size_t)(row0 + ai * HALF + m * 16) * ldc + col0;
#pragma unroll
                for (int bj = 0; bj < 2; ++bj) { const f32x4 v0 = acc[ai][bj][m][0], v1 = acc[ai][bj][m][1];
                    u32x4e w; w.x = cvt_pk_bf16(v0[0], v0[1]); w.y = cvt_pk_bf16(v0[2], v0[3]); w.z = cvt_pk_bf16(v1[0], v1[1]); w.w = cvt_pk_bf16(v1[2], v1[3]);
                    *(u32x4e*)(rowp + bj * HALF) = w; } }
    }
};
struct EpiGlu {
    static constexpr bool PERM = true, AFTER_DRAIN = false;
    bf16_t* O; const bf16_t* Zg; int ldz;
    __device__ __forceinline__ void operator()(const f32x4 (&acc)[2][2][4][2], const Unit& u, int wr, int wc, int fr, int fq) const {
        const int row0 = u.pm * BM + wr * 64 + fr, oc0 = u.pn * 128 + wc * 32 + 8 * fq;
#pragma unroll
        for (int ai = 0; ai < 2; ++ai)
#pragma unroll
            for (int m = 0; m < 4; ++m) { const int r = row0 + ai * HALF + m * 16;
                const u32x4e gz = *(const u32x4e*)(Zg + (size_t)r * ldz + oc0);
                const f32x4 a0 = acc[ai][0][m][0], a1 = acc[ai][0][m][1], b0 = acc[ai][1][m][0], b1 = acc[ai][1][m][1];
                float o[8];
                o[0] = glu3(a0[0], b0[0], bf_lo(gz.x)); o[1] = glu3(a0[1], b0[1], bf_hi(gz.x));
                o[2] = glu3(a0[2], b0[2], bf_lo(gz.y)); o[3] = glu3(a0[3], b0[3], bf_hi(gz.y));
                o[4] = glu3(a1[0], b1[0], bf_lo(gz.z)); o[5] = glu3(a1[1], b1[1], bf_hi(gz.z));
                o[6] = glu3(a1[2], b1[2], bf_lo(gz.w)); o[7] = glu3(a1[3], b1[3], bf_hi(gz.w));
                u32x4e w; w.x = cvt_pk_bf16(o[0], o[1]); w.y = cvt_pk_bf16(o[2], o[3]); w.z = cvt_pk_bf16(o[4], o[5]); w.w = cvt_pk_bf16(o[6], o[7]);
                *(u32x4e*)(O + (size_t)r * 512 + oc0) = w; }
    }
};
struct EpiBranch {
    static constexpr bool PERM = true, AFTER_DRAIN = false;
    bf16_t* MIX; const bf16_t* Zm; int ldz;
    __device__ __forceinline__ void operator()(const f32x4 (&acc)[2][2][4][2], const Unit& u, int wr, int wc, int fr, int fq) const {
        const int br = u.pn >> 2, pn = u.pn & 3, pm = u.pm - 40 * br;
        const int row0 = pm * BM + wr * 64 + fr, col0 = pn * BM + wc * 32 + 8 * fq;
#pragma unroll
        for (int ai = 0; ai < 2; ++ai)
#pragma unroll
            for (int m = 0; m < 4; ++m) { const int r = row0 + ai * HALF + m * 16;
#pragma unroll
                for (int bj = 0; bj < 2; ++bj) { const int c = col0 + bj * HALF;
                    const u32x4e gz = *(const u32x4e*)(Zm + (size_t)r * ldz + br * 1024 + c);
                    u32x4e pv = (u32x4e){0u, 0u, 0u, 0u};
                    if (br > 0) pv = *(const u32x4e*)(MIX + (size_t)r * 1024 + c);
                    const f32x4 v0 = acc[ai][bj][m][0], v1 = acc[ai][bj][m][1];
                    float o[8];
                    o[0] = v0[0] * sigm(bf_lo(gz.x)) + bf_lo(pv.x); o[1] = v0[1] * sigm(bf_hi(gz.x)) + bf_hi(pv.x);
                    o[2] = v0[2] * sigm(bf_lo(gz.y)) + bf_lo(pv.y); o[3] = v0[3] * sigm(bf_hi(gz.y)) + bf_hi(pv.y);
                    o[4] = v1[0] * sigm(bf_lo(gz.z)) + bf_lo(pv.z); o[5] = v1[1] * sigm(bf_hi(gz.z)) + bf_hi(pv.z);
                    o[6] = v1[2] * sigm(bf_lo(gz.w)) + bf_lo(pv.w); o[7] = v1[3] * sigm(bf_hi(gz.w)) + bf_hi(pv.w);
                    u32x4e w; w.x = cvt_pk_bf16(o[0], o[1]); w.y = cvt_pk_bf16(o[2], o[3]); w.z = cvt_pk_bf16(o[4], o[5]); w.w = cvt_pk_bf16(o[6], o[7]);
                    *(u32x4e*)(MIX + (size_t)r * 1024 + c) = w; } }
    }
};
struct WinOrder {
    int G, c;
    __device__ __forceinline__ static void unit_of(int W, Unit& u) { const int gid = W / 216, rr = W % 216; u.pm = gid * 8 + (rr & 7); u.pn = rr >> 3; }
    __device__ __forceinline__ bool next(int i, Unit& u) const {
        const int L = i * G + c; if (L >= 1024) return false;
        unit_of((L & 7) * 128 + (L >> 3), u); return true;
    }
    __device__ __forceinline__ void a_ready(const Unit&) const {}
    __device__ __forceinline__ void done(const Unit&) const {}
};
struct OneUnit {
    int W;
    __device__ __forceinline__ bool next(int i, Unit& u) const { if (i > 0) return false; WinOrder::unit_of(W, u); return true; }
    __device__ __forceinline__ void a_ready(const Unit&) const {}
    __device__ __forceinline__ void done(const Unit&) const {}
};
struct BranchOrderX {
    int NB, c;
    __device__ __forceinline__ bool next(int i, Unit& u) const {
        const int tI = (i >> 1) * NB + c, br = (i & 1) * 2; if (tI >= 160) return false;
        u.pm = br * 40 + (tI >> 2); u.pn = br * 4 + (tI & 3); return true;
    }
    __device__ __forceinline__ void a_ready(const Unit&) const {}
    __device__ __forceinline__ void done(const Unit&) const {}
};
struct GluOrder {
    int NG, c;
    __device__ __forceinline__ bool next(int i, Unit& u) const {
        const int tI = i * NG + c; if (tI >= 160) return false;
        u.pm = tI >> 2; u.pn = tI & 3; return true;
    }
    __device__ __forceinline__ void a_ready(const Unit&) const {}
    __device__ __forceinline__ void done(const Unit&) const {}
};
struct BranchOrderY {
    int G, c;
    __device__ __forceinline__ bool next(int i, Unit& u) const {
        const int tI = i * G + c; if (tI >= 160) return false;
        u.pm = 40 + (tI >> 2); u.pn = 4 + (tI & 3); return true;
    }
    __device__ __forceinline__ void a_ready(const Unit&) const {}
    __device__ __forceinline__ void done(const Unit&) const {}
};
struct BranchOrder {
    int G, c;
    __device__ __forceinline__ bool next(int i, Unit& u) const {
        const int tI = (i / 3) * G + c, br = i % 3; if (tI >= 160) return false;
        u.pm = br * 40 + (tI >> 2); u.pn = br * 4 + (tI & 3); return true;
    }
    __device__ __forceinline__ void a_ready(const Unit&) const {}
    __device__ __forceinline__ void done(const Unit&) const {}
};
struct EpiResid {
    static constexpr bool PERM = false, AFTER_DRAIN = false;
    const float* base_ctx; const float* base_lat; float* out; const float* gate;
    __device__ __forceinline__ void operator()(const f32x4 (&acc)[2][2][4][2], const Unit& u, int wr, int wc, int fr, int fq) const {
        const int row0 = u.pm * BM + wr * 64 + fr, col0 = u.pn * BM + wc * 32 + 4 * fq;
        const int cond = u.pm < 32 ? 0 : 1 + ((u.pm - 32) >> 2);
        const float* bp = u.pm < 32 ? base_ctx : base_lat - (size_t)8192 * 1024;
        f32x4 gv[2][2];
#pragma unroll
        for (int bj = 0; bj < 2; ++bj)
#pragma unroll
            for (int n = 0; n < 2; ++n) gv[bj][n] = *(const f32x4*)(gate + cond * 3072 + col0 + bj * HALF + n * 16);
#pragma unroll
        for (int ai = 0; ai < 2; ++ai)
#pragma unroll
            for (int m = 0; m < 4; ++m) { const size_t off = (size_t)(row0 + ai * HALF + m * 16) * 1024 + col0;
#pragma unroll
                for (int bj = 0; bj < 2; ++bj)
#pragma unroll
                    for (int n = 0; n < 2; ++n) { const f32x4 bs = *(const f32x4*)(bp + off + bj * HALF + n * 16);
                        *(f32x4*)(out + off + bj * HALF + n * 16) = bs + gv[bj][n] * acc[ai][bj][m][n]; } }
    }
};
template <class Epi, class Sched, bool ALIGN_EPI = false, bool SP2 = false>
__device__ __forceinline__ void gemm_phase(PG8_LAS unsigned char* lds, const Gemm g, const Sched& S, const Epi& E) {
    int tid_l = threadIdx.x; asm volatile("" : "+v"(tid_l));
    const int tid = tid_l, wid = __builtin_amdgcn_readfirstlane(tid >> 6), lane = tid & 63, wr = wid >> 2, wc = wid & 3, fr = lane & 15, fq = lane >> 4;
    const int K = g.K, nt = K / BK;
    unsigned voffA[2], voffB[2];
#pragma unroll
    for (int i = 0; i < 2; ++i) { int R, C; stage_rc(tid * 16 + i * 8192, R, C); const int Rb = Epi::PERM ? ((R & ~31) + perm32(R & 31)) : R;
        voffA[i] = (unsigned)(R * K + C) * 2u; voffB[i] = (unsigned)(Rb * K + C) * 2u; }
    const size_t kstep = (size_t)(BK * 2);
    const size_t hstep = (size_t)HALF * K * 2;
    const size_t tstep = 2 * hstep;
    const unsigned ldsw = (unsigned)wid * 1024u;
    const int aoff = lds_byte(wr * 64 + fr, fq * 8), boff = lds_byte(wc * 32 + fr, fq * 8);
#define PG8_SA(b, h) (((b) * 2 + (h)) * HTB)
#define PG8_SB(b, h) ((4 + (b) * 2 + (h)) * HTB)
#define PG8_STAGE(bufoff, gbase, voff) do { _Pragma("unroll") for (int _i = 0; _i < 2; ++_i) \
        __builtin_amdgcn_global_load_lds((const unsigned*)((const char*)(gbase) + (voff)[_i]), (PG8_LAS unsigned*)(lds + (bufoff) + ldsw + _i * 8192), 16, 0, 0); } while (0)
#define PG8_LDA(dst, b, h) do { _Pragma("unroll") for (int m = 0; m < 4; ++m) _Pragma("unroll") for (int k = 0; k < 2; ++k) dst[m][k] = *(const PG8_LAS bf16x8*)(lds + PG8_SA(b, h) + aoff + m * 2048 + k * 1024); } while (0)
#define PG8_LDB(dst, b, h) do { _Pragma("unroll") for (int n = 0; n < 2; ++n) _Pragma("unroll") for (int k = 0; k < 2; ++k) dst[n][k] = *(const PG8_LAS bf16x8*)(lds + PG8_SB(b, h) + boff + n * 2048 + k * 1024); } while (0)
#define PG8_MMA(ai, bj, At, Bt) do { __builtin_amdgcn_s_setprio(1); _Pragma("unroll") for (int m = 0; m < 4; ++m) _Pragma("unroll") for (int n = 0; n < 2; ++n) _Pragma("unroll") for (int k = 0; k < 2; ++k) \
        acc[ai][bj][m][n] = __builtin_amdgcn_mfma_f32_16x16x32_bf16(Bt[n][k], At[m][k], acc[ai][bj][m][n], 0, 0, 0); __builtin_amdgcn_s_setprio(0); } while (0)
#define PG8_WAIT_V(n) asm volatile("s_waitcnt vmcnt(" #n ")" ::: "memory")
#define PG8_WAIT_L(n) asm volatile("s_waitcnt lgkmcnt(" #n ")" ::: "memory")
#define PG8_BAR __builtin_amdgcn_s_barrier()
#define PG8_SCHED __builtin_amdgcn_sched_barrier(0)
    Unit cur, nxt; int ui = 0;
    if (!S.next(0, cur)) return;
    f32x4 acc[2][2][4][2];
#pragma unroll
    for (int a = 0; a < 2; ++a)
#pragma unroll
        for (int b = 0; b < 2; ++b)
#pragma unroll
            for (int m = 0; m < 4; ++m)
#pragma unroll
                for (int n = 0; n < 2; ++n) acc[a][b][m][n] = (f32x4){0.f, 0.f, 0.f, 0.f};
    bf16x8 At[4][2], B0[2][2], B1[2][2];
    const char* cA = (const char*)g.A + (size_t)cur.pm * tstep; const char* cB = (const char*)g.Bt + (size_t)cur.pn * tstep;
    S.a_ready(cur);
    if constexpr (SP2) {
        PG8_STAGE(PG8_SB(0, 0), cB, voffB); PG8_STAGE(PG8_SB(0, 1), cB + hstep, voffB); PG8_STAGE(PG8_SA(0, 0), cA, voffA); PG8_STAGE(PG8_SA(0, 1), cA + hstep, voffA);
        if (wr == 1) PG8_BAR;
        PG8_WAIT_V(2); PG8_BAR;
        PG8_STAGE(PG8_SB(1, 0), cB + kstep, voffB); PG8_STAGE(PG8_SA(1, 0), cA + kstep, voffA); PG8_STAGE(PG8_SB(1, 1), cB + hstep + kstep, voffB);
        PG8_WAIT_V(6); PG8_BAR;
    } else {
        PG8_STAGE(PG8_SB(0, 0), cB, voffB); PG8_STAGE(PG8_SA(0, 0), cA, voffA); PG8_STAGE(PG8_SB(0, 1), cB + hstep, voffB); PG8_STAGE(PG8_SA(0, 1), cA + hstep, voffA);
        if (wr == 1) PG8_BAR;
        PG8_WAIT_V(4); PG8_BAR;
        PG8_STAGE(PG8_SB(1, 0), cB + kstep, voffB); PG8_STAGE(PG8_SA(1, 0), cA + kstep, voffA); PG8_STAGE(PG8_SB(1, 1), cB + hstep + kstep, voffB);
        PG8_WAIT_V(6); PG8_BAR;
    }
    for (;;) {
        const bool has_next = S.next(ui + 1, nxt);
        const char* nA = has_next ? (const char*)g.A + (size_t)nxt.pm * tstep : cA; const char* nB = has_next ? (const char*)g.Bt + (size_t)nxt.pn * tstep : cB;
        for (int t = 0; t < nt; t += 2) {
            const bool last = (t == nt - 2);
            const char* a1 = cA + (size_t)(t + 1) * kstep;
            const char* a2 = last ? nA : cA + (size_t)(t + 2) * kstep; const char* b2 = last ? nB : cB + (size_t)(t + 2) * kstep;
            const char* a3 = a2 + kstep; const char* b3 = b2 + kstep;
            if (last && has_next) S.a_ready(nxt);
            if constexpr (SP2) {
            PG8_LDB(B0, 0, 0); PG8_LDB(B1, 0, 1); PG8_SCHED; PG8_LDA(At, 0, 0); PG8_STAGE(PG8_SA(1, 1), a1 + hstep, voffA);
            PG8_WAIT_V(8); PG8_WAIT_L(0); PG8_BAR; PG8_MMA(0, 0, At, B0); PG8_MMA(0, 1, At, B1); PG8_BAR; PG8_SCHED;
            PG8_LDA(At, 0, 1); PG8_STAGE(PG8_SB(0, 0), b2, voffB); PG8_STAGE(PG8_SB(0, 1), b2 + hstep, voffB); PG8_STAGE(PG8_SA(0, 0), a2, voffA);
            PG8_WAIT_V(8); PG8_WAIT_L(0); PG8_BAR; PG8_MMA(1, 0, At, B0); PG8_MMA(1, 1, At, B1); PG8_BAR; PG8_SCHED;
            PG8_LDB(B0, 1, 0); PG8_LDB(B1, 1, 1); PG8_SCHED; PG8_LDA(At, 1, 0); PG8_STAGE(PG8_SA(0, 1), a2 + hstep, voffA);
            PG8_WAIT_V(8); PG8_WAIT_L(0); PG8_BAR; PG8_MMA(0, 0, At, B0); PG8_MMA(0, 1, At, B1); PG8_BAR; PG8_SCHED;
            PG8_LDA(At, 1, 1); PG8_STAGE(PG8_SB(1, 0), b3, voffB); PG8_STAGE(PG8_SB(1, 1), b3 + hstep, voffB); PG8_STAGE(PG8_SA(1, 0), a3, voffA);
            PG8_WAIT_V(8); PG8_WAIT_L(0); PG8_BAR; PG8_MMA(1, 0, At, B0); PG8_MMA(1, 1, At, B1); PG8_BAR; PG8_SCHED;
            } else {
            PG8_LDB(B0, 0, 0); PG8_SCHED; PG8_LDA(At, 0, 0); PG8_STAGE(PG8_SA(1, 1), a1 + hstep, voffA);
            PG8_WAIT_L(8); PG8_BAR; PG8_WAIT_L(0); PG8_MMA(0, 0, At, B0); PG8_BAR; PG8_SCHED;
            PG8_LDB(B1, 0, 1); PG8_STAGE(PG8_SB(0, 0), b2, voffB);
            PG8_BAR; PG8_WAIT_L(0); PG8_MMA(0, 1, At, B1); PG8_BAR;
            PG8_LDA(At, 0, 1); PG8_STAGE(PG8_SA(0, 0), a2, voffA);
            PG8_BAR; PG8_WAIT_L(0); PG8_MMA(1, 0, At, B0); PG8_BAR; PG8_SCHED;
            PG8_STAGE(PG8_SB(0, 1), b2 + hstep, voffB);
            PG8_WAIT_V(6); PG8_BAR; PG8_MMA(1, 1, At, B1); PG8_BAR;
            PG8_LDB(B0, 1, 0); PG8_SCHED; PG8_LDA(At, 1, 0); PG8_STAGE(PG8_SA(0, 1), a2 + hstep, voffA);
            PG8_WAIT_L(8); PG8_BAR; PG8_WAIT_L(0); PG8_MMA(0, 0, At, B0); PG8_BAR; PG8_SCHED;
            PG8_LDB(B1, 1, 1); PG8_STAGE(PG8_SB(1, 0), b3, voffB);
            PG8_BAR; PG8_WAIT_L(0); PG8_MMA(0, 1, At, B1); PG8_BAR;
            PG8_LDA(At, 1, 1); PG8_STAGE(PG8_SA(1, 0), a3, voffA);
            PG8_BAR; PG8_WAIT_L(0); PG8_MMA(1, 0, At, B0); PG8_BAR; PG8_SCHED;
            PG8_STAGE(PG8_SB(1, 1), b3 + hstep, voffB);
            PG8_WAIT_V(6); PG8_BAR; PG8_MMA(1, 1, At, B1); PG8_BAR;
            }
        }
        if constexpr (ALIGN_EPI) { if (wr == 0) PG8_BAR; }
        if constexpr (!Epi::AFTER_DRAIN) { E(acc, cur, wr, wc, fr, fq); S.done(cur); }
        if (!has_next) break;
#pragma unroll
        for (int a = 0; a < 2; ++a)
#pragma unroll
            for (int b = 0; b < 2; ++b)
#pragma unroll
                for (int m = 0; m < 4; ++m)
#pragma unroll
                    for (int n = 0; n < 2; ++n) acc[a][b][m][n] = (f32x4){0.f, 0.f, 0.f, 0.f};
        cur = nxt; cA = nA; cB = nB; ++ui;
        if constexpr (ALIGN_EPI) { if (wr == 1) PG8_BAR; }
    }
    PG8_WAIT_V(0);
    if constexpr (!ALIGN_EPI) { if (wr == 0) PG8_BAR; }
    PG8_BAR;
    if constexpr (Epi::AFTER_DRAIN) { E.fused(acc, cur, wr, wc, fr, fq, lds, wid, lane); S.done(cur); }
#undef PG8_SA
#undef PG8_SB
#undef PG8_STAGE
#undef PG8_LDA
#undef PG8_LDB
#undef PG8_MMA
#undef PG8_WAIT_V
#undef PG8_WAIT_L
#undef PG8_BAR
#undef PG8_SCHED
}
}

#define LAS __attribute__((address_space(3)))
typedef unsigned short bf16;
typedef unsigned u32x4 __attribute__((ext_vector_type(4)));
typedef unsigned u32x2 __attribute__((ext_vector_type(2)));
typedef float f32x4 __attribute__((ext_vector_type(4)));
typedef float f32x2 __attribute__((ext_vector_type(2)));
typedef float f32x16 __attribute__((ext_vector_type(16)));
typedef short bf16x8 __attribute__((ext_vector_type(8)));
using pg8::cvt_pk_bf16; using pg8::bf_lo; using pg8::bf_hi; using pg8::sigm; using pg8::silu_f;

constexpr int DM = 1024, NCOL = 6912, MTOK = 10240, MCTX = 8192;
constexpr int C_CONVA = 0, C_CONVG = 512, C_CGATE = 1024, C_SSMIN = 1536, C_SGATE = 2048, C_Q = 2560, C_K = 3072, C_V = 3200, C_AGATE = 3328, C_MERGE = 3840;
constexpr float EPS = 1e-6f;
constexpr size_t MiB = (size_t)1 << 20;
constexpr size_t WS_CTL = 0, CTL_ZERO_BYTES = 256 * 1024;
constexpr size_t WS_MODS = 4096;
constexpr size_t WS_ROPE = 1 * MiB;
constexpr size_t WS_LAM = 1 * MiB + 64 * 1024;
constexpr size_t WS_BB = 2 * MiB;
constexpr size_t WS_CT = 3 * MiB;
constexpr size_t WS_E = 4 * MiB;
constexpr size_t WS_W = 10 * MiB;
constexpr size_t W_IN_B = (size_t)NCOL * DM * 2, W_GLU_B = (size_t)1024 * 512 * 2, W_BR_B = (size_t)3 * 1024 * 512 * 2, W_OUT_B = (size_t)1024 * 1024 * 2;
constexpr size_t W_LAYER_B = W_IN_B + W_GLU_B + W_BR_B + W_OUT_B;
constexpr size_t WS_H = 50 * MiB;
constexpr size_t WS_ABR = 70 * MiB;
constexpr size_t WS_YB = 100 * MiB;
constexpr size_t WS_MODSP = WS_YB;
constexpr size_t WS_Z = 110 * MiB;
constexpr size_t WS_END = WS_Z + (size_t)MTOK * NCOL * 2;
static_assert(WS_W + 2 * W_LAYER_B <= WS_H && WS_END <= 256 * MiB, "ws map");
constexpr int LDS_BYTES = 147456;

struct Params { const float* in[31]; float* out; unsigned char* ws; };
typedef const __attribute__((address_space(4))) Params* KP;
#define RELOAD_P(P) asm volatile("" : "+s"(P))
enum { I_XP = 0, I_XS, I_CK, I_CV, I_SRE, I_SIM, I_C, I_CCTX, I_NG, I_WADA, I_BADA, I_WIN, I_DWW, I_DWB, I_LNG, I_LNB, I_WCO, I_ARE, I_AIM, I_LDT, I_BRE, I_BIM, I_CRE, I_CIM, I_SD, I_WGLU, I_WSO, I_QG, I_KG, I_WAO, I_WOUT };
constexpr size_t O_Y = 0, O_CK = 10485760, O_CV = 12582912, O_SRE = 14680064, O_SIM = 14942208;

__device__ __forceinline__ float wave_sum(float v) {
#pragma unroll
    for (int o = 1; o < 64; o <<= 1) v += __shfl_xor(v, o);
    return v;
}
__device__ __forceinline__ void unpack8(const u32x4 w, float* f) {
    f[0] = bf_lo(w.x); f[1] = bf_hi(w.x); f[2] = bf_lo(w.y); f[3] = bf_hi(w.y); f[4] = bf_lo(w.z); f[5] = bf_hi(w.z); f[6] = bf_lo(w.w); f[7] = bf_hi(w.w);
}
__device__ __forceinline__ u32x4 pack8(const float* f) {
    u32x4 w; w.x = cvt_pk_bf16(f[0], f[1]); w.y = cvt_pk_bf16(f[2], f[3]); w.z = cvt_pk_bf16(f[4], f[5]); w.w = cvt_pk_bf16(f[6], f[7]); return w;
}
#define MFMA32(a, b, c) __builtin_amdgcn_mfma_f32_32x32x16_bf16((a), (b), (c), 0, 0, 0)
#define MFMA16(a, b, c) __builtin_amdgcn_mfma_f32_16x16x32_bf16((a), (b), (c), 0, 0, 0)

__device__ __forceinline__ void p0_transpose_item(const float* W, int K, int N, bf16* WT, int glu, LAS float* scr, int item, int lane) {
    const int nblk = N / 32, kb = item / nblk, nb = item % nblk, k0 = 64 * kb, n0 = 32 * nb;
    int d0 = n0;
    if (glu) { const int bj = n0 >> 9, rem = n0 & 511; d0 = 256 * (rem >> 7) + 128 * bj + (rem & 127); }
    float wv[32];
    const float* wsrc = W + (size_t)(k0 + (lane >> 5)) * N + n0 + (lane & 31);
#pragma unroll
    for (int i = 0; i < 32; ++i) wv[i] = wsrc[(size_t)(2 * i) * N];
#pragma unroll
    for (int i = 0; i < 32; ++i) scr[(2 * i + (lane >> 5)) * 33 + (lane & 31)] = wv[i];
    asm volatile("s_waitcnt lgkmcnt(0)" ::: "memory");
    const int c = lane & 7;
#pragma unroll
    for (int j = 0; j < 4; ++j) { const int n = (lane >> 3) + 8 * j; const LAS float* s = scr + (8 * c) * 33 + n;
        u32x4 o; o.x = cvt_pk_bf16(s[0 * 33], s[1 * 33]); o.y = cvt_pk_bf16(s[2 * 33], s[3 * 33]); o.z = cvt_pk_bf16(s[4 * 33], s[5 * 33]); o.w = cvt_pk_bf16(s[6 * 33], s[7 * 33]);
        *(u32x4*)(WT + (size_t)(d0 + n) * K + k0 + 8 * c) = o; }
    asm volatile("s_waitcnt lgkmcnt(0)" ::: "memory");
}

#ifndef REP_P0A
#define REP_P0A 1
#endif
__device__ __forceinline__ void convert_weights(KP P, int l, int part, int first_block, LAS unsigned char* lds) {
    RELOAD_P(P);
    asm volatile("" : "+s"(l));
    int tid_ = threadIdx.x; asm volatile("" : "+v"(tid_));
    const int lane = tid_ & 63, wid = __builtin_amdgcn_readfirstlane(tid_ >> 6);
    const int gw = ((int)blockIdx.x - first_block) * 8 + wid, NGW = ((int)gridDim.x - first_block) * 8;
    LAS float* scr = (LAS float*)(lds + wid * 8448);
    constexpr int I_IN = 16 * 216, I_S = 8 * 32, I_O = 16 * 32;
    unsigned char* wl = P->ws + WS_W + (size_t)l * W_LAYER_B;
    if (part == 0) {
        for (int r = gw; r < I_IN; r += NGW) p0_transpose_item(P->in[I_WIN] + (size_t)l * DM * NCOL, DM, NCOL, (bf16*)wl, 0, scr, r, lane);
    } else {
        for (int it = gw; it < 4 * I_S + I_O; it += NGW) {
            int r = it;
            if (r < I_S) { p0_transpose_item(P->in[I_WGLU] + (size_t)l * 512 * 1024, 512, 1024, (bf16*)(wl + W_IN_B), 1, scr, r, lane); continue; } r -= I_S;
            if (r < I_S) { p0_transpose_item(P->in[I_WCO] + (size_t)l * 512 * 1024, 512, 1024, (bf16*)(wl + W_IN_B + W_GLU_B), 0, scr, r, lane); continue; } r -= I_S;
            if (r < I_S) { p0_transpose_item(P->in[I_WSO] + (size_t)l * 512 * 1024, 512, 1024, (bf16*)(wl + W_IN_B + W_GLU_B) + (size_t)1024 * 512, 0, scr, r, lane); continue; } r -= I_S;
            if (r < I_S) { p0_transpose_item(P->in[I_WAO] + (size_t)l * 512 * 1024, 512, 1024, (bf16*)(wl + W_IN_B + W_GLU_B) + (size_t)2048 * 512, 0, scr, r, lane); continue; } r -= I_S;
            p0_transpose_item(P->in[I_WOUT] + (size_t)l * 1024 * 1024, 1024, 1024, (bf16*)(wl + W_IN_B + W_GLU_B + W_BR_B), 0, scr, r, lane);
        }
    }
}
__device__ __forceinline__ bool defer_l1_weights() { return gridDim.x >= 200; }

__device__ __forceinline__ void p0_prologue(KP P, LAS unsigned char* lds, int tid, int lane, int wid) {
    RELOAD_P(P);
    unsigned char* ws = P->ws;
    {
        const int nl = defer_l1_weights() ? 1 : 2;
#pragma unroll 1
        for (int rep0_ = 0; rep0_ < REP_P0A; ++rep0_)
#pragma unroll 1
        for (int lp = 0; lp < 2 * nl; ++lp) convert_weights(P, lp >> 1, lp & 1, 0, lds);
    }
    __syncthreads();
    for (int it = blockIdx.x; it < 209; it += gridDim.x) {
        if (it < 192) {
            const int l = it / 96, n0 = 32 * (it % 96);
            LAS float* sc = (LAS float*)lds;
            LAS float* red = (LAS float*)(lds + 12288);
            __syncthreads();
            for (int i = tid; i < 3072; i += 512) { const int j = i >> 10, k = i & 1023; const float cv = (j == 0) ? P->in[I_CCTX][k] : P->in[I_C][(j - 1) * 1024 + k]; sc[i] = cv / (1.f + __expf(-cv)); }
            __syncthreads();
            const int ks = tid >> 5, col = tid & 31;
            const float* w = P->in[I_WADA] + ((size_t)l * 1024 + ks * 64) * 3072 + n0 + col;
            float a0 = 0.f, a1 = 0.f, a2 = 0.f;
#pragma unroll 16
            for (int k = 0; k < 64; ++k) { const float wv = w[(size_t)k * 3072]; a0 += sc[ks * 64 + k] * wv; a1 += sc[1024 + ks * 64 + k] * wv; a2 += sc[2048 + ks * 64 + k] * wv; }
            red[(ks * 3 + 0) * 32 + col] = a0; red[(ks * 3 + 1) * 32 + col] = a1; red[(ks * 3 + 2) * 32 + col] = a2;
            __syncthreads();
            if (tid < 96) { const int j = tid >> 5, c2 = tid & 31; float sum = P->in[I_BADA][l * 3072 + n0 + c2];
#pragma unroll
                for (int q = 0; q < 16; ++q) sum += red[(q * 3 + j) * 32 + c2];
                ((float*)(ws + WS_MODS))[(l * 3 + j) * 3072 + n0 + c2] = sum; }
        } else if (it < 208) {
            const int idx = (it - 192) * 512 + tid; const int l = idx >> 12, dir = (idx >> 11) & 1, g = (idx >> 6) & 31, p = idx & 63;
            const double are = (double)P->in[I_ARE][idx], aim = (double)P->in[I_AIM][idx], dt = exp((double)P->in[I_LDT][(l * 2 + dir) * 32 + g]);
            const double mag = exp(are * dt), lr = mag * cos(aim * dt), li = mag * sin(aim * dt);
            ((f32x2*)(ws + WS_LAM))[idx] = (f32x2){(float)lr, (float)li};
            const double d2 = are * are + aim * aim, qr = ((lr - 1.0) * are + li * aim) / d2, qi = (li * are - (lr - 1.0) * aim) / d2;
            float bre[16], bim[16];
#pragma unroll
            for (int c = 0; c < 16; ++c) { const double br = (double)P->in[I_BRE][(size_t)idx * 16 + c], bi = (double)P->in[I_BIM][(size_t)idx * 16 + c]; bre[c] = (float)(qr * br - qi * bi); bim[c] = (float)(qr * bi + qi * br); }
            bf16* bb = (bf16*)(ws + WS_BB);
            u32x4* d_re = (u32x4*)(bb + ((size_t)(((l * 2 + dir) * 32 + g) * 2 + 0) * 64 + p) * 16);
            u32x4* d_im = (u32x4*)(bb + ((size_t)(((l * 2 + dir) * 32 + g) * 2 + 1) * 64 + p) * 16);
            d_re[0] = pack8(bre); d_re[1] = pack8(bre + 8); d_im[0] = pack8(bim); d_im[1] = pack8(bim + 8);
            bf16* ct = (bf16*)(ws + WS_CT);
#pragma unroll
            for (int cc = 0; cc < 16; ++cc) { const size_t ci = ((size_t)((l * 2 + dir) * 32 + g) * 16 + cc) * 64 + p;
                const float cre = P->in[I_CRE][ci], cim = P->in[I_CIM][ci];
                *(unsigned*)(ct + ((size_t)(((l * 32 + g) * 2 + dir) * 16 + cc) * 128 + 2 * p)) = cvt_pk_bf16(cre, -cim); }
        } else {
            for (int idx = tid; idx < 1024; idx += 512) { const int pos = idx >> 4, j = idx & 15;
                const double inv = exp(-(double)j / 16.0 * log(10000.0)), ang = (double)pos * inv;
                ((f32x2*)(ws + WS_ROPE))[idx] = (f32x2){(float)cos(ang), (float)sin(ang)}; }
        }
    }
}


__device__ __forceinline__ void p1_rows(KP P, int l, int lane, int wid) {
    RELOAD_P(P);
    const float* mods = (const float*)(P->ws + WS_MODS) + (size_t)l * 3 * 3072;
    const float* ng = P->in[I_NG] + l * DM;
    bf16* H = (bf16*)(P->ws + WS_H);
    const int gw = blockIdx.x * 8 + wid, NGW = gridDim.x * 8;
    for (int m = gw; m < MTOK; m += NGW) {
        const float* xr = (l == 0) ? (m < MCTX ? P->in[I_XP] + (size_t)m * DM : P->in[I_XS] + (size_t)(m - MCTX) * DM) : P->out + (size_t)m * DM;
        const int cond = m < MCTX ? 0 : 1 + ((m - MCTX) >> 10);
        const float* sh = mods + cond * 3072; const float* sc = sh + 1024;
        f32x4 v[4]; float s = 0.f;
#pragma unroll
        for (int j = 0; j < 4; ++j) { v[j] = *(const f32x4*)(xr + 4 * lane + 256 * j); s += (v[j].x * v[j].x + v[j].y * v[j].y) + (v[j].z * v[j].z + v[j].w * v[j].w); }
        const float rstd = rsqrtf(wave_sum(s) * (1.f / DM) + EPS);
#pragma unroll
        for (int j = 0; j < 4; ++j) { const int c = 4 * lane + 256 * j;
            const f32x4 g4 = *(const f32x4*)(ng + c), sc4 = *(const f32x4*)(sc + c), sh4 = *(const f32x4*)(sh + c);
            const f32x4 o = v[j] * rstd * g4 * (sc4 + 1.f) + sh4;
            u32x2 w; w.x = cvt_pk_bf16(o.x, o.y); w.y = cvt_pk_bf16(o.z, o.w);
            *(u32x2*)(H + (size_t)m * DM + c) = w; }
    }
}

constexpr int KS_PITCH = 144, VT_PITCH = 528, VT_OFF = 256 * KS_PITCH;
__device__ __forceinline__ int crow(int r, int hi) { return (r & 3) + 8 * (r >> 2) + 4 * hi; }
__device__ __forceinline__ float max3f(float a, float b, float c) { float r; asm("v_max3_f32 %0, %1, %2, %3" : "=v"(r) : "v"(a), "v"(b), "v"(c)); return r; }
__device__ __forceinline__ void attn_item(KP P, int l, int it, LAS unsigned char* lds, int tid, int lane, int wid) {
    RELOAD_P(P);
    asm volatile("" : "+s"(l)); asm volatile("" : "+v"(tid)); lane = tid & 63; wid = __builtin_amdgcn_readfirstlane(tid >> 6);
    const bf16* Z = (const bf16*)(P->ws + WS_Z);
    bf16* OA = (bf16*)(P->ws + WS_ABR) + (size_t)2 * MTOK * 512;
    const f32x2* rope = (const f32x2*)(P->ws + WS_ROPE);
    const bool lat = it < 64;
    int b, kvh, qb;
    if (lat) { b = it >> 5; kvh = (it >> 4) & 1; qb = it & 15; } else { const int j = it - 64; b = j >> 3; kvh = (j >> 2) & 1; qb = j & 3; }
    const int rowbase = lat ? MCTX + b * 1024 : b * 256;
    const int nkt = lat ? 5 : 1;
    const int r32 = lane & 31, hi = lane >> 5;
    const int h = 4 * kvh + (wid & 3);
    const int tq = qb * 64 + 32 * (wid >> 2) + r32;
    const int qrow = rowbase + tq;
    bf16x8 qf[4];
    {
        float qv[4][8]; float ss = 0.f;
        const bf16* zq = Z + (size_t)qrow * NCOL + C_Q + 64 * h + 8 * hi;
#pragma unroll
        for (int d0 = 0; d0 < 4; ++d0) { const u32x4 w = *(const u32x4*)(zq + 16 * d0); unpack8(w, qv[d0]);
#pragma unroll
            for (int i = 0; i < 8; ++i) ss += qv[d0][i] * qv[d0][i]; }
        ss += __shfl_xor(ss, 32);
        const float rs = rsqrtf(ss * (1.f / 64.f) + EPS);
        const float* qg = P->in[I_QG] + l * 64 + 8 * hi;
#pragma unroll
        for (int d0 = 0; d0 < 4; ++d0)
#pragma unroll
            for (int i = 0; i < 8; ++i) qv[d0][i] *= rs * qg[16 * d0 + i];
        if (lat) {
            const int prow = tq >> 6, pcol = tq & 63;
#pragma unroll
            for (int i = 0; i < 8; ++i) { const int j = 8 * hi + i;
                const f32x2 a = rope[prow * 16 + j]; float x1 = qv[0][i], x2 = qv[1][i]; qv[0][i] = x1 * a.x - x2 * a.y; qv[1][i] = x1 * a.y + x2 * a.x;
                const f32x2 c = rope[pcol * 16 + j]; x1 = qv[2][i]; x2 = qv[3][i]; qv[2][i] = x1 * c.x - x2 * c.y; qv[3][i] = x1 * c.y + x2 * c.x; }
        }
        const float qs = 0.125f * 1.4426950408889634f;
#pragma unroll
        for (int d0 = 0; d0 < 4; ++d0) {
#pragma unroll
            for (int i = 0; i < 8; ++i) qv[d0][i] *= qs;
            qf[d0] = __builtin_bit_cast(bf16x8, pack8(qv[d0])); }
    }
    constexpr float ATT_THR = 8.f;
    float mhat = 0.f, lrun = 0.f;
    f32x16 negm;
#pragma unroll
    for (int r = 0; r < 16; ++r) negm[r] = 0.f;
    f32x16 o0, o1;
#pragma unroll
    for (int r = 0; r < 16; ++r) { o0[r] = 0.f; o1[r] = 0.f; }
    for (int kt = 0; kt < nkt; ++kt) {
        __syncthreads();
        {
            const int key = tid >> 1, half = tid & 1;
            float kx[32];
            const bool from_z = (!lat) || kt < 4;
            if (from_z) {
                const int t = kt * 256 + key;
                const bf16* src = Z + (size_t)(rowbase + t) * NCOL + C_K + 64 * kvh + 32 * half;
                float ss = 0.f;
#pragma unroll
                for (int q = 0; q < 4; ++q) { const u32x4 w = *(const u32x4*)(src + 8 * q); unpack8(w, kx + 8 * q); }
#pragma unroll
                for (int i = 0; i < 32; ++i) ss += kx[i] * kx[i];
                ss += __shfl_xor(ss, 1);
                const float rs = rsqrtf(ss * (1.f / 64.f) + EPS);
                const float* kg = P->in[I_KG] + l * 64 + 32 * half;
#pragma unroll
                for (int i = 0; i < 32; ++i) kx[i] *= rs * kg[i];
                if (!lat && qb == 0) { float* dst = P->out + O_CK + ((size_t)((b * 2 + l) * 256 + key) * 2 + kvh) * 64 + 32 * half;
#pragma unroll
                    for (int q = 0; q < 8; ++q) *(f32x4*)(dst + 4 * q) = (f32x4){kx[4 * q], kx[4 * q + 1], kx[4 * q + 2], kx[4 * q + 3]}; }
                if (lat) { const int pos = half ? (t & 63) : (t >> 6);
#pragma unroll
                    for (int j = 0; j < 16; ++j) { const f32x2 a = rope[pos * 16 + j]; const float x1 = kx[j], x2 = kx[16 + j]; kx[j] = x1 * a.x - x2 * a.y; kx[16 + j] = x1 * a.y + x2 * a.x; } }
            } else {
                const float* src = P->in[I_CK] + ((size_t)((b * 2 + l) * 256 + key) * 2 + kvh) * 64 + 32 * half;
#pragma unroll
                for (int q = 0; q < 8; ++q) { const f32x4 w = *(const f32x4*)(src + 4 * q); kx[4 * q] = w.x; kx[4 * q + 1] = w.y; kx[4 * q + 2] = w.z; kx[4 * q + 3] = w.w; }
            }
            LAS u32x4* kd = (LAS u32x4*)(lds + key * KS_PITCH + 64 * half);
#pragma unroll
            for (int q = 0; q < 4; ++q) kd[q] = pack8(kx + 8 * q);
            if (from_z) {
                const int t = kt * 256 + key;
                const bf16* src = Z + (size_t)(rowbase + t) * NCOL + C_V + 64 * kvh + 32 * half;
#pragma unroll
                for (int q = 0; q < 4; ++q) { const u32x4 w = *(const u32x4*)(src + 8 * q); unpack8(w, kx + 8 * q); }
                if (!lat && qb == 0) { float* dst = P->out + O_CV + ((size_t)((b * 2 + l) * 256 + key) * 2 + kvh) * 64 + 32 * half;
#pragma unroll
                    for (int q = 0; q < 8; ++q) *(f32x4*)(dst + 4 * q) = (f32x4){kx[4 * q], kx[4 * q + 1], kx[4 * q + 2], kx[4 * q + 3]}; }
            } else {
                const float* src = P->in[I_CV] + ((size_t)((b * 2 + l) * 256 + key) * 2 + kvh) * 64 + 32 * half;
#pragma unroll
                for (int q = 0; q < 8; ++q) { const f32x4 w = *(const f32x4*)(src + 4 * q); kx[4 * q] = w.x; kx[4 * q + 1] = w.y; kx[4 * q + 2] = w.z; kx[4 * q + 3] = w.w; }
            }
            const int pos = (key & ~15) | ((key & 4) << 1) | ((key & 8) >> 1) | (key & 3);
            LAS bf16* vd = (LAS bf16*)(lds + VT_OFF + (32 * half) * VT_PITCH + 2 * pos);
#pragma unroll
            for (int i = 0; i < 32; i += 2) { const unsigned w = cvt_pk_bf16(kx[i], kx[i + 1]);
                vd[(size_t)i * (VT_PITCH / 2)] = (bf16)(w & 0xffffu); vd[(size_t)(i + 1) * (VT_PITCH / 2)] = (bf16)(w >> 16); }
        }
        __syncthreads();
#pragma unroll 1
        for (int st = 0; st < 4; ++st) {
            f32x16 p0 = negm, p1 = negm;
            const LAS unsigned char* kb = lds + (64 * st + r32) * KS_PITCH + 16 * hi;
#pragma unroll
            for (int d0 = 0; d0 < 4; ++d0) {
                const bf16x8 a0 = *(const LAS bf16x8*)(kb + 32 * d0);
                const bf16x8 a1 = *(const LAS bf16x8*)(kb + 32 * KS_PITCH + 32 * d0);
                p0 = MFMA32(a0, qf[d0], p0); p1 = MFMA32(a1, qf[d0], p1);
            }
            asm volatile("s_nop 15\n\ts_nop 7" : "+v"(p0), "+v"(p1));
            float tm;
            { float a = max3f(p0[0], p0[1], p1[0]), b2 = max3f(p0[2], p0[3], p1[1]); a = max3f(a, p1[2], p1[3]);
#pragma unroll
              for (int r = 4; r < 16; r += 4) { a = max3f(a, p0[r], p0[r + 1]); b2 = max3f(b2, p0[r + 2], p0[r + 3]); a = max3f(a, p1[r], p1[r + 1]); b2 = max3f(b2, p1[r + 2], p1[r + 3]); }
              tm = max3f(a, b2, b2); }
            { const float other = __shfl_xor(tm, 32); tm = max3f(tm, other, other); }
            if (__any(fabsf(tm) > ATT_THR)) {
                const float dl = fabsf(tm) > ATT_THR ? tm : 0.f;
                mhat += dl;
                const float f = __builtin_amdgcn_exp2f(-dl);
#pragma unroll
                for (int r = 0; r < 16; ++r) { p0[r] -= dl; p1[r] -= dl; negm[r] = -mhat; o0[r] *= f; o1[r] *= f; }
                lrun *= f;
            }
            float ps = 0.f;
#pragma unroll
            for (int r = 0; r < 16; ++r) { p0[r] = __builtin_amdgcn_exp2f(p0[r]); p1[r] = __builtin_amdgcn_exp2f(p1[r]); ps += p0[r] + p1[r]; }
            lrun += ps;
            bf16x8 pb[4];
            { float t8[8];
#pragma unroll
              for (int J = 0; J < 4; ++J) {
#pragma unroll
                  for (int i = 0; i < 8; ++i) t8[i] = (J < 2) ? p0[8 * (J & 1) + i] : p1[8 * (J & 1) + i];
                  pb[J] = __builtin_bit_cast(bf16x8, pack8(t8)); } }
            const LAS unsigned char* vb = lds + VT_OFF + r32 * VT_PITCH + 2 * (64 * st + 8 * hi);
#pragma unroll
            for (int J = 0; J < 4; ++J) {
                const bf16x8 v0 = *(const LAS bf16x8*)(vb + 32 * J);
                const bf16x8 v1 = *(const LAS bf16x8*)(vb + 32 * VT_PITCH + 32 * J);
                o0 = MFMA32(v0, pb[J], o0); o1 = MFMA32(v1, pb[J], o1);
            }
        }
    }
    lrun += __shfl_xor(lrun, 32);
    const float inv = 1.f / lrun;
    const bf16* zg = Z + (size_t)qrow * NCOL + C_AGATE + 64 * h;
    bf16* od = OA + (size_t)qrow * 512 + 64 * h;
#pragma unroll
    for (int dt = 0; dt < 2; ++dt)
#pragma unroll
        for (int rq = 0; rq < 4; ++rq) { const int d = 32 * dt + 8 * rq + 4 * hi;
            const u32x2 gw = *(const u32x2*)(zg + d);
            float v[4];
#pragma unroll
            for (int i = 0; i < 4; ++i) v[i] = (dt ? o1[4 * rq + i] : o0[4 * rq + i]) * inv;
            v[0] *= silu_f(bf_lo(gw.x)); v[1] *= silu_f(bf_hi(gw.x)); v[2] *= silu_f(bf_lo(gw.y)); v[3] *= silu_f(bf_hi(gw.y));
            u32x2 w; w.x = cvt_pk_bf16(v[0], v[1]); w.y = cvt_pk_bf16(v[2], v[3]);
            *(u32x2*)(od + d) = w; }
}

__device__ __forceinline__ float fsigm(float x) { return __builtin_amdgcn_rcpf(1.f + __builtin_amdgcn_exp2f(-1.4426950408889634f * x)); }
__device__ __forceinline__ void conv_item(KP P, int l, int it, LAS unsigned char* lds, int tid, int lane, int wid, const float (&w)[32], const float bias, const float lgam, const float lbet) {
    RELOAD_P(P);
    asm volatile("" : "+s"(l)); asm volatile("" : "+v"(tid)); lane = tid & 63; wid = __builtin_amdgcn_readfirstlane(tid >> 6);
    const bf16* Z = (const bf16*)(P->ws + WS_Z);
    bf16* YA = (bf16*)(P->ws + WS_ABR);
    int rowbase, L, t0;
    if (it < 512) { rowbase = (it >> 4) * 256; L = 256; t0 = 16 * (it & 15); } else { const int j = it - 512; rowbase = MCTX + (j >> 6) * 1024; L = 1024; t0 = 16 * (j & 63); }
    LAS float* yb = (LAS float*)lds;
    LAS float* sb = (LAS float*)(lds + 47 * 512 * 4);
    LAS float* st = (LAS float*)(lds + 47 * 512 * 4 + 16 * 516 * 4);
    u32x4 la[6], lg[6];
#pragma unroll
    for (int i = 0; i < 6; ++i) {
        const int e = tid + 512 * i, rr = e >> 6, ch = e & 63, t = t0 - 15 + rr;
        la[i] = (u32x4){0u, 0u, 0u, 0u}; lg[i] = (u32x4){0u, 0u, 0u, 0u};
        if (rr < 47 && t >= 0 && t < L) { const bf16* src = Z + (size_t)(rowbase + t) * NCOL + 8 * ch; la[i] = *(const u32x4*)(src + C_CONVA); lg[i] = *(const u32x4*)(src + C_CONVG); }
    }
    const int c = tid;
    bf16 gt[16];
#pragma unroll
    for (int t = 0; t < 16; ++t) gt[t] = Z[(size_t)(rowbase + t0 + t) * NCOL + C_CGATE + c];
#pragma unroll
    for (int i = 0; i < 6; ++i) {
        const int e = tid + 512 * i, rr = e >> 6, ch = e & 63;
        if (rr < 47) {
            float a[8], g[8]; unpack8(la[i], a); unpack8(lg[i], g);
#pragma unroll
            for (int q = 0; q < 8; ++q) a[q] *= fsigm(g[q]);
            LAS f32x4* d = (LAS f32x4*)(yb + rr * 512 + 8 * ch);
            d[0] = (f32x4){a[0], a[1], a[2], a[3]}; d[1] = (f32x4){a[4], a[5], a[6], a[7]};
        }
    }
    __syncthreads();
    float acc[16];
#pragma unroll
    for (int t = 0; t < 16; ++t) acc[t] = bias;
#pragma unroll
    for (int kb = 0; kb < 32; kb += 8) {
        const LAS float* yp = yb + kb * 512 + c;
        float rows[23];
#pragma unroll
        for (int j = 0; j < 23; ++j) rows[j] = yp[j * 512];
#pragma unroll
        for (int t = 0; t < 16; ++t)
#pragma unroll
            for (int i = 0; i < 8; ++i) acc[t] += w[kb + i] * rows[t + i];
    }
#pragma unroll
    for (int t = 0; t < 16; ++t) sb[t * 516 + c] = acc[t];
    __syncthreads();
    {
        const int t = tid >> 5, j = tid & 31;
        const LAS f32x4* q = (const LAS f32x4*)(sb + t * 516 + 16 * j);
        float s1 = 0.f, s2 = 0.f;
#pragma unroll
        for (int i = 0; i < 4; ++i) { const f32x4 v = q[i]; s1 += (v.x + v.y) + (v.z + v.w); s2 += (v.x * v.x + v.y * v.y) + (v.z * v.z + v.w * v.w); }
#pragma unroll
        for (int o = 1; o < 32; o <<= 1) { s1 += __shfl_xor(s1, o); s2 += __shfl_xor(s2, o); }
        if (j == 0) { const float mean = s1 * (1.f / 512.f); const float var = fmaxf(s2 * (1.f / 512.f) - mean * mean, 0.f); st[2 * t] = mean; st[2 * t + 1] = rsqrtf(var + EPS); }
    }
    __syncthreads();
#pragma unroll
    for (int t = 0; t < 16; ++t) {
        const float y = (acc[t] - st[2 * t]) * st[2 * t + 1] * lgam + lbet;
        const float gate = __uint_as_float((unsigned)gt[t] << 16);
        const float o = y * gate * __builtin_amdgcn_rcpf((1.f + __builtin_amdgcn_exp2f(-1.4426950408889634f * y)) * (1.f + __builtin_amdgcn_exp2f(-1.4426950408889634f * gate)));
        YA[(size_t)(rowbase + t0 + t) * 512 + c] = (bf16)(cvt_pk_bf16(o, o) & 0xffffu);
    }
}

constexpr int HS_PITCH = 272, HS_S = 16 * HS_PITCH, HS_WAVE = 2 * HS_S;
struct SsmIdx { int lat, b, rg, go, NR; };
__device__ __forceinline__ SsmIdx ssm_decode(int it) {
    SsmIdx s;
    if (it < 512) { s.lat = 0; s.b = it >> 4; s.rg = (it >> 2) & 3; s.go = it & 3; s.NR = 4; }
    else { const int j = it - 512; s.lat = 1; s.b = j >> 6; s.rg = (j >> 2) & 15; s.go = j & 3; s.NR = 16; }
    return s;
}
#define CMUL_ADD(hr, hi_, lr, li, br, bi) do { const float _tr = __builtin_fmaf(-(li), (hi_), (br)), _ti = __builtin_fmaf((li), (hr), (bi)); const float _nr = __builtin_fmaf((lr), (hr), _tr), _ni = __builtin_fmaf((lr), (hi_), _ti); (hr) = _nr; (hi_) = _ni; } while (0)

template <int PASS>
__device__ __forceinline__ void ssm_item(KP P, int l, int it, LAS unsigned char* lds, int tid, int lane, int wid, int gsel) {
    RELOAD_P(P);
    asm volatile("" : "+s"(l)); asm volatile("" : "+v"(tid)); lane = tid & 63; wid = __builtin_amdgcn_readfirstlane(tid >> 6);
    const bf16* Z = (const bf16*)(P->ws + WS_Z);
    const SsmIdx S = ssm_decode(it);
    const int g = 8 * S.go + gsel;
    const int r32 = lane & 31, hi = lane >> 5;
    const int rb = S.lat ? MCTX + S.b * 1024 : S.b * 256;
    const int kA = (r32 & 3) + 4 * (r32 >> 3);
    const int t_start = 64 * S.rg;
    const int sr_base = S.lat ? 128 + S.b * 16 : S.b * 4;
    const bf16* zu = Z + (size_t)(rb + t_start + kA) * NCOL + C_SSMIN + 16 * g + 8 * hi;
    bf16x8 uf[4];
    if (PASS == 2) {
#pragma unroll
        for (int j = 0; j < 4; ++j) uf[j] = __builtin_bit_cast(bf16x8, *(const u32x4*)(zu + (size_t)(16 * j) * NCOL));
    }
    f32x2* E = (f32x2*)(P->ws + WS_E);
    const f32x2* LAM = (const f32x2*)(P->ws + WS_LAM);
    const bf16* BB = (const bf16*)(P->ws + WS_BB);
    const bf16* CT = (const bf16*)(P->ws + WS_CT);
    LAS unsigned char* hs = lds + wid * HS_WAVE;
    f32x4 yacc[4];
    if (PASS == 2) {
#pragma unroll
        for (int j = 0; j < 4; ++j) yacc[j] = (f32x4){0.f, 0.f, 0.f, 0.f};
    }
#pragma unroll
    for (int dir = 0; dir < 2; ++dir) {
        const int ldg = (l * 2 + dir) * 32 + g;
        bf16x8 bfr[2][2];
        f32x2 lam[2];
#pragma unroll
        for (int pt = 0; pt < 2; ++pt) {
            lam[pt] = LAM[(size_t)ldg * 64 + 32 * pt + r32];
#pragma unroll
            for (int ri = 0; ri < 2; ++ri) bfr[pt][ri] = __builtin_bit_cast(bf16x8, *(const u32x4*)(BB + ((size_t)(ldg * 2 + ri) * 64 + 32 * pt + r32) * 16 + 8 * hi));
        }
        float hr[2], hm[2];
        bf16x8 ctf[4];
        if (PASS == 1) { hr[0] = hr[1] = hm[0] = hm[1] = 0.f; }
        else {
            const int q4 = lane >> 4, cc = lane & 15;
#pragma unroll
            for (int kk = 0; kk < 4; ++kk) ctf[kk] = __builtin_bit_cast(bf16x8, *(const u32x4*)(CT + ((size_t)((l * 32 + g) * 2 + dir) * 16 + cc) * 128 + 32 * kk + 8 * q4));
#pragma unroll
            for (int pt = 0; pt < 2; ++pt) {
                float l64r = lam[pt].x, l64i = lam[pt].y;
#pragma unroll
                for (int q = 0; q < 6; ++q) { const float nr = l64r * l64r - l64i * l64i, ni = 2.f * l64r * l64i; l64r = nr; l64i = ni; }
                float cr = 0.f, ci = 0.f;
                if (S.lat) { const size_t si = ((size_t)((S.b * 2 + l) * 2 + dir) * 32 + g) * 64 + 32 * pt + r32; cr = P->in[I_SRE][si]; ci = P->in[I_SIM][si]; }
                {
                    const int n_it = dir == 0 ? S.rg : S.NR - 1 - S.rg;
                    const f32x2* Eb = E + ((size_t)(sr_base * 32 + g) * 2 + dir) * 64 + 32 * pt + r32;
                    for (int i0 = 0; i0 < n_it; i0 += 4) {
                        f32x2 e4[4];
#pragma unroll
                        for (int k = 0; k < 4; ++k) { const int i = min(i0 + k, n_it - 1); const int ri = dir == 0 ? i : S.NR - 1 - i; e4[k] = Eb[(size_t)ri * 4096]; }
#pragma unroll
                        for (int k = 0; k < 4; ++k) { const bool ok = i0 + k < n_it; const float nr = __builtin_fmaf(l64r, cr, __builtin_fmaf(-l64i, ci, e4[k].x)), ni = __builtin_fmaf(l64r, ci, __builtin_fmaf(l64i, cr, e4[k].y)); cr = ok ? nr : cr; ci = ok ? ni : ci; }
                    }
                }
                hr[pt] = cr; hm[pt] = ci;
            }
        }
#pragma unroll (PASS == 2 ? 4 : 1)
        for (int jj = 0; jj < 4; ++jj) {
            const int j = dir ? 3 - jj : jj;
            bf16x8 ufj;
            if (PASS == 2) ufj = uf[j]; else ufj = __builtin_bit_cast(bf16x8, *(const u32x4*)(zu + (size_t)(16 * j) * NCOL));
            const f32x16 zero16 = (f32x16){0.f, 0.f, 0.f, 0.f, 0.f, 0.f, 0.f, 0.f, 0.f, 0.f, 0.f, 0.f, 0.f, 0.f, 0.f, 0.f};
#pragma unroll
            for (int pt = 0; pt < 2; ++pt) {
                const f32x16 are = MFMA32(ufj, bfr[pt][0], zero16);
                const f32x16 aim = MFMA32(ufj, bfr[pt][1], zero16);
                LAS unsigned* hw = (LAS unsigned*)(hs + hi * HS_S + 4 * (32 * pt + r32));
#pragma unroll
                for (int rr = 0; rr < 16; ++rr) { const int r = dir ? 15 - rr : rr;
                    CMUL_ADD(hr[pt], hm[pt], lam[pt].x, lam[pt].y, are[r], aim[r]);
                    if (PASS == 2) hw[r * (HS_PITCH / 4)] = cvt_pk_bf16(hr[pt], hm[pt]); }
                __builtin_amdgcn_sched_barrier(0);
            }
            if (PASS == 2) {
                const int q4 = lane >> 4, n = lane & 15;
#pragma unroll
                for (int kk = 0; kk < 4; ++kk) { const bf16x8 hb = *(const LAS bf16x8*)(hs + n * HS_PITCH + 64 * kk + 16 * q4);
                    yacc[j] = MFMA16(ctf[kk], hb, yacc[j]); }
            }
        }
        if (hi == 0) {
            if (PASS == 1) {
#pragma unroll
                for (int pt = 0; pt < 2; ++pt) E[((size_t)((sr_base + S.rg) * 32 + g) * 2 + dir) * 64 + 32 * pt + r32] = (f32x2){hr[pt], hm[pt]};
            } else if (!S.lat && ((dir == 0 && S.rg == 3) || (dir == 1 && S.rg == 0))) {
#pragma unroll
                for (int pt = 0; pt < 2; ++pt) { const size_t oi = ((size_t)((S.b * 2 + l) * 2 + dir) * 32 + g) * 64 + 32 * pt + r32;
                    P->out[O_SRE + oi] = hr[pt]; P->out[O_SIM + oi] = hm[pt]; }
            }
        }
    }
    if (PASS == 2) {
        bf16* YB = (bf16*)(P->ws + WS_YB);
        const int q4 = lane >> 4, n = lane & 15;
        const f32x4 dv = *(const f32x4*)(P->in[I_SD] + l * 512 + 16 * g + 4 * q4);
#pragma unroll
        for (int j = 0; j < 4; ++j) {
            const size_t row = (size_t)(rb + t_start + 16 * j + n);
            const u32x2 uw = *(const u32x2*)(Z + row * NCOL + C_SSMIN + 16 * g + 4 * q4);
            float y[4];
            y[0] = yacc[j][0] + dv.x * bf_lo(uw.x); y[1] = yacc[j][1] + dv.y * bf_hi(uw.x); y[2] = yacc[j][2] + dv.z * bf_lo(uw.y); y[3] = yacc[j][3] + dv.w * bf_hi(uw.y);
#pragma unroll
            for (int i = 0; i < 4; ++i) { const float x = y[i]; y[i] = x * sigm(1.5957691216057308f * (x + 0.044715f * x * x * x)); }
            u32x2 w; w.x = cvt_pk_bf16(y[0], y[1]); w.y = cvt_pk_bf16(y[2], y[3]);
            *(u32x2*)(YB + row * 512 + 16 * g + 4 * q4) = w;
        }
    }
}

#ifdef DBG_NAIVE_STATE
__device__ __forceinline__ void naive_state_item(KP P, int l, int it, int tid) {
    RELOAD_P(P);
    asm volatile("" : "+s"(l)); asm volatile("" : "+v"(tid));
    const bf16* Z = (const bf16*)(P->ws + WS_Z);
    const int idx = it * 512 + tid; const int p = idx & 63, g = (idx >> 6) & 31, dir = (idx >> 11) & 1, b = idx >> 12;
    const int ti = ((l * 2 + dir) * 32 + g) * 64 + p;
    const float are = P->in[I_ARE][ti], aim = P->in[I_AIM][ti];
    const f32x2 lmb = ((const f32x2*)(P->ws + WS_LAM))[ti];
    const float lr = lmb.x, li = lmb.y;
    const float d2 = are * are + aim * aim, qr = ((lr - 1.0f) * are + li * aim) / d2, qi = (li * are - (lr - 1.0f) * aim) / d2;
    float bre[16], bim[16];
#pragma unroll
    for (int c = 0; c < 16; ++c) { const float br = P->in[I_BRE][(size_t)ti * 16 + c], bi = P->in[I_BIM][(size_t)ti * 16 + c]; bre[c] = qr * br - qi * bi; bim[c] = qr * bi + qi * br;
#ifdef DBG_BF16_B
        { const unsigned w = cvt_pk_bf16(bre[c], bim[c]); bre[c] = bf_lo(w); bim[c] = bf_hi(w); }
#endif
#ifdef DBG_USE_BB
        { const bf16* BBt = (const bf16*)(P->ws + WS_BB); const int ldg_ = (l * 2 + dir) * 32 + g;
          bre[c] = __uint_as_float((unsigned)BBt[((size_t)(ldg_ * 2 + 0) * 64 + p) * 16 + c] << 16); bim[c] = __uint_as_float((unsigned)BBt[((size_t)(ldg_ * 2 + 1) * 64 + p) * 16 + c] << 16); }
#endif
    }
    float hr = 0.f, hm = 0.f;
#pragma unroll 1
    for (int tt = 0; tt < 256; ++tt) {
        const int t = dir ? 255 - tt : tt;
        const bf16* src = Z + (size_t)(b * 256 + t) * NCOL + C_SSMIN + 16 * g;
        float u[16]; unpack8(*(const u32x4*)src, u); unpack8(*(const u32x4*)(src + 8), u + 8);
        float br = 0.f, bi = 0.f;
#pragma unroll
        for (int c = 0; c < 16; ++c) { br += bre[c] * u[c]; bi += bim[c] * u[c]; }
        CMUL_ADD(hr, hm, lr, li, br, bi);
    }
    const size_t oi = ((size_t)((b * 2 + l) * 2 + dir) * 32 + g) * 64 + p;
#if defined(DBG_SPLIT_HI) && defined(DBG_SWAP)
    if ((b & 1) == DBG_SPLIT_HI)
#elif defined(DBG_SPLIT_HI)
    if ((b & 1) != DBG_SPLIT_HI)
#endif
    { P->out[O_SRE + oi] = hr; P->out[O_SIM + oi] = hm; }
}
#endif

__device__ __forceinline__ void state_item(KP P, int l, int it, int tid, int lane, int wid) {
    RELOAD_P(P);
    asm volatile("" : "+s"(l)); asm volatile("" : "+v"(tid)); lane = tid & 63; wid = __builtin_amdgcn_readfirstlane(tid >> 6);
    const bf16* Z = (const bf16*)(P->ws + WS_Z);
    const int w = __builtin_amdgcn_readfirstlane(it * 8 + wid);
    const int g = w & 31, dir = (w >> 5) & 1, b = w >> 6;
    const int r32 = lane & 31, hi = lane >> 5;
    const int kA = (r32 & 3) + 4 * (r32 >> 3);
    const int ldg = (l * 2 + dir) * 32 + g;
    const f32x2* LAM = (const f32x2*)(P->ws + WS_LAM);
    const bf16* BB = (const bf16*)(P->ws + WS_BB);
    bf16x8 bfr[2][2]; f32x2 lam[2]; float hr[2] = {0.f, 0.f}, hm[2] = {0.f, 0.f};
#pragma unroll
    for (int pt = 0; pt < 2; ++pt) {
        lam[pt] = LAM[(size_t)ldg * 64 + 32 * pt + r32];
#pragma unroll
        for (int ri = 0; ri < 2; ++ri) bfr[pt][ri] = __builtin_bit_cast(bf16x8, *(const u32x4*)(BB + ((size_t)(ldg * 2 + ri) * 64 + 32 * pt + r32) * 16 + 8 * hi));
    }
    const bf16* zb = Z + (size_t)(b * 256 + kA) * NCOL + C_SSMIN + 16 * g + 8 * hi;
    const f32x16 z16 = (f32x16){0.f, 0.f, 0.f, 0.f, 0.f, 0.f, 0.f, 0.f, 0.f, 0.f, 0.f, 0.f, 0.f, 0.f, 0.f, 0.f};
#pragma unroll 1
    for (int q = 0; q < 16; q += 2) {
        const int j0 = dir ? 15 - q : q, j1 = dir ? 14 - q : q + 1;
        const bf16x8 u0 = __builtin_bit_cast(bf16x8, *(const u32x4*)(zb + (size_t)(16 * j0) * NCOL));
        const bf16x8 u1 = __builtin_bit_cast(bf16x8, *(const u32x4*)(zb + (size_t)(16 * j1) * NCOL));
#pragma unroll
        for (int half = 0; half < 2; ++half) {
            const bf16x8 ux = half ? u1 : u0;
#pragma unroll
            for (int pt = 0; pt < 2; ++pt) {
                const f32x16 xr = MFMA32(ux, bfr[pt][0], z16);
                const f32x16 xi = MFMA32(ux, bfr[pt][1], z16);
                if (dir == 0) {
#pragma unroll
                    for (int r = 0; r < 16; ++r) CMUL_ADD(hr[pt], hm[pt], lam[pt].x, lam[pt].y, xr[r], xi[r]);
                } else {
#pragma unroll
                    for (int r = 15; r >= 0; --r) CMUL_ADD(hr[pt], hm[pt], lam[pt].x, lam[pt].y, xr[r], xi[r]);
                }
            }
        }
    }
    if (hi == 0) {
#pragma unroll
        for (int pt = 0; pt < 2; ++pt) { const size_t oi = ((size_t)((b * 2 + l) * 2 + dir) * 32 + g) * 64 + 32 * pt + r32;
            P->out[O_SRE + oi] = hr[pt]; P->out[O_SIM + oi] = hm[pt]; }
    }
}
#define XB_TMO      128
#define XB_XCNT(j)  (256  + 64 * (j))
#define XB_XSUB(j)  (1280 + 64 * (j))
#define XB_XGEN(j)  (2304 + 64 * (j))
#define XB_TOP      3328
#define XB_TOPGEN   3392
#define XCD_BAR_WORDS 3456
#define XB_SPIN_CAP (1u << 18)

__device__ __forceinline__ unsigned xb_ld(unsigned* p)              { return __hip_atomic_load(p, __ATOMIC_RELAXED, __HIP_MEMORY_SCOPE_AGENT); }
__device__ __forceinline__ unsigned xb_add(unsigned* p, unsigned v) { return __hip_atomic_fetch_add(p, v, __ATOMIC_RELAXED, __HIP_MEMORY_SCOPE_AGENT); }
__device__ __forceinline__ unsigned xb_xcc_id() { return (unsigned)__builtin_amdgcn_s_getreg((3 << 11) | 20) & 0xFu; }
#define XB_SPIN(cond, bar) do { unsigned _sp = 0; while (cond) { __builtin_amdgcn_s_sleep(1); \
    if ((++_sp & 255u) == 0u) { if (xb_ld(&(bar)[XB_TMO])) break; if (_sp > XB_SPIN_CAP) { atomicAdd(&(bar)[XB_TMO], 1u); break; } } } } while (0)

struct XcdBarrier {
    unsigned* bar; unsigned x;
    volatile LAS unsigned* st;
};

__device__ __forceinline__ XcdBarrier xcd_barrier_post(unsigned* bar, volatile LAS unsigned* st) {
    XcdBarrier b; b.bar = bar; b.x = xb_xcc_id(); b.st = st;
    if (threadIdx.x == 0) (void)xb_add(&bar[XB_XCNT(b.x)], 1u);
    return b;
}
__device__ __forceinline__ void xcd_barrier_complete(unsigned* bar, unsigned x, unsigned& nloc, unsigned& nx) {
    const unsigned G = gridDim.x * gridDim.y * gridDim.z;
    unsigned sum, cnt, mine, sp = 0u;
    for (;;) {
        sum = 0u; cnt = 0u; mine = 0u;
#pragma unroll
        for (unsigned j = 0; j < 16; ++j) { const unsigned c = xb_ld(&bar[XB_XCNT(j)]); sum += c; cnt += (c > 0u) ? 1u : 0u; mine = (j == x) ? c : mine; }
        if (sum == G) break;
        __builtin_amdgcn_s_sleep(1);
        if ((++sp & 255u) == 0u) { if (xb_ld(&bar[XB_TMO])) break; if (sp > XB_SPIN_CAP) { atomicAdd(&bar[XB_TMO], 1u); break; } }
    }
    nloc = mine > 0u ? mine : 1u; nx = cnt > 0u ? cnt : 1u;
}

__device__ __forceinline__ void xcd_barrier(const XcdBarrier& b) {
    asm volatile("s_waitcnt vmcnt(0)" ::: "memory");
    __syncthreads();
    if (threadIdx.x == 0) {
        unsigned* bar = b.bar;
        __builtin_amdgcn_s_waitcnt(0);
        unsigned nloc = b.st[0], nx = b.st[1];
        if (nloc == 0u) { xcd_barrier_complete(bar, b.x, nloc, nx); b.st[0] = nloc; b.st[1] = nx; }
        const unsigned old = xb_add(&bar[XB_XSUB(b.x)], 1u);
        const unsigned gen = old / nloc;
        if (old + 1u == (gen + 1u) * nloc) {
            __builtin_amdgcn_fence(__ATOMIC_RELEASE, "agent");
            asm volatile("s_waitcnt vmcnt(0)" ::: "memory");
            const unsigned og = xb_add(&bar[XB_TOP], 1u);
            const unsigned tg = og / nx;
            if (og + 1u == (tg + 1u) * nx) xb_add(&bar[XB_TOPGEN], 1u);
            else XB_SPIN(xb_ld(&bar[XB_TOPGEN]) == tg, bar);
            __builtin_amdgcn_fence(__ATOMIC_ACQUIRE, "agent");
            xb_add(&bar[XB_XGEN(b.x)], 1u);
            asm volatile("s_waitcnt vmcnt(0)" ::: "memory");
        } else {
            XB_SPIN(xb_ld(&bar[XB_XGEN(b.x)]) == gen, bar);
            __builtin_amdgcn_fence(__ATOMIC_ACQUIRE, "agent");
            asm volatile("s_waitcnt vmcnt(0)" ::: "memory");
        }
    }
    __syncthreads();
}


constexpr int CW_XBAR = 32768;
#ifndef REP_SYNC
#define REP_SYNC 1
#endif
#ifndef REP_ATT
#define REP_ATT 1
#endif
#ifndef REP_SSM1
#define REP_SSM1 1
#endif
#ifndef REP_CONV
#define REP_CONV 1
#endif
#ifndef REP_P2
#define REP_P2 1
#endif
#ifndef REP_P3
#define REP_P3 1
#endif
#ifndef REP_P4
#define REP_P4 1
#endif
#ifndef REP_P56
#define REP_P56 1
#endif
__device__ __forceinline__ void grid_sync_all(cg::grid_group& grid) {
    asm volatile("s_waitcnt vmcnt(0) lgkmcnt(0)" ::: "memory");
    grid.sync();
    __builtin_amdgcn_fence(__ATOMIC_ACQUIRE, "agent");
    asm volatile("s_waitcnt vmcnt(0)" ::: "memory");
}
__device__ __forceinline__ int q_next(unsigned* ctr, LAS int* slot, int tid) {
    __syncthreads();
    if (tid == 0) *slot = (int)atomicAdd(ctr, 1u);
    __syncthreads();
    return *slot;
}

__global__ void __launch_bounds__(512, 2) fwd_kernel(Params Pk_unused) {
    KP P = (KP)__builtin_amdgcn_kernarg_segment_ptr();
    extern __shared__ __attribute__((aligned(16))) unsigned char lds_raw[];
    cg::grid_group grid = cg::this_grid();
    LAS unsigned char* lds = (LAS unsigned char*)lds_raw;
    LAS int* qslot = (LAS int*)(lds + 131072 + 1024);
    const int tid = threadIdx.x, lane = tid & 63, wid = __builtin_amdgcn_readfirstlane(tid >> 6);
    volatile LAS unsigned* xst = (volatile LAS unsigned*)(lds + 131072 + 2048);
    if (tid < 2) xst[tid] = 0u;
    __syncthreads();
    const XcdBarrier xbar = xcd_barrier_post((unsigned*)(P->ws + WS_CTL) + CW_XBAR, xst);

#ifndef REP_P0
#define REP_P0 1
#endif
    for (int r0_ = 0; r0_ < REP_P0; ++r0_) { if (r0_) __syncthreads(); p0_prologue(P, lds, tid, lane, wid); }
    for (int rs_ = 0; rs_ < REP_SYNC; ++rs_) xcd_barrier(xbar);
    if (xb_ld(&xbar.bar[XB_TMO]) != 0u) grid.sync();

#pragma unroll 1
    for (int l = 0; l < 2; ++l) {
#ifndef REP_P1
#define REP_P1 1
#endif
        for (int r1_ = 0; r1_ < REP_P1; ++r1_) p1_rows(P, l, lane, wid);
        for (int rs_ = 0; rs_ < REP_SYNC; ++rs_) xcd_barrier(xbar);
#ifndef NO_P2
#pragma unroll 1
        for (int rep_ = 0; rep_ < REP_P2; ++rep_) {
            RELOAD_P(P); unsigned char* ws = P->ws; const unsigned char* wl = ws + WS_W + (size_t)l * W_LAYER_B; bf16* Z = (bf16*)(ws + WS_Z); unsigned* ctl = (unsigned*)(ws + WS_CTL); (void)wl; (void)Z; (void)ctl;
            pg8::Gemm g{(const bf16*)(ws + WS_H), (const bf16*)wl, MTOK, NCOL, DM};
            pg8::WinOrder S{(int)gridDim.x, (int)blockIdx.x};
            pg8::EpiPlain E{Z, NCOL};
            pg8::gemm_phase<pg8::EpiPlain, pg8::WinOrder, true, true>(lds, g, S, E);
        }
#endif
        for (int rs_ = 0; rs_ < REP_SYNC; ++rs_) xcd_barrier(xbar);
#ifndef NO_P3
#pragma unroll 1
        for (int rep_ = 0; rep_ < REP_P3; ++rep_) {
            RELOAD_P(P); unsigned char* ws = P->ws; const unsigned char* wl = ws + WS_W + (size_t)l * W_LAYER_B; bf16* Z = (bf16*)(ws + WS_Z); unsigned* ctl = (unsigned*)(ws + WS_CTL); (void)wl; (void)Z; (void)ctl;
            unsigned* ctr = ctl + 64 * (1 + 2 * l) + 320 * rep_;
            unsigned pre0 = 0u; if (tid == 0) pre0 = atomicAdd(ctr, 1u);
            if (gridDim.x == 256) {
#pragma unroll 1
                for (int k = 0; k < 3; ++k) {
                    int item, gs;
                    if (k < 2) { item = (int)blockIdx.x + 256 * k; gs = wid; }
                    else { if (wid >= 4) break; item = 512 + ((int)blockIdx.x >> 1); gs = ((int)blockIdx.x & 1) * 4 + wid; }
                    ssm_item<1>(P, l, item, lds, tid, lane, wid, gs);
                }
            } else {
                for (int item = (int)blockIdx.x; item < 640; item += (int)gridDim.x) ssm_item<1>(P, l, item, lds, tid, lane, wid, wid);
            }
            int it;
            for (bool first = true;; first = false) {
                if (first) { __syncthreads(); if (tid == 0) *qslot = (int)pre0; __syncthreads(); it = *qslot; } else it = q_next(ctr, qslot, tid);
                if (it >= 376) break;
                if (it < 64 || it >= 120) {
                    const int ia = it < 64 ? it : it - 56;
                    for (int ra_ = 0; ra_ < REP_ATT; ++ra_) { if (ra_) __syncthreads(); attn_item(P, l, ia, lds, tid, lane, wid); }
                } else {
                    pg8::Gemm g{(const bf16*)(ws + WS_H), (const bf16*)wl, MTOK, NCOL, DM};
                    pg8::OneUnit S1{1024 + (it - 64)};
                    pg8::EpiPlain E{Z, NCOL};
                    pg8::gemm_phase<pg8::EpiPlain, pg8::OneUnit, true, true>(lds, g, S1, E);
                }
            }
            if (it < 1016) {
                float cw[32];
                { const float* wp = P->in[I_DWW] + (size_t)l * 31 * 512 + tid;
#pragma unroll
                  for (int k = 0; k < 31; ++k) cw[k] = wp[k * 512];
                  cw[31] = 0.f; }
                const float cbias = P->in[I_DWB][l * 512 + tid], clg = P->in[I_LNG][l * 512 + tid], clb = P->in[I_LNB][l * 512 + tid];
                do {
                    for (int ra_ = 0; ra_ < REP_CONV; ++ra_) { if (ra_) __syncthreads(); conv_item(P, l, it - 376, lds, tid, lane, wid, cw, cbias, clg, clb); }
                    it = q_next(ctr, qslot, tid);
                } while (it < 1016);
            }
        }
#endif
        for (int rs_ = 0; rs_ < REP_SYNC; ++rs_) xcd_barrier(xbar);
#ifndef NO_P4
#pragma unroll 1
        for (int rep_ = 0; rep_ < REP_P4; ++rep_) {
            RELOAD_P(P); unsigned char* ws = P->ws; const unsigned char* wl = ws + WS_W + (size_t)l * W_LAYER_B; bf16* Z = (bf16*)(ws + WS_Z); unsigned* ctl = (unsigned*)(ws + WS_CTL); (void)wl; (void)Z; (void)ctl;
            unsigned* ctr = ctl + 64 * (2 + 2 * l) + 320 * rep_;
            (void)ctr;
            if (gridDim.x == 256) {
#pragma unroll 1
                for (int k = 0; k < 3; ++k) {
                    int item, gs;
                    if (k < 2) { item = (int)blockIdx.x + 256 * k; gs = wid; }
                    else { if (wid >= 4) break; item = 512 + ((int)blockIdx.x >> 1); gs = ((int)blockIdx.x & 1) * 4 + wid; }
                    const int it2 = item < 128 ? 512 + item : item - 128;
                    ssm_item<2>(P, l, it2, lds, tid, lane, wid, gs);
                }
            } else {
                for (int item = (int)blockIdx.x; item < 640; item += (int)gridDim.x) { const int it2 = item < 128 ? 512 + item : item - 128; ssm_item<2>(P, l, it2, lds, tid, lane, wid, wid); }
            }
#ifdef DBG_NAIVE_STATE
#pragma unroll 1
            for (int it = blockIdx.x; it < 256; it += gridDim.x) naive_state_item(P, l, it, tid);
#endif
        }
#endif
        for (int rs_ = 0; rs_ < REP_SYNC; ++rs_) xcd_barrier(xbar);
#pragma unroll 1
        for (int rep_ = 0; rep_ < REP_P56; ++rep_) {
            RELOAD_P(P); unsigned char* ws = P->ws; const unsigned char* wl = ws + WS_W + (size_t)l * W_LAYER_B; bf16* Z = (bf16*)(ws + WS_Z);
            const int G = (int)gridDim.x, NB = G >= 200 ? 160 : (G * 5) / 8;
            if ((int)blockIdx.x < NB) {
                pg8::Gemm g{(const bf16*)(ws + WS_ABR), (const bf16*)(wl + W_IN_B + W_GLU_B), 3 * MTOK, 3 * 1024, 512};
                pg8::BranchOrderX S{NB, (int)blockIdx.x};
                pg8::EpiBranch E{(bf16*)(ws + WS_H), Z + C_MERGE, NCOL};
                pg8::gemm_phase<pg8::EpiBranch, pg8::BranchOrderX, true, true>(lds, g, S, E);
            } else {
                pg8::Gemm g{(const bf16*)(ws + WS_YB), (const bf16*)(wl + W_IN_B), MTOK, 1024, 512};
                pg8::GluOrder S{G - NB, (int)blockIdx.x - NB};
                pg8::EpiGlu E{(bf16*)(ws + WS_ABR) + (size_t)MTOK * 512, Z + C_SGATE, NCOL};
                pg8::gemm_phase<pg8::EpiGlu, pg8::GluOrder, true, true>(lds, g, S, E);
            }
        }
        for (int rs_ = 0; rs_ < REP_SYNC; ++rs_) xcd_barrier(xbar);
#pragma unroll 1
        for (int rep_ = 0; rep_ < 1; ++rep_) {
            RELOAD_P(P); unsigned char* ws = P->ws; const unsigned char* wl = ws + WS_W + (size_t)l * W_LAYER_B; bf16* Z = (bf16*)(ws + WS_Z);
            pg8::Gemm g{(const bf16*)(ws + WS_ABR), (const bf16*)(wl + W_IN_B + W_GLU_B), 3 * MTOK, 3 * 1024, 512};
            pg8::BranchOrderY S{(int)gridDim.x, (int)blockIdx.x};
            pg8::EpiBranch E{(bf16*)(ws + WS_H), Z + C_MERGE, NCOL};
            pg8::gemm_phase<pg8::EpiBranch, pg8::BranchOrderY, true, true>(lds, g, S, E);
            if (l == 0 && defer_l1_weights() && blockIdx.x >= 160) convert_weights(P, 1, 1, 160, lds);
        }
        for (int rs_ = 0; rs_ < REP_SYNC; ++rs_) xcd_barrier(xbar);
#ifndef REP_P7L0
#define REP_P7L0 1
#endif
#pragma unroll 1
        for (int rep7_ = 0; rep7_ < (l == 0 ? REP_P7L0 : 1); ++rep7_) {
            RELOAD_P(P); unsigned char* ws = P->ws; const unsigned char* wl = ws + WS_W + (size_t)l * W_LAYER_B; bf16* Z = (bf16*)(ws + WS_Z); unsigned* ctl = (unsigned*)(ws + WS_CTL); (void)wl; (void)Z; (void)ctl;
            pg8::Gemm g{(const bf16*)(ws + WS_H), (const bf16*)(wl + W_IN_B + W_GLU_B + W_BR_B), MTOK, 1024, 1024};
            pg8::StaticOrder S; S.init(MTOK, 1024, (int)gridDim.x, (int)blockIdx.x);
            const float* gate = (const float*)(ws + WS_MODS) + (size_t)l * 3 * 3072 + 2048;
            pg8::EpiResid E{l == 0 ? P->in[I_XP] : P->out, l == 0 ? P->in[I_XS] : P->out + (size_t)MCTX * DM, P->out, gate};
            pg8::gemm_phase<pg8::EpiResid, pg8::StaticOrder, true, true>(lds, g, S, E);
            if (l == 0 && defer_l1_weights() && blockIdx.x >= 160) convert_weights(P, 1, 0, 160, lds);
        }
        if (l == 0) for (int rs_ = 0; rs_ < REP_SYNC; ++rs_) xcd_barrier(xbar);
    }
}

extern "C" void kernel_launch(void* const* d_in, const int* in_sizes, int n_in, void* d_out, int out_size, void* d_ws, size_t ws_size, hipStream_t stream) {
    static int grid = 0;
    if (grid == 0) {
        if (n_in != 31 || ws_size < WS_END) { fprintf(stderr, "kernel_launch: unexpected n_in %d / ws_size %zu (need %zu)\n", n_in, ws_size, (size_t)WS_END); grid = -1; return; }
        int dev = 0, cus = 0, per_cu = 0;
        hipGetDevice(&dev);
        hipDeviceGetAttribute(&cus, hipDeviceAttributeMultiprocessorCount, dev);
        if (hipFuncSetAttribute((const void*)fwd_kernel, hipFuncAttributeMaxDynamicSharedMemorySize, LDS_BYTES) != hipSuccess) { fprintf(stderr, "kernel_launch: hipFuncSetAttribute failed\n"); grid = -1; return; }
        if (hipOccupancyMaxActiveBlocksPerMultiprocessor(&per_cu, (const void*)fwd_kernel, 512, LDS_BYTES) != hipSuccess || per_cu < 1) { fprintf(stderr, "kernel_launch: occupancy query says %d\n", per_cu); (void)hipGetLastError(); per_cu = 1; }
        grid = cus * 1;
    }
    if (grid < 0) return;
    (void)hipMemsetAsync((char*)d_ws + WS_CTL, 0, CTL_ZERO_BYTES, stream);
    Params p{};
    for (int i = 0; i < 31; ++i) p.in[i] = (const float*)d_in[i];
    p.out = (float*)d_out; p.ws = (unsigned char*)d_ws;
    void* args[] = {&p};
    hipError_t e = hipLaunchCooperativeKernel((const void*)fwd_kernel, dim3(grid), dim3(512), args, LDS_BYTES, stream);
    if (e != hipSuccess) fprintf(stderr, "cooperative launch failed: %s (grid %d)\n", hipGetErrorString(e), grid);
}
```

```cpp
#include <hip/hip_runtime.h>
#include <hip/hip_cooperative_groups.h>
#include <cstdio>
#include <cstdint>
#include <cmath>
namespace cg = cooperative_groups;
namespace pg8 {
#define PG8_LAS __attribute__((address_space(3)))
typedef unsigned short bf16_t;
typedef short bf16x8 __attribute__((ext_vector_type(8)));
typedef float f32x4 __attribute__((ext_vector_type(4)));
typedef unsigned u32x4 __attribute__((ext_vector_type(4)));
constexpr int BM = 256, BK = 64, HALF = 128, HTB = HALF * BK * 2  , STAGE_BYTES = 8 * HTB, NXCD = 8, WGM = 8;

__host__ __device__ __forceinline__ int lds_byte(int r, int c) { const int st = (r >> 4) * 2 + (c >> 5), rr = r & 15, cc = c & 31, ob = rr * 64 + cc * 2; return st * 1024 + (ob ^ (((ob >> 9) & 1) << 5)); }
__host__ __device__ __forceinline__ void stage_rc(int b, int& R, int& C) { const int st = b / 1024, sb = b % 1024, swz = sb ^ (((sb >> 9) & 1) << 5); R = (st >> 1) * 16 + swz / 64; C = (st & 1) * 32 + (swz % 64) / 2; }
__host__ __device__ __forceinline__ int perm32(int rho) { const int n = rho >> 4, i = rho & 15; return 8 * (i >> 2) + 4 * n + (i & 3); }

struct Unit { int pm, pn; };
struct Gemm { const bf16_t* A; const bf16_t* Bt; int M, N, K; };

struct StaticOrder {
    int nM, nN, nwg, G, c;
    __host__ __device__ void init(int M, int N, int G_, int c_) { nM = M / BM; nN = N / BM; nwg = nM * nN; G = G_; c = c_; }
    __host__ __device__ bool next(int i, Unit& u) const {
        const long L = (long)i * G + c; if (L >= nwg) return false;
        int wgid = (int)L; { const int q = nwg / NXCD, r = nwg % NXCD, xcd = wgid % NXCD, off = wgid / NXCD; wgid = (xcd < r ? xcd * (q + 1) : r * (q + 1) + (xcd - r) * q) + off; }
        const int nig = WGM * nN, gid = wgid / nig, fm = gid * WGM, gsz = (nM - fm) < WGM ? (nM - fm) : WGM;
        u.pm = fm + ((wgid % nig) % gsz); u.pn = (wgid % nig) / gsz; return true;
    }
    __device__ __forceinline__ void a_ready(const Unit&) const {}
    __device__ __forceinline__ void done(const Unit&) const {}
};

__device__ __forceinline__ unsigned cvt_pk_bf16(float lo, float hi) { unsigned r; asm volatile("v_cvt_pk_bf16_f32 %0, %1, %2" : "=v"(r) : "v"(lo), "v"(hi)); return r; }
typedef float f32x2 __attribute__((ext_vector_type(2)));
typedef unsigned u32x4e __attribute__((ext_vector_type(4)));
__device__ __forceinline__ float bf_lo(unsigned w) { return __uint_as_float(w << 16); }
__device__ __forceinline__ float bf_hi(unsigned w) { return __uint_as_float(w & 0xffff0000u); }
__device__ __forceinline__ float sigm(float x) { return __builtin_amdgcn_rcpf(1.f + __builtin_amdgcn_exp2f(-1.4426950408889634f * x)); }
__device__ __forceinline__ float silu_f(float x) { return x * __builtin_amdgcn_rcpf(1.f + __builtin_amdgcn_exp2f(-1.4426950408889634f * x)); }
__device__ __forceinline__ float glu3(float a, float b, float g) { return a * g * __builtin_amdgcn_rcpf((1.f + __builtin_amdgcn_exp2f(-1.4426950408889634f * b)) * (1.f + __builtin_amdgcn_exp2f(-1.4426950408889634f * g))); }

struct EpiPlain {
    static constexpr bool PERM = true, AFTER_DRAIN = false;
    bf16_t* O; int ldc;
    __device__ __forceinline__ void operator()(const f32x4 (&acc)[2][2][4][2], const Unit& u, int wr, int wc, int fr, int fq) const {
        const int row0 = u.pm * BM + wr * 64 + fr, col0 = u.pn * BM + wc * 32 + 8 * fq;
#pragma unroll
        for (int ai = 0; ai < 2; ++ai)
#pragma unroll
            for (int m = 0; m < 4; ++m) { bf16_t* rowp = O + (size_t)(row0 + ai * HALF + m * 16) * ldc + col0;
#pragma unroll
                for (int bj = 0; bj < 2; ++bj) { const f32x4 v0 = acc[ai][bj][m][0], v1 = acc[ai][bj][m][1];
                    u32x4e w; w.x = cvt_pk_bf16(v0[0], v0[1]); w.y = cvt_pk_bf16(v0[2], v0[3]); w.z = cvt_pk_bf16(v1[0], v1[1]); w.w = cvt_pk_bf16(v1[2], v1[3]);
                    *(u32x4e*)(rowp + bj * HALF) = w; } }
    }
};
struct EpiGlu {
    static constexpr bool PERM = true, AFTER_DRAIN = false;
    bf16_t* O; const bf16_t* Zg; int ldz;
    __device__ __forceinline__ void operator()(const f32x4 (&acc)[2][2][4][2], const Unit& u, int wr, int wc, int fr, int fq) const {
        const int row0 = u.pm * BM + wr * 64 + fr, oc0 = u.pn * 128 + wc * 32 + 8 * fq;
#pragma unroll
        for (int ai = 0; ai < 2; ++ai)
#pragma unroll
            for (int m = 0; m < 4; ++m) { const int r = row0 + ai * HALF + m * 16;
                const u32x4e gz = *(const u32x4e*)(Zg + (size_t)r * ldz + oc0);
                const f32x4 a0 = acc[ai][0][m][0], a1 = acc[ai][0][m][1], b0 = acc[ai][1][m][0], b1 = acc[ai][1][m][1];
                float o[8];
                o[0] = glu3(a0[0], b0[0], bf_lo(gz.x)); o[1] = glu3(a0[1], b0[1], bf_hi(gz.x));
                o[2] = glu3(a0[2], b0[2], bf_lo(gz.y)); o[3] = glu3(a0[3], b0[3], bf_hi(gz.y));
                o[4] = glu3(a1[0], b1[0], bf_lo(gz.z)); o[5] = glu3(a1[1], b1[1], bf_hi(gz.z));
                o[6] = glu3(a1[2], b1[2], bf_lo(gz.w)); o[7] = glu3(a1[3], b1[3], bf_hi(gz.w));
                u32x4e w; w.x = cvt_pk_bf16(o[0], o[1]); w.y = cvt_pk_bf16(o[2], o[3]); w.z = cvt_pk_bf16(o[4], o[5]); w.w = cvt_pk_bf16(o[6], o[7]);
                *(u32x4e*)(O + (size_t)r * 512 + oc0) = w; }
    }
};
struct EpiBranch {
    static constexpr bool PERM = true, AFTER_DRAIN = false;
    bf16_t* MIX; const bf16_t* Zm; int ldz;
    __device__ __forceinline__ void operator()(const f32x4 (&acc)[2][2][4][2], const Unit& u, int wr, int wc, int fr, int fq) const {
        const int br = u.pn >> 2, pn = u.pn & 3, pm = u.pm - 40 * br;
        const int row0 = pm * BM + wr * 64 + fr, col0 = pn * BM + wc * 32 + 8 * fq;
#pragma unroll
        for (int ai = 0; ai < 2; ++ai)
#pragma unroll
            for (int m = 0; m < 4; ++m) { const int r = row0 + ai * HALF + m * 16;
#pragma unroll
                for (int bj = 0; bj < 2; ++bj) { const int c = col0 + bj * HALF;
                    const u32x4e gz = *(const u32x4e*)(Zm + (size_t)r * ldz + br * 1024 + c);
                    u32x4e pv = (u32x4e){0u, 0u, 0u, 0u};
                    if (br > 0) pv = *(const u32x4e*)(MIX + (size_t)r * 1024 + c);
                    const f32x4 v0 = acc[ai][bj][m][0], v1 = acc[ai][bj][m][1];
                    float o[8];
                    o[0] = v0[0] * sigm(bf_lo(gz.x)) + bf_lo(pv.x); o[1] = v0[1] * sigm(bf_hi(gz.x)) + bf_hi(pv.x);
                    o[2] = v0[2] * sigm(bf_lo(gz.y)) + bf_lo(pv.y); o[3] = v0[3] * sigm(bf_hi(gz.y)) + bf_hi(pv.y);
                    o[4] = v1[0] * sigm(bf_lo(gz.z)) + bf_lo(pv.z); o[5] = v1[1] * sigm(bf_hi(gz.z)) + bf_hi(pv.z);
                    o[6] = v1[2] * sigm(bf_lo(gz.w)) + bf_lo(pv.w); o[7] = v1[3] * sigm(bf_hi(gz.w)) + bf_hi(pv.w);
                    u32x4e w; w.x = cvt_pk_bf16(o[0], o[1]); w.y = cvt_pk_bf16(o[2], o[3]); w.z = cvt_pk_bf16(o[4], o[5]); w.w = cvt_pk_bf16(o[6], o[7]);
                    *(u32x4e*)(MIX + (size_t)r * 1024 + c) = w; } }
    }
};
struct WinOrder {
    int G, c;
    __device__ __forceinline__ static void unit_of(int W, Unit& u) { const int gid = W / 216, rr = W % 216; u.pm = gid * 8 + (rr & 7); u.pn = rr >> 3; }
    __device__ __forceinline__ bool next(int i, Unit& u) const {
        const int L = i * G + c; if (L >= 1024) return false;
        unit_of((L & 7) * 128 + (L >> 3), u); return true;
    }
    __device__ __forceinline__ void a_ready(const Unit&) const {}
    __device__ __forceinline__ void done(const Unit&) const {}
};
struct OneUnit {
    int W;
    __device__ __forceinline__ bool next(int i, Unit& u) const { if (i > 0) return false; WinOrder::unit_of(W, u); return true; }
    __device__ __forceinline__ void a_ready(const Unit&) const {}
    __device__ __forceinline__ void done(const Unit&) const {}
};
struct BranchOrderX {
    int NB, c;
    __device__ __forceinline__ bool next(int i, Unit& u) const {
        const int tI = (i >> 1) * NB + c, br = (i & 1) * 2; if (tI >= 160) return false;
        u.pm = br * 40 + (tI >> 2); u.pn = br * 4 + (tI & 3); return true;
    }
    __device__ __forceinline__ void a_ready(const Unit&) const {}
    __device__ __forceinline__ void done(const Unit&) const {}
};
struct GluOrder {
    int NG, c;
    __device__ __forceinline__ bool next(int i, Unit& u) const {
        const int tI = i * NG + c; if (tI >= 160) return false;
        u.pm = tI >> 2; u.pn = tI & 3; return true;
    }
    __device__ __forceinline__ void a_ready(const Unit&) const {}
    __device__ __forceinline__ void done(const Unit&) const {}
};
struct BranchOrderY {
    int G, c;
    __device__ __forceinline__ bool next(int i, Unit& u) const {
        const int tI = i * G + c; if (tI >= 160) return false;
        u.pm = 40 + (tI >> 2); u.pn = 4 + (tI & 3); return true;
    }
    __device__ __forceinline__ void a_ready(const Unit&) const {}
    __device__ __forceinline__ void done(const Unit&) const {}
};
struct BranchOrder {
    int G, c;
    __device__ __forceinline__ bool next(int i, Unit& u) const {
        const int tI = (i / 3) * G + c, br = i % 3; if (tI >= 160) return false;
        u.pm = br * 40 + (tI >> 2); u.pn = br * 4 + (tI & 3); return true;
    }
    __device__ __forceinline__ void a_ready(const Unit&) const {}
    __device__ __forceinline__ void done(const Unit&) const {}
};
struct EpiResid {
    static constexpr bool PERM = false, AFTER_DRAIN = false;
    const float* base_ctx; const float* base_lat; float* out; const float* gate;
    __device__ __forceinline__ void operator()(const f32x4 (&acc)[2][2][4][2], const Unit& u, int wr, int wc, int fr, int fq) const {
        const int row0 = u.pm * BM + wr * 64 + fr, col0 = u.pn * BM + wc * 32 + 4 * fq;
        const int cond = u.pm < 32 ? 0 : 1 + ((u.pm - 32) >> 2);
        const float* bp = u.pm < 32 ? base_ctx : base_lat - (size_t)8192 * 1024;
        f32x4 gv[2][2];
#pragma unroll
        for (int bj = 0; bj < 2; ++bj)
#pragma unroll
            for (int n = 0; n < 2; ++n) gv[bj][n] = *(const f32x4*)(gate + cond * 3072 + col0 + bj * HALF + n * 16);
#pragma unroll
        for (int ai = 0; ai < 2; ++ai)
#pragma unroll
            for (int m = 0; m < 4; ++m) { const size_t off = (size_t)(row0 + ai * HALF + m * 16) * 1024 + col0;
#pragma unroll
                for (int bj = 0; bj < 2; ++bj)
#pragma unroll
                    for (int n = 0; n < 2; ++n) { const f32x4 bs = *(const f32x4*)(bp + off + bj * HALF + n * 16);
                        *(f32x4*)(out + off + bj * HALF + n * 16) = bs + gv[bj][n] * acc[ai][bj][m][n]; } }
    }
};
template <class Epi, class Sched, bool ALIGN_EPI = false, bool SP2 = false>
__device__ __forceinline__ void gemm_phase(PG8_LAS unsigned char* lds, const Gemm g, const Sched& S, const Epi& E) {
    int tid_l = threadIdx.x; asm volatile("" : "+v"(tid_l));
    const int tid = tid_l, wid = __builtin_amdgcn_readfirstlane(tid >> 6), lane = tid & 63, wr = wid >> 2, wc = wid & 3, fr = lane & 15, fq = lane >> 4;
    const int K = g.K, nt = K / BK;
    unsigned voffA[2], voffB[2];
#pragma unroll
    for (int i = 0; i < 2; ++i) { int R, C; stage_rc(tid * 16 + i * 8192, R, C); const int Rb = Epi::PERM ? ((R & ~31) + perm32(R & 31)) : R;
        voffA[i] = (unsigned)(R * K + C) * 2u; voffB[i] = (unsigned)(Rb * K + C) * 2u; }
    const size_t kstep = (size_t)(BK * 2);
    const size_t hstep = (size_t)HALF * K * 2;
    const size_t tstep = 2 * hstep;
    const unsigned ldsw = (unsigned)wid * 1024u;
    const int aoff = lds_byte(wr * 64 + fr, fq * 8), boff = lds_byte(wc * 32 + fr, fq * 8);
#define PG8_SA(b, h) (((b) * 2 + (h)) * HTB)
#define PG8_SB(b, h) ((4 + (b) * 2 + (h)) * HTB)
#define PG8_STAGE(bufoff, gbase, voff) do { _Pragma("unroll") for (int _i = 0; _i < 2; ++_i) \
        __builtin_amdgcn_global_load_lds((const unsigned*)((const char*)(gbase) + (voff)[_i]), (PG8_LAS unsigned*)(lds + (bufoff) + ldsw + _i * 8192), 16, 0, 0); } while (0)
#define PG8_LDA(dst, b, h) do { _Pragma("unroll") for (int m = 0; m < 4; ++m) _Pragma("unroll") for (int k = 0; k < 2; ++k) dst[m][k] = *(const PG8_LAS bf16x8*)(lds + PG8_SA(b, h) + aoff + m * 2048 + k * 1024); } while (0)
#define PG8_LDB(dst, b, h) do { _Pragma("unroll") for (int n = 0; n < 2; ++n) _Pragma("unroll") for (int k = 0; k < 2; ++k) dst[n][k] = *(const PG8_LAS bf16x8*)(lds + PG8_SB(b, h) + boff + n * 2048 + k * 1024); } while (0)
#define PG8_MMA(ai, bj, At, Bt) do { __builtin_amdgcn_s_setprio(1); _Pragma("unroll") for (int m = 0; m < 4; ++m) _Pragma("unroll") for (int n = 0; n < 2; ++n) _Pragma("unroll") for (int k = 0; k < 2; ++k) \
        acc[ai][bj][m][n] = __builtin_amdgcn_mfma_f32_16x16x32_bf16(Bt[n][k], At[m][k], acc[ai][bj][m][n], 0, 0, 0); __builtin_amdgcn_s_setprio(0); } while (0)
#define PG8_WAIT_V(n) asm volatile("s_waitcnt vmcnt(" #n ")" ::: "memory")
#define PG8_WAIT_L(n) asm volatile("s_waitcnt lgkmcnt(" #n ")" ::: "memory")
#define PG8_BAR __builtin_amdgcn_s_barrier()
#define PG8_SCHED __builtin_amdgcn_sched_barrier(0)
    Unit cur, nxt; int ui = 0;
    if (!S.next(0, cur)) return;
    f32x4 acc[2][2][4][2];
#pragma unroll
    for (int a = 0; a < 2; ++a)
#pragma unroll
        for (int b = 0; b < 2; ++b)
#pragma unroll
            for (int m = 0; m < 4; ++m)
#pragma unroll
                for (int n = 0; n < 2; ++n) acc[a][b][m][n] = (f32x4){0.f, 0.f, 0.f, 0.f};
    bf16x8 At[4][2], B0[2][2], B1[2][2];
    const char* cA = (const char*)g.A + (size_t)cur.pm * tstep; const char* cB = (const char*)g.Bt + (size_t)cur.pn * tstep;
    S.a_ready(cur);
    if constexpr (SP2) {
        PG8_STAGE(PG8_SB(0, 0), cB, voffB); PG8_STAGE(PG8_SB(0, 1), cB + hstep, voffB); PG8_STAGE(PG8_SA(0, 0), cA, voffA); PG8_STAGE(PG8_SA(0, 1), cA + hstep, voffA);
        if (wr == 1) PG8_BAR;
        PG8_WAIT_V(2); PG8_BAR;
        PG8_STAGE(PG8_SB(1, 0), cB + kstep, voffB); PG8_STAGE(PG8_SA(1, 0), cA + kstep, voffA); PG8_STAGE(PG8_SB(1, 1), cB + hstep + kstep, voffB);
        PG8_WAIT_V(6); PG8_BAR;
    } else {
        PG8_STAGE(PG8_SB(0, 0), cB, voffB); PG8_STAGE(PG8_SA(0, 0), cA, voffA); PG8_STAGE(PG8_SB(0, 1), cB + hstep, voffB); PG8_STAGE(PG8_SA(0, 1), cA + hstep, voffA);
        if (wr == 1) PG8_BAR;
        PG8_WAIT_V(4); PG8_BAR;
        PG8_STAGE(PG8_SB(1, 0), cB + kstep, voffB); PG8_STAGE(PG8_SA(1, 0), cA + kstep, voffA); PG8_STAGE(PG8_SB(1, 1), cB + hstep + kstep, voffB);
        PG8_WAIT_V(6); PG8_BAR;
    }
    for (;;) {
        const bool has_next = S.next(ui + 1, nxt);
        const char* nA = has_next ? (const char*)g.A + (size_t)nxt.pm * tstep : cA; const char* nB = has_next ? (const char*)g.Bt + (size_t)nxt.pn * tstep : cB;
        for (int t = 0; t < nt; t += 2) {
            const bool last = (t == nt - 2);
            const char* a1 = cA + (size_t)(t + 1) * kstep;
            const char* a2 = last ? nA : cA + (size_t)(t + 2) * kstep; const char* b2 = last ? nB : cB + (size_t)(t + 2) * kstep;
            const char* a3 = a2 + kstep; const char* b3 = b2 + kstep;
            if (last && has_next) S.a_ready(nxt);
            if constexpr (SP2) {
            PG8_LDB(B0, 0, 0); PG8_LDB(B1, 0, 1); PG8_SCHED; PG8_LDA(At, 0, 0); PG8_STAGE(PG8_SA(1, 1), a1 + hstep, voffA);
            PG8_WAIT_V(8); PG8_WAIT_L(0); PG8_BAR; PG8_MMA(0, 0, At, B0); PG8_MMA(0, 1, At, B1); PG8_BAR; PG8_SCHED;
            PG8_LDA(At, 0, 1); PG8_STAGE(PG8_SB(0, 0), b2, voffB); PG8_STAGE(PG8_SB(0, 1), b2 + hstep, voffB); PG8_STAGE(PG8_SA(0, 0), a2, voffA);
            PG8_WAIT_V(8); PG8_WAIT_L(0); PG8_BAR; PG8_MMA(1, 0, At, B0); PG8_MMA(1, 1, At, B1); PG8_BAR; PG8_SCHED;
            PG8_LDB(B0, 1, 0); PG8_LDB(B1, 1, 1); PG8_SCHED; PG8_LDA(At, 1, 0); PG8_STAGE(PG8_SA(0, 1), a2 + hstep, voffA);
            PG8_WAIT_V(8); PG8_WAIT_L(0); PG8_BAR; PG8_MMA(0, 0, At, B0); PG8_MMA(0, 1, At, B1); PG8_BAR; PG8_SCHED;
            PG8_LDA(At, 1, 1); PG8_STAGE(PG8_SB(1, 0), b3, voffB); PG8_STAGE(PG8_SB(1, 1), b3 + hstep, voffB); PG8_STAGE(PG8_SA(1, 0), a3, voffA);
            PG8_WAIT_V(8); PG8_WAIT_L(0); PG8_BAR; PG8_MMA(1, 0, At, B0); PG8_MMA(1, 1, At, B1); PG8_BAR; PG8_SCHED;
            } else {
            PG8_LDB(B0, 0, 0); PG8_SCHED; PG8_LDA(At, 0, 0); PG8_STAGE(PG8_SA(1, 1), a1 + hstep, voffA);
            PG8_WAIT_L(8); PG8_BAR; PG8_WAIT_L(0); PG8_MMA(0, 0, At, B0); PG8_BAR; PG8_SCHED;
            PG8_LDB(B1, 0, 1); PG8_STAGE(PG8_SB(0, 0), b2, voffB);
            PG8_BAR; PG8_WAIT_L(0); PG8_MMA(0, 1, At, B1); PG8_BAR;
            PG8_LDA(At, 0, 1); PG8_STAGE(PG8_SA(0, 0), a2, voffA);
            PG8_BAR; PG8_WAIT_L(0); PG8_MMA(1, 0, At, B0); PG8_BAR; PG8_SCHED;
            PG8_STAGE(PG8_SB(0, 1), b2 + hstep, voffB);
            PG8_WAIT_V(6); PG8_BAR; PG8_MMA(1, 1, At, B1); PG8_BAR;
            PG8_LDB(B0, 1, 0); PG8_SCHED; PG8_LDA(At, 1, 0); PG8_STAGE(PG8_SA(0, 1), a2 + hstep, voffA);
            PG8_WAIT_L(8); PG8_BAR; PG8_WAIT_L(0); PG8_MMA(0, 0, At, B0); PG8_BAR; PG8_SCHED;
            PG8_LDB(B1, 1, 1); PG8_STAGE(PG8_SB(1, 0), b3, voffB);
            PG8_BAR; PG8_WAIT_L(0); PG8_MMA(0, 1, At, B1); PG8_BAR;
            PG8_LDA(At, 1, 1); PG8_STAGE(PG8_SA(1, 0), a3, voffA);
            PG8_BAR; PG8_WAIT_L(0); PG8_MMA(1, 0, At, B0); PG8_BAR; PG8_SCHED;
            PG8_STAGE(PG8_SB(1, 1), b3 + hstep, voffB);
            PG8_WAIT_V(6); PG8_BAR; PG8_MMA(1, 1, At, B1); PG8_BAR;
            }
        }
        if constexpr (ALIGN_EPI) { if (wr == 0) PG8_BAR; }
        if constexpr (!Epi::AFTER_DRAIN) { E(acc, cur, wr, wc, fr, fq); S.done(cur); }
        if (!has_next) break;
#pragma unroll
        for (int a = 0; a < 2; ++a)
#pragma unroll
            for (int b = 0; b < 2; ++b)
#pragma unroll
                for (int m = 0; m < 4; ++m)
#pragma unroll
                    for (int n = 0; n < 2; ++n) acc[a][b][m][n] = (f32x4){0.f, 0.f, 0.f, 0.f};
        cur = nxt; cA = nA; cB = nB; ++ui;
        if constexpr (ALIGN_EPI) { if (wr == 1) PG8_BAR; }
    }
    PG8_WAIT_V(0);
    if constexpr (!ALIGN_EPI) { if (wr == 0) PG8_BAR; }
    PG8_BAR;
    if constexpr (Epi::AFTER_DRAIN) { E.fused(acc, cur, wr, wc, fr, fq, lds, wid, lane); S.done(cur); }
#undef PG8_SA
#undef PG8_SB
#undef PG8_STAGE
#undef PG8_LDA
#undef PG8_LDB
#undef PG8_MMA
#undef PG8_WAIT_V
#undef PG8_WAIT_L
#undef PG8_BAR
#undef PG8_SCHED
}
}

#define LAS __attribute__((address_space(3)))
typedef unsigned short bf16;
typedef unsigned u32x4 __attribute__((ext_vector_type(4)));
typedef unsigned u32x2 __attribute__((ext_vector_type(2)));
typedef float f32x4 __attribute__((ext_vector_type(4)));
typedef float f32x2 __attribute__((ext_vector_type(2)));
typedef float f32x16 __attribute__((ext_vector_type(16)));
typedef short bf16x8 __attribute__((ext_vector_type(8)));
using pg8::cvt_pk_bf16; using pg8::bf_lo; using pg8::bf_hi; using pg8::sigm; using pg8::silu_f;

constexpr int DM = 1024, NCOL = 6912, MTOK = 10240, MCTX = 8192;
constexpr int C_CONVA = 0, C_CONVG = 512, C_CGATE = 1024, C_SSMIN = 1536, C_SGATE = 2048, C_Q = 2560, C_K = 3072, C_V = 3200, C_AGATE = 3328, C_MERGE = 3840;
constexpr float EPS = 1e-6f;
constexpr size_t MiB = (size_t)1 << 20;
constexpr size_t WS_CTL = 0, CTL_ZERO_BYTES = 256 * 1024;
constexpr size_t WS_MODS = 4096;
constexpr size_t WS_ROPE = 1 * MiB;
constexpr size_t WS_LAM = 1 * MiB + 64 * 1024;
constexpr size_t WS_BB = 2 * MiB;
constexpr size_t WS_CT = 3 * MiB;
constexpr size_t WS_E = 4 * MiB;
constexpr size_t WS_W = 10 * MiB;
constexpr size_t W_IN_B = (size_t)NCOL * DM * 2, W_GLU_B = (size_t)1024 * 512 * 2, W_BR_B = (size_t)3 * 1024 * 512 * 2, W_OUT_B = (size_t)1024 * 1024 * 2;
constexpr size_t W_LAYER_B = W_IN_B + W_GLU_B + W_BR_B + W_OUT_B;
constexpr size_t WS_H = 50 * MiB;
constexpr size_t WS_ABR = 70 * MiB;
constexpr size_t WS_YB = 100 * MiB;
constexpr size_t WS_MODSP = WS_YB;
constexpr size_t WS_Z = 110 * MiB;
constexpr size_t WS_END = WS_Z + (size_t)MTOK * NCOL * 2;
static_assert(WS_W + 2 * W_LAYER_B <= WS_H && WS_END <= 256 * MiB, "ws map");
constexpr int LDS_BYTES = 147456;

struct Params { const float* in[31]; float* out; unsigned char* ws; };
typedef const __attribute__((address_space(4))) Params* KP;
#define RELOAD_P(P) asm volatile("" : "+s"(P))
enum { I_XP = 0, I_XS, I_CK, I_CV, I_SRE, I_SIM, I_C, I_CCTX, I_NG, I_WADA, I_BADA, I_WIN, I_DWW, I_DWB, I_LNG, I_LNB, I_WCO, I_ARE, I_AIM, I_LDT, I_BRE, I_BIM, I_CRE, I_CIM, I_SD, I_WGLU, I_WSO, I_QG, I_KG, I_WAO, I_WOUT };
constexpr size_t O_Y = 0, O_CK = 10485760, O_CV = 12582912, O_SRE = 14680064, O_SIM = 14942208;

__device__ __forceinline__ float wave_sum(float v) {
#pragma unroll
    for (int o = 1; o < 64; o <<= 1) v += __shfl_xor(v, o);
    return v;
}
__device__ __forceinline__ void unpack8(const u32x4 w, float* f) {
    f[0] = bf_lo(w.x); f[1] = bf_hi(w.x); f[2] = bf_lo(w.y); f[3] = bf_hi(w.y); f[4] = bf_lo(w.z); f[5] = bf_hi(w.z); f[6] = bf_lo(w.w); f[7] = bf_hi(w.w);
}
__device__ __forceinline__ u32x4 pack8(const float* f) {
    u32x4 w; w.x = cvt_pk_bf16(f[0], f[1]); w.y = cvt_pk_bf16(f[2], f[3]); w.z = cvt_pk_bf16(f[4], f[5]); w.w = cvt_pk_bf16(f[6], f[7]); return w;
}
#define MFMA32(a, b, c) __builtin_amdgcn_mfma_f32_32x32x16_bf16((a), (b), (c), 0, 0, 0)
#define MFMA16(a, b, c) __builtin_amdgcn_mfma_f32_16x16x32_bf16((a), (b), (c), 0, 0, 0)

__device__ __forceinline__ void p0_transpose_item(const float* W, int K, int N, bf16* WT, int glu, LAS float* scr, int item, int lane) {
    const int nblk = N / 32, kb = item / nblk, nb = item % nblk, k0 = 64 * kb, n0 = 32 * nb;
    int d0 = n0;
    if (glu) { const int bj = n0 >> 9, rem = n0 & 511; d0 = 256 * (rem >> 7) + 128 * bj + (rem & 127); }
    float wv[32];
    const float* wsrc = W + (size_t)(k0 + (lane >> 5)) * N + n0 + (lane & 31);
#pragma unroll
    for (int i = 0; i < 32; ++i) wv[i] = wsrc[(size_t)(2 * i) * N];
#pragma unroll
    for (int i = 0; i < 32; ++i) scr[(2 * i + (lane >> 5)) * 33 + (lane & 31)] = wv[i];
    asm volatile("s_waitcnt lgkmcnt(0)" ::: "memory");
    const int c = lane & 7;
#pragma unroll
    for (int j = 0; j < 4; ++j) { const int n = (lane >> 3) + 8 * j; const LAS float* s = scr + (8 * c) * 33 + n;
        u32x4 o; o.x = cvt_pk_bf16(s[0 * 33], s[1 * 33]); o.y = cvt_pk_bf16(s[2 * 33], s[3 * 33]); o.z = cvt_pk_bf16(s[4 * 33], s[5 * 33]); o.w = cvt_pk_bf16(s[6 * 33], s[7 * 33]);
        *(u32x4*)(WT + (size_t)(d0 + n) * K + k0 + 8 * c) = o; }
    asm volatile("s_waitcnt lgkmcnt(0)" ::: "memory");
}

#ifndef REP_P0A
#define REP_P0A 1
#endif
__device__ __forceinline__ void convert_weights(KP P, int l, int part, int first_block, LAS unsigned char* lds) {
    RELOAD_P(P);
    asm volatile("" : "+s"(l));
    int tid_ = threadIdx.x; asm volatile("" : "+v"(tid_));
    const int lane = tid_ & 63, wid = __builtin_amdgcn_readfirstlane(tid_ >> 6);
    const int gw = ((int)blockIdx.x - first_block) * 8 + wid, NGW = ((int)gridDim.x - first_block) * 8;
    LAS float* scr = (LAS float*)(lds + wid * 8448);
    constexpr int I_IN = 16 * 216, I_S = 8 * 32, I_O = 16 * 32;
    unsigned char* wl = P->ws + WS_W + (size_t)l * W_LAYER_B;
    if (part == 0) {
        for (int r = gw; r < I_IN; r += NGW) p0_transpose_item(P->in[I_WIN] + (size_t)l * DM * NCOL, DM, NCOL, (bf16*)wl, 0, scr, r, lane);
    } else {
        for (int it = gw; it < 4 * I_S + I_O; it += NGW) {
            int r = it;
            if (r < I_S) { p0_transpose_item(P->in[I_WGLU] + (size_t)l * 512 * 1024, 512, 1024, (bf16*)(wl + W_IN_B), 1, scr, r, lane); continue; } r -= I_S;
            if (r < I_S) { p0_transpose_item(P->in[I_WCO] + (size_t)l * 512 * 1024, 512, 1024, (bf16*)(wl + W_IN_B + W_GLU_B), 0, scr, r, lane); continue; } r -= I_S;
            if (r < I_S) { p0_transpose_item(P->in[I_WSO] + (size_t)l * 512 * 1024, 512, 1024, (bf16*)(wl + W_IN_B + W_GLU_B) + (size_t)1024 * 512, 0, scr, r, lane); continue; } r -= I_S;
            if (r < I_S) { p0_transpose_item(P->in[I_WAO] + (size_t)l * 512 * 1024, 512, 1024, (bf16*)(wl + W_IN_B + W_GLU_B) + (size_t)2048 * 512, 0, scr, r, lane); continue; } r -= I_S;
            p0_transpose_item(P->in[I_WOUT] + (size_t)l * 1024 * 1024, 1024, 1024, (bf16*)(wl + W_IN_B + W_GLU_B + W_BR_B), 0, scr, r, lane);
        }
    }
}
__device__ __forceinline__ bool defer_l1_weights() { return gridDim.x >= 200; }

__device__ __forceinline__ void p0_prologue(KP P, LAS unsigned char* lds, int tid, int lane, int wid) {
    RELOAD_P(P);
    unsigned char* ws = P->ws;
    {
        const int nl = defer_l1_weights() ? 1 : 2;
#pragma unroll 1
        for (int rep0_ = 0; rep0_ < REP_P0A; ++rep0_)
#pragma unroll 1
        for (int lp = 0; lp < 2 * nl; ++lp) convert_weights(P, lp >> 1, lp & 1, 0, lds);
    }
    __syncthreads();
    for (int it = blockIdx.x; it < 209; it += gridDim.x) {
        if (it < 192) {
            const int l = it / 96, n0 = 32 * (it % 96);
            LAS float* sc = (LAS float*)lds;
            LAS float* red = (LAS float*)(lds + 12288);
            __syncthreads();
            for (int i = tid; i < 3072; i += 512) { const int j = i >> 10, k = i & 1023; const float cv = (j == 0) ? P->in[I_CCTX][k] : P->in[I_C][(j - 1) * 1024 + k]; sc[i] = cv / (1.f + __expf(-cv)); }
            __syncthreads();
            const int ks = tid >> 5, col = tid & 31;
            const float* w = P->in[I_WADA] + ((size_t)l * 1024 + ks * 64) * 3072 + n0 + col;
            float a0 = 0.f, a1 = 0.f, a2 = 0.f;
#pragma unroll 16
            for (int k = 0; k < 64; ++k) { const float wv = w[(size_t)k * 3072]; a0 += sc[ks * 64 + k] * wv; a1 += sc[1024 + ks * 64 + k] * wv; a2 += sc[2048 + ks * 64 + k] * wv; }
            red[(ks * 3 + 0) * 32 + col] = a0; red[(ks * 3 + 1) * 32 + col] = a1; red[(ks * 3 + 2) * 32 + col] = a2;
            __syncthreads();
            if (tid < 96) { const int j = tid >> 5, c2 = tid & 31; float sum = P->in[I_BADA][l * 3072 + n0 + c2];
#pragma unroll
                for (int q = 0; q < 16; ++q) sum += red[(q * 3 + j) * 32 + c2];
                ((float*)(ws + WS_MODS))[(l * 3 + j) * 3072 + n0 + c2] = sum; }
        } else if (it < 208) {
            const int idx = (it - 192) * 512 + tid; const int l = idx >> 12, dir = (idx >> 11) & 1, g = (idx >> 6) & 31, p = idx & 63;
            const double are = (double)P->in[I_ARE][idx], aim = (double)P->in[I_AIM][idx], dt = exp((double)P->in[I_LDT][(l * 2 + dir) * 32 + g]);
            const double mag = exp(are * dt), lr = mag * cos(aim * dt), li = mag * sin(aim * dt);
            ((f32x2*)(ws + WS_LAM))[idx] = (f32x2){(float)lr, (float)li};
            const double d2 = are * are + aim * aim, qr = ((lr - 1.0) * are + li * aim) / d2, qi = (li * are - (lr - 1.0) * aim) / d2;
            float bre[16], bim[16];
#pragma unroll
            for (int c = 0; c < 16; ++c) { const double br = (double)P->in[I_BRE][(size_t)idx * 16 + c], bi = (double)P->in[I_BIM][(size_t)idx * 16 + c]; bre[c] = (float)(qr * br - qi * bi); bim[c] = (float)(qr * bi + qi * br); }
            bf16* bb = (bf16*)(ws + WS_BB);
            u32x4* d_re = (u32x4*)(bb + ((size_t)(((l * 2 + dir) * 32 + g) * 2 + 0) * 64 + p) * 16);
            u32x4* d_im = (u32x4*)(bb + ((size_t)(((l * 2 + dir) * 32 + g) * 2 + 1) * 64 + p) * 16);
            d_re[0] = pack8(bre); d_re[1] = pack8(bre + 8); d_im[0] = pack8(bim); d_im[1] = pack8(bim + 8);
            bf16* ct = (bf16*)(ws + WS_CT);
#pragma unroll
            for (int cc = 0; cc < 16; ++cc) { const size_t ci = ((size_t)((l * 2 + dir) * 32 + g) * 16 + cc) * 64 + p;
                const float cre = P->in[I_CRE][ci], cim = P->in[I_CIM][ci];
                *(unsigned*)(ct + ((size_t)(((l * 32 + g) * 2 + dir) * 16 + cc) * 128 + 2 * p)) = cvt_pk_bf16(cre, -cim); }
        } else {
            for (int idx = tid; idx < 1024; idx += 512) { const int pos = idx >> 4, j = idx & 15;
                const double inv = exp(-(double)j / 16.0 * log(10000.0)), ang = (double)pos * inv;
                ((f32x2*)(ws + WS_ROPE))[idx] = (f32x2){(float)cos(ang), (float)sin(ang)}; }
        }
    }
}


__device__ __forceinline__ void p1_rows(KP P, int l, int lane, int wid) {
    RELOAD_P(P);
    const float* mods = (const float*)(P->ws + WS_MODS) + (size_t)l * 3 * 3072;
    const float* ng = P->in[I_NG] + l * DM;
    bf16* H = (bf16*)(P->ws + WS_H);
    const int gw = blockIdx.x * 8 + wid, NGW = gridDim.x * 8;
    for (int m = gw; m < MTOK; m += NGW) {
        const float* xr = (l == 0) ? (m < MCTX ? P->in[I_XP] + (size_t)m * DM : P->in[I_XS] + (size_t)(m - MCTX) * DM) : P->out + (size_t)m * DM;
        const int cond = m < MCTX ? 0 : 1 + ((m - MCTX) >> 10);
        const float* sh = mods + cond * 3072; const float* sc = sh + 1024;
        f32x4 v[4]; float s = 0.f;
#pragma unroll
        for (int j = 0; j < 4; ++j) { v[j] = *(const f32x4*)(xr + 4 * lane + 256 * j); s += (v[j].x * v[j].x + v[j].y * v[j].y) + (v[j].z * v[j].z + v[j].w * v[j].w); }
        const float rstd = rsqrtf(wave_sum(s) * (1.f / DM) + EPS);
#pragma unroll
        for (int j = 0; j < 4; ++j) { const int c = 4 * lane + 256 * j;
            const f32x4 g4 = *(const f32x4*)(ng + c), sc4 = *(const f32x4*)(sc + c), sh4 = *(const f32x4*)(sh + c);
            const f32x4 o = v[j] * rstd * g4 * (sc4 + 1.f) + sh4;
            u32x2 w; w.x = cvt_pk_bf16(o.x, o.y); w.y = cvt_pk_bf16(o.z, o.w);
            *(u32x2*)(H + (size_t)m * DM + c) = w; }
    }
}

constexpr int KS_PITCH = 144, VT_PITCH = 528, VT_OFF = 256 * KS_PITCH;
__device__ __forceinline__ int crow(int r, int hi) { return (r & 3) + 8 * (r >> 2) + 4 * hi; }
__device__ __forceinline__ float max3f(float a, float b, float c) { float r; asm("v_max3_f32 %0, %1, %2, %3" : "=v"(r) : "v"(a), "v"(b), "v"(c)); return r; }
__device__ __forceinline__ void attn_item(KP P, int l, int it, LAS unsigned char* lds, int tid, int lane, int wid) {
    RELOAD_P(P);
    asm volatile("" : "+s"(l)); asm volatile("" : "+v"(tid)); lane = tid & 63; wid = __builtin_amdgcn_readfirstlane(tid >> 6);
    const bf16* Z = (const bf16*)(P->ws + WS_Z);
    bf16* OA = (bf16*)(P->ws + WS_ABR) + (size_t)2 * MTOK * 512;
    const f32x2* rope = (const f32x2*)(P->ws + WS_ROPE);
    const bool lat = it < 64;
    int b, kvh, qb;
    if (lat) { b = it >> 5; kvh = (it >> 4) & 1; qb = it & 15; } else { const int j = it - 64; b = j >> 3; kvh = (j >> 2) & 1; qb = j & 3; }
    const int rowbase = lat ? MCTX + b * 1024 : b * 256;
    const int nkt = lat ? 5 : 1;
    const int r32 = lane & 31, hi = lane >> 5;
    const int h = 4 * kvh + (wid & 3);
    const int tq = qb * 64 + 32 * (wid >> 2) + r32;
    const int qrow = rowbase + tq;
    bf16x8 qf[4];
    {
        float qv[4][8]; float ss = 0.f;
        const bf16* zq = Z + (size_t)qrow * NCOL + C_Q + 64 * h + 8 * hi;
#pragma unroll
        for (int d0 = 0; d0 < 4; ++d0) { const u32x4 w = *(const u32x4*)(zq + 16 * d0); unpack8(w, qv[d0]);
#pragma unroll
            for (int i = 0; i < 8; ++i) ss += qv[d0][i] * qv[d0][i]; }
        ss += __shfl_xor(ss, 32);
        const float rs = rsqrtf(ss * (1.f / 64.f) + EPS);
        const float* qg = P->in[I_QG] + l * 64 + 8 * hi;
#pragma unroll
        for (int d0 = 0; d0 < 4; ++d0)
#pragma unroll
            for (int i = 0; i < 8; ++i) qv[d0][i] *= rs * qg[16 * d0 + i];
        if (lat) {
            const int prow = tq >> 6, pcol = tq & 63;
#pragma unroll
            for (int i = 0; i < 8; ++i) { const int j = 8 * hi + i;
                const f32x2 a = rope[prow * 16 + j]; float x1 = qv[0][i], x2 = qv[1][i]; qv[0][i] = x1 * a.x - x2 * a.y; qv[1][i] = x1 * a.y + x2 * a.x;
                const f32x2 c = rope[pcol * 16 + j]; x1 = qv[2][i]; x2 = qv[3][i]; qv[2][i] = x1 * c.x - x2 * c.y; qv[3][i] = x1 * c.y + x2 * c.x; }
        }
        const float qs = 0.125f * 1.4426950408889634f;
#pragma unroll
        for (int d0 = 0; d0 < 4; ++d0) {
#pragma unroll
            for (int i = 0; i < 8; ++i) qv[d0][i] *= qs;
            qf[d0] = __builtin_bit_cast(bf16x8, pack8(qv[d0])); }
    }
    constexpr float ATT_THR = 8.f;
    float mhat = 0.f, lrun = 0.f;
    f32x16 negm;
#pragma unroll
    for (int r = 0; r < 16; ++r) negm[r] = 0.f;
    f32x16 o0, o1;
#pragma unroll
    for (int r = 0; r < 16; ++r) { o0[r] = 0.f; o1[r] = 0.f; }
    for (int kt = 0; kt < nkt; ++kt) {
        __syncthreads();
        {
            const int key = tid >> 1, half = tid & 1;
            float kx[32];
            const bool from_z = (!lat) || kt < 4;
            if (from_z) {
                const int t = kt * 256 + key;
                const bf16* src = Z + (size_t)(rowbase + t) * NCOL + C_K + 64 * kvh + 32 * half;
                float ss = 0.f;
#pragma unroll
                for (int q = 0; q < 4; ++q) { const u32x4 w = *(const u32x4*)(src + 8 * q); unpack8(w, kx + 8 * q); }
#pragma unroll
                for (int i = 0; i < 32; ++i) ss += kx[i] * kx[i];
                ss += __shfl_xor(ss, 1);
                const float rs = rsqrtf(ss * (1.f / 64.f) + EPS);
                const float* kg = P->in[I_KG] + l * 64 + 32 * half;
#pragma unroll
                for (int i = 0; i < 32; ++i) kx[i] *= rs * kg[i];
                if (!lat && qb == 0) { float* dst = P->out + O_CK + ((size_t)((b * 2 + l) * 256 + key) * 2 + kvh) * 64 + 32 * half;
#pragma unroll
                    for (int q = 0; q < 8; ++q) *(f32x4*)(dst + 4 * q) = (f32x4){kx[4 * q], kx[4 * q + 1], kx[4 * q + 2], kx[4 * q + 3]}; }
                if (lat) { const int pos = half ? (t & 63) : (t >> 6);
#pragma unroll
                    for (int j = 0; j < 16; ++j) { const f32x2 a = rope[pos * 16 + j]; const float x1 = kx[j], x2 = kx[16 + j]; kx[j] = x1 * a.x - x2 * a.y; kx[16 + j] = x1 * a.y + x2 * a.x; } }
            } else {
                const float* src = P->in[I_CK] + ((size_t)((b * 2 + l) * 256 + key) * 2 + kvh) * 64 + 32 * half;
#pragma unroll
                for (int q = 0; q < 8; ++q) { const f32x4 w = *(const f32x4*)(src + 4 * q); kx[4 * q] = w.x; kx[4 * q + 1] = w.y; kx[4 * q + 2] = w.z; kx[4 * q + 3] = w.w; }
            }
            LAS u32x4* kd = (LAS u32x4*)(lds + key * KS_PITCH + 64 * half);
#pragma unroll
            for (int q = 0; q < 4; ++q) kd[q] = pack8(kx + 8 * q);
            if (from_z) {
                const int t = kt * 256 + key;
                const bf16* src = Z + (size_t)(rowbase + t) * NCOL + C_V + 64 * kvh + 32 * half;
#pragma unroll
                for (int q = 0; q < 4; ++q) { const u32x4 w = *(const u32x4*)(src + 8 * q); unpack8(w, kx + 8 * q); }
                if (!lat && qb == 0) { float* dst = P->out + O_CV + ((size_t)((b * 2 + l) * 256 + key) * 2 + kvh) * 64 + 32 * half;
#pragma unroll
                    for (int q = 0; q < 8; ++q) *(f32x4*)(dst + 4 * q) = (f32x4){kx[4 * q], kx[4 * q + 1], kx[4 * q + 2], kx[4 * q + 3]}; }
            } else {
                const float* src = P->in[I_CV] + ((size_t)((b * 2 + l) * 256 + key) * 2 + kvh) * 64 + 32 * half;
#pragma unroll
                for (int q = 0; q < 8; ++q) { const f32x4 w = *(const f32x4*)(src + 4 * q); kx[4 * q] = w.x; kx[4 * q + 1] = w.y; kx[4 * q + 2] = w.z; kx[4 * q + 3] = w.w; }
            }
            const int pos = (key & ~15) | ((key & 4) << 1) | ((key & 8) >> 1) | (key & 3);
            LAS bf16* vd = (LAS bf16*)(lds + VT_OFF + (32 * half) * VT_PITCH + 2 * pos);
#pragma unroll
            for (int i = 0; i < 32; i += 2) { const unsigned w = cvt_pk_bf16(kx[i], kx[i + 1]);
                vd[(size_t)i * (VT_PITCH / 2)] = (bf16)(w & 0xffffu); vd[(size_t)(i + 1) * (VT_PITCH / 2)] = (bf16)(w >> 16); }
        }
        __syncthreads();
#pragma unroll 1
        for (int st = 0; st < 4; ++st) {
            f32x16 p0 = negm, p1 = negm;
            const LAS unsigned char* kb = lds + (64 * st + r32) * KS_PITCH + 16 * hi;
#pragma unroll
            for (int d0 = 0; d0 < 4; ++d0) {
                const bf16x8 a0 = *(const LAS bf16x8*)(kb + 32 * d0);
                const bf16x8 a1 = *(const LAS bf16x8*)(kb + 32 * KS_PITCH + 32 * d0);
                p0 = MFMA32(a0, qf[d0], p0); p1 = MFMA32(a1, qf[d0], p1);
            }
            asm volatile("s_nop 15\n\ts_nop 7" : "+v"(p0), "+v"(p1));
            float tm;
            { float a = max3f(p0[0], p0[1], p1[0]), b2 = max3f(p0[2], p0[3], p1[1]); a = max3f(a, p1[2], p1[3]);
#pragma unroll
              for (int r = 4; r < 16; r += 4) { a = max3f(a, p0[r], p0[r + 1]); b2 = max3f(b2, p0[r + 2], p0[r + 3]); a = max3f(a, p1[r], p1[r + 1]); b2 = max3f(b2, p1[r + 2], p1[r + 3]); }
              tm = max3f(a, b2, b2); }
            { const float other = __shfl_xor(tm, 32); tm = max3f(tm, other, other); }
            if (__any(fabsf(tm) > ATT_THR)) {
                const float dl = fabsf(tm) > ATT_THR ? tm : 0.f;
                mhat += dl;
                const float f = __builtin_amdgcn_exp2f(-dl);
#pragma unroll
                for (int r = 0; r < 16; ++r) { p0[r] -= dl; p1[r] -= dl; negm[r] = -mhat; o0[r] *= f; o1[r] *= f; }
                lrun *= f;
            }
            float ps = 0.f;
#pragma unroll
            for (int r = 0; r < 16; ++r) { p0[r] = __builtin_amdgcn_exp2f(p0[r]); p1[r] = __builtin_amdgcn_exp2f(p1[r]); ps += p0[r] + p1[r]; }
            lrun += ps;
            bf16x8 pb[4];
            { float t8[8];
#pragma unroll
              for (int J = 0; J < 4; ++J) {
#pragma unroll
                  for (int i = 0; i < 8; ++i) t8[i] = (J < 2) ? p0[8 * (J & 1) + i] : p1[8 * (J & 1) + i];
                  pb[J] = __builtin_bit_cast(bf16x8, pack8(t8)); } }
            const LAS unsigned char* vb = lds + VT_OFF + r32 * VT_PITCH + 2 * (64 * st + 8 * hi);
#pragma unroll
            for (int J = 0; J < 4; ++J) {
                const bf16x8 v0 = *(const LAS bf16x8*)(vb + 32 * J);
                const bf16x8 v1 = *(const LAS bf16x8*)(vb + 32 * VT_PITCH + 32 * J);
                o0 = MFMA32(v0, pb[J], o0); o1 = MFMA32(v1, pb[J], o1);
            }
        }
    }
    lrun += __shfl_xor(lrun, 32);
    const float inv = 1.f / lrun;
    const bf16* zg = Z + (size_t)qrow * NCOL + C_AGATE + 64 * h;
    bf16* od = OA + (size_t)qrow * 512 + 64 * h;
#pragma unroll
    for (int dt = 0; dt < 2; ++dt)
#pragma unroll
        for (int rq = 0; rq < 4; ++rq) { const int d = 32 * dt + 8 * rq + 4 * hi;
            const u32x2 gw = *(const u32x2*)(zg + d);
            float v[4];
#pragma unroll
            for (int i = 0; i < 4; ++i) v[i] = (dt ? o1[4 * rq + i] : o0[4 * rq + i]) * inv;
            v[0] *= silu_f(bf_lo(gw.x)); v[1] *= silu_f(bf_hi(gw.x)); v[2] *= silu_f(bf_lo(gw.y)); v[3] *= silu_f(bf_hi(gw.y));
            u32x2 w; w.x = cvt_pk_bf16(v[0], v[1]); w.y = cvt_pk_bf16(v[2], v[3]);
            *(u32x2*)(od + d) = w; }
}

__device__ __forceinline__ float fsigm(float x) { return __builtin_amdgcn_rcpf(1.f + __builtin_amdgcn_exp2f(-1.4426950408889634f * x)); }
__device__ __forceinline__ void conv_item(KP P, int l, int it, LAS unsigned char* lds, int tid, int lane, int wid, const float (&w)[32], const float bias, const float lgam, const float lbet, unsigned* qctr, unsigned& next_ticket) {
    RELOAD_P(P);
    asm volatile("" : "+s"(l)); asm volatile("" : "+v"(tid)); lane = tid & 63; wid = __builtin_amdgcn_readfirstlane(tid >> 6);
    const bf16* Z = (const bf16*)(P->ws + WS_Z);
    bf16* YA = (bf16*)(P->ws + WS_ABR);
    int rowbase, L, t0;
    if (it < 512) { rowbase = (it >> 4) * 256; L = 256; t0 = 16 * (it & 15); } else { const int j = it - 512; rowbase = MCTX + (j >> 6) * 1024; L = 1024; t0 = 16 * (j & 63); }
    LAS float* yb = (LAS float*)lds;
    LAS float* sb = (LAS float*)(lds + 47 * 512 * 4);
    LAS float* st = (LAS float*)(lds + 47 * 512 * 4 + 16 * 516 * 4);
    u32x4 la[6], lg[6];
#pragma unroll
    for (int i = 0; i < 6; ++i) {
        const int e = tid + 512 * i, rr = e >> 6, ch = e & 63, t = t0 - 15 + rr;
        la[i] = (u32x4){0u, 0u, 0u, 0u}; lg[i] = (u32x4){0u, 0u, 0u, 0u};
        if (rr < 47 && t >= 0 && t < L) { const bf16* src = Z + (size_t)(rowbase + t) * NCOL + 8 * ch; la[i] = *(const u32x4*)(src + C_CONVA); lg[i] = *(const u32x4*)(src + C_CONVG); }
    }
    const int c = tid;
    bf16 gt[16];
#pragma unroll
    for (int t = 0; t < 16; ++t) gt[t] = Z[(size_t)(rowbase + t0 + t) * NCOL + C_CGATE + c];
#pragma unroll
    for (int i = 0; i < 6; ++i) {
        const int e = tid + 512 * i, rr = e >> 6, ch = e & 63;
        if (rr < 47) {
            float a[8], g[8]; unpack8(la[i], a); unpack8(lg[i], g);
#pragma unroll
            for (int q = 0; q < 8; ++q) a[q] *= fsigm(g[q]);
            LAS f32x4* d = (LAS f32x4*)(yb + rr * 512 + 8 * ch);
            d[0] = (f32x4){a[0], a[1], a[2], a[3]}; d[1] = (f32x4){a[4], a[5], a[6], a[7]};
        }
    }
    __syncthreads();
    float acc[16];
#pragma unroll
    for (int t = 0; t < 16; ++t) acc[t] = bias;
#pragma unroll
    for (int kb = 0; kb < 32; kb += 8) {
        const LAS float* yp = yb + kb * 512 + c;
        float rows[23];
#pragma unroll
        for (int j = 0; j < 23; ++j) rows[j] = yp[j * 512];
#pragma unroll
        for (int t = 0; t < 16; ++t)
#pragma unroll
            for (int i = 0; i < 8; ++i) acc[t] += w[kb + i] * rows[t + i];
    }
#pragma unroll
    for (int t = 0; t < 16; ++t) sb[t * 516 + c] = acc[t];
    __syncthreads();
    {
        const int t = tid >> 5, j = tid & 31;
        const LAS f32x4* q = (const LAS f32x4*)(sb + t * 516 + 16 * j);
        float s1 = 0.f, s2 = 0.f;
#pragma unroll
        for (int i = 0; i < 4; ++i) { const f32x4 v = q[i]; s1 += (v.x + v.y) + (v.z + v.w); s2 += (v.x * v.x + v.y * v.y) + (v.z * v.z + v.w * v.w); }
#pragma unroll
        for (int o = 1; o < 32; o <<= 1) { s1 += __shfl_xor(s1, o); s2 += __shfl_xor(s2, o); }
        if (j == 0) { const float mean = s1 * (1.f / 512.f); const float var = fmaxf(s2 * (1.f / 512.f) - mean * mean, 0.f); st[2 * t] = mean; st[2 * t + 1] = rsqrtf(var + EPS); }
    }
    __syncthreads();
    if (tid == 0) next_ticket = atomicAdd(qctr, 1u);
#pragma unroll
    for (int t = 0; t < 16; ++t) {
        const float y = (acc[t] - st[2 * t]) * st[2 * t + 1] * lgam + lbet;
        const float gate = __uint_as_float((unsigned)gt[t] << 16);
        const float o = y * gate * __builtin_amdgcn_rcpf((1.f + __builtin_amdgcn_exp2f(-1.4426950408889634f * y)) * (1.f + __builtin_amdgcn_exp2f(-1.4426950408889634f * gate)));
        YA[(size_t)(rowbase + t0 + t) * 512 + c] = (bf16)(cvt_pk_bf16(o, o) & 0xffffu);
    }
}

constexpr int HS_PITCH = 272, HS_S = 16 * HS_PITCH, HS_WAVE = 2 * HS_S;
struct SsmIdx { int lat, b, rg, go, NR; };
__device__ __forceinline__ SsmIdx ssm_decode(int it) {
    SsmIdx s;
    if (it < 512) { s.lat = 0; s.b = it >> 4; s.rg = (it >> 2) & 3; s.go = it & 3; s.NR = 4; }
    else { const int j = it - 512; s.lat = 1; s.b = j >> 6; s.rg = (j >> 2) & 15; s.go = j & 3; s.NR = 16; }
    return s;
}
#define CMUL_ADD(hr, hi_, lr, li, br, bi) do { const float _tr = __builtin_fmaf(-(li), (hi_), (br)), _ti = __builtin_fmaf((li), (hr), (bi)); const float _nr = __builtin_fmaf((lr), (hr), _tr), _ni = __builtin_fmaf((lr), (hi_), _ti); (hr) = _nr; (hi_) = _ni; } while (0)

template <int PASS>
__device__ __forceinline__ void ssm_item(KP P, int l, int it, LAS unsigned char* lds, int tid, int lane, int wid, int gsel) {
    RELOAD_P(P);
    asm volatile("" : "+s"(l)); asm volatile("" : "+v"(tid)); lane = tid & 63; wid = __builtin_amdgcn_readfirstlane(tid >> 6);
    const bf16* Z = (const bf16*)(P->ws + WS_Z);
    const SsmIdx S = ssm_decode(it);
    const int g = 8 * S.go + gsel;
    const int r32 = lane & 31, hi = lane >> 5;
    const int rb = S.lat ? MCTX + S.b * 1024 : S.b * 256;
    const int kA = (r32 & 3) + 4 * (r32 >> 3);
    const int t_start = 64 * S.rg;
    const int sr_base = S.lat ? 128 + S.b * 16 : S.b * 4;
    const bf16* zu = Z + (size_t)(rb + t_start + kA) * NCOL + C_SSMIN + 16 * g + 8 * hi;
    bf16x8 uf[4];
    if (PASS == 2) {
#pragma unroll
        for (int j = 0; j < 4; ++j) uf[j] = __builtin_bit_cast(bf16x8, *(const u32x4*)(zu + (size_t)(16 * j) * NCOL));
    }
    f32x2* E = (f32x2*)(P->ws + WS_E);
    const f32x2* LAM = (const f32x2*)(P->ws + WS_LAM);
    const bf16* BB = (const bf16*)(P->ws + WS_BB);
    const bf16* CT = (const bf16*)(P->ws + WS_CT);
    LAS unsigned char* hs = lds + wid * HS_WAVE;
    f32x4 yacc[4];
    if (PASS == 2) {
#pragma unroll
        for (int j = 0; j < 4; ++j) yacc[j] = (f32x4){0.f, 0.f, 0.f, 0.f};
    }
#pragma unroll
    for (int dir = 0; dir < 2; ++dir) {
        const int ldg = (l * 2 + dir) * 32 + g;
        bf16x8 bfr[2][2];
        f32x2 lam[2];
#pragma unroll
        for (int pt = 0; pt < 2; ++pt) {
            lam[pt] = LAM[(size_t)ldg * 64 + 32 * pt + r32];
#pragma unroll
            for (int ri = 0; ri < 2; ++ri) bfr[pt][ri] = __builtin_bit_cast(bf16x8, *(const u32x4*)(BB + ((size_t)(ldg * 2 + ri) * 64 + 32 * pt + r32) * 16 + 8 * hi));
        }
        float hr[2], hm[2];
        bf16x8 ctf[4];
        if (PASS == 1) { hr[0] = hr[1] = hm[0] = hm[1] = 0.f; }
        else {
            const int q4 = lane >> 4, cc = lane & 15;
#pragma unroll
            for (int kk = 0; kk < 4; ++kk) ctf[kk] = __builtin_bit_cast(bf16x8, *(const u32x4*)(CT + ((size_t)((l * 32 + g) * 2 + dir) * 16 + cc) * 128 + 32 * kk + 8 * q4));
#pragma unroll
            for (int pt = 0; pt < 2; ++pt) {
                float l64r = lam[pt].x, l64i = lam[pt].y;
#pragma unroll
                for (int q = 0; q < 6; ++q) { const float nr = l64r * l64r - l64i * l64i, ni = 2.f * l64r * l64i; l64r = nr; l64i = ni; }
                float cr = 0.f, ci = 0.f;
                if (S.lat) { const size_t si = ((size_t)((S.b * 2 + l) * 2 + dir) * 32 + g) * 64 + 32 * pt + r32; cr = P->in[I_SRE][si]; ci = P->in[I_SIM][si]; }
                {
                    const int n_it = dir == 0 ? S.rg : S.NR - 1 - S.rg;
                    const f32x2* Eb = E + ((size_t)(sr_base * 32 + g) * 2 + dir) * 64 + 32 * pt + r32;
                    for (int i0 = 0; i0 < n_it; i0 += 4) {
                        f32x2 e4[4];
#pragma unroll
                        for (int k = 0; k < 4; ++k) { const int i = min(i0 + k, n_it - 1); const int ri = dir == 0 ? i : S.NR - 1 - i; e4[k] = Eb[(size_t)ri * 4096]; }
#pragma unroll
                        for (int k = 0; k < 4; ++k) { const bool ok = i0 + k < n_it; const float nr = __builtin_fmaf(l64r, cr, __builtin_fmaf(-l64i, ci, e4[k].x)), ni = __builtin_fmaf(l64r, ci, __builtin_fmaf(l64i, cr, e4[k].y)); cr = ok ? nr : cr; ci = ok ? ni : ci; }
                    }
                }
                hr[pt] = cr; hm[pt] = ci;
            }
        }
#pragma unroll (PASS == 2 ? 4 : 1)
        for (int jj = 0; jj < 4; ++jj) {
            const int j = dir ? 3 - jj : jj;
            bf16x8 ufj;
            if (PASS == 2) ufj = uf[j]; else ufj = __builtin_bit_cast(bf16x8, *(const u32x4*)(zu + (size_t)(16 * j) * NCOL));
            const f32x16 zero16 = (f32x16){0.f, 0.f, 0.f, 0.f, 0.f, 0.f, 0.f, 0.f, 0.f, 0.f, 0.f, 0.f, 0.f, 0.f, 0.f, 0.f};
#pragma unroll
            for (int pt = 0; pt < 2; ++pt) {
                const f32x16 are = MFMA32(ufj, bfr[pt][0], zero16);
                const f32x16 aim = MFMA32(ufj, bfr[pt][1], zero16);
                LAS unsigned* hw = (LAS unsigned*)(hs + hi * HS_S + 4 * (32 * pt + r32));
#pragma unroll
                for (int rr = 0; rr < 16; ++rr) { const int r = dir ? 15 - rr : rr;
                    CMUL_ADD(hr[pt], hm[pt], lam[pt].x, lam[pt].y, are[r], aim[r]);
                    if (PASS == 2) hw[r * (HS_PITCH / 4)] = cvt_pk_bf16(hr[pt], hm[pt]); }
                __builtin_amdgcn_sched_barrier(0);
            }
            if (PASS == 2) {
                const int q4 = lane >> 4, n = lane & 15;
#pragma unroll
                for (int kk = 0; kk < 4; ++kk) { const bf16x8 hb = *(const LAS bf16x8*)(hs + n * HS_PITCH + 64 * kk + 16 * q4);
                    yacc[j] = MFMA16(ctf[kk], hb, yacc[j]); }
            }
        }
        if (hi == 0) {
            if (PASS == 1) {
#pragma unroll
                for (int pt = 0; pt < 2; ++pt) E[((size_t)((sr_base + S.rg) * 32 + g) * 2 + dir) * 64 + 32 * pt + r32] = (f32x2){hr[pt], hm[pt]};
            } else if (!S.lat && ((dir == 0 && S.rg == 3) || (dir == 1 && S.rg == 0))) {
#pragma unroll
                for (int pt = 0; pt < 2; ++pt) { const size_t oi = ((size_t)((S.b * 2 + l) * 2 + dir) * 32 + g) * 64 + 32 * pt + r32;
                    P->out[O_SRE + oi] = hr[pt]; P->out[O_SIM + oi] = hm[pt]; }
            }
        }
    }
    if (PASS == 2) {
        bf16* YB = (bf16*)(P->ws + WS_YB);
        const int q4 = lane >> 4, n = lane & 15;
        const f32x4 dv = *(const f32x4*)(P->in[I_SD] + l * 512 + 16 * g + 4 * q4);
#pragma unroll
        for (int j = 0; j < 4; ++j) {
            const size_t row = (size_t)(rb + t_start + 16 * j + n);
            const u32x2 uw = *(const u32x2*)(Z + row * NCOL + C_SSMIN + 16 * g + 4 * q4);
            float y[4];
            y[0] = yacc[j][0] + dv.x * bf_lo(uw.x); y[1] = yacc[j][1] + dv.y * bf_hi(uw.x); y[2] = yacc[j][2] + dv.z * bf_lo(uw.y); y[3] = yacc[j][3] + dv.w * bf_hi(uw.y);
#pragma unroll
            for (int i = 0; i < 4; ++i) { const float x = y[i]; y[i] = x * sigm(1.5957691216057308f * (x + 0.044715f * x * x * x)); }
            u32x2 w; w.x = cvt_pk_bf16(y[0], y[1]); w.y = cvt_pk_bf16(y[2], y[3]);
            *(u32x2*)(YB + row * 512 + 16 * g + 4 * q4) = w;
        }
    }
}

#ifdef DBG_NAIVE_STATE
__device__ __forceinline__ void naive_state_item(KP P, int l, int it, int tid) {
    RELOAD_P(P);
    asm volatile("" : "+s"(l)); asm volatile("" : "+v"(tid));
    const bf16* Z = (const bf16*)(P->ws + WS_Z);
    const int idx = it * 512 + tid; const int p = idx & 63, g = (idx >> 6) & 31, dir = (idx >> 11) & 1, b = idx >> 12;
    const int ti = ((l * 2 + dir) * 32 + g) * 64 + p;
    const float are = P->in[I_ARE][ti], aim = P->in[I_AIM][ti];
    const f32x2 lmb = ((const f32x2*)(P->ws + WS_LAM))[ti];
    const float lr = lmb.x, li = lmb.y;
    const float d2 = are * are + aim * aim, qr = ((lr - 1.0f) * are + li * aim) / d2, qi = (li * are - (lr - 1.0f) * aim) / d2;
    float bre[16], bim[16];
#pragma unroll
    for (int c = 0; c < 16; ++c) { const float br = P->in[I_BRE][(size_t)ti * 16 + c], bi = P->in[I_BIM][(size_t)ti * 16 + c]; bre[c] = qr * br - qi * bi; bim[c] = qr * bi + qi * br;
#ifdef DBG_BF16_B
        { const unsigned w = cvt_pk_bf16(bre[c], bim[c]); bre[c] = bf_lo(w); bim[c] = bf_hi(w); }
#endif
#ifdef DBG_USE_BB
        { const bf16* BBt = (const bf16*)(P->ws + WS_BB); const int ldg_ = (l * 2 + dir) * 32 + g;
          bre[c] = __uint_as_float((unsigned)BBt[((size_t)(ldg_ * 2 + 0) * 64 + p) * 16 + c] << 16); bim[c] = __uint_as_float((unsigned)BBt[((size_t)(ldg_ * 2 + 1) * 64 + p) * 16 + c] << 16); }
#endif
    }
    float hr = 0.f, hm = 0.f;
#pragma unroll 1
    for (int tt = 0; tt < 256; ++tt) {
        const int t = dir ? 255 - tt : tt;
        const bf16* src = Z + (size_t)(b * 256 + t) * NCOL + C_SSMIN + 16 * g;
        float u[16]; unpack8(*(const u32x4*)src, u); unpack8(*(const u32x4*)(src + 8), u + 8);
        float br = 0.f, bi = 0.f;
#pragma unroll
        for (int c = 0; c < 16; ++c) { br += bre[c] * u[c]; bi += bim[c] * u[c]; }
        CMUL_ADD(hr, hm, lr, li, br, bi);
    }
    const size_t oi = ((size_t)((b * 2 + l) * 2 + dir) * 32 + g) * 64 + p;
#if defined(DBG_SPLIT_HI) && defined(DBG_SWAP)
    if ((b & 1) == DBG_SPLIT_HI)
#elif defined(DBG_SPLIT_HI)
    if ((b & 1) != DBG_SPLIT_HI)
#endif
    { P->out[O_SRE + oi] = hr; P->out[O_SIM + oi] = hm; }
}
#endif

__device__ __forceinline__ void state_item(KP P, int l, int it, int tid, int lane, int wid) {
    RELOAD_P(P);
    asm volatile("" : "+s"(l)); asm volatile("" : "+v"(tid)); lane = tid & 63; wid = __builtin_amdgcn_readfirstlane(tid >> 6);
    const bf16* Z = (const bf16*)(P->ws + WS_Z);
    const int w = __builtin_amdgcn_readfirstlane(it * 8 + wid);
    const int g = w & 31, dir = (w >> 5) & 1, b = w >> 6;
    const int r32 = lane & 31, hi = lane >> 5;
    const int kA = (r32 & 3) + 4 * (r32 >> 3);
    const int ldg = (l * 2 + dir) * 32 + g;
    const f32x2* LAM = (const f32x2*)(P->ws + WS_LAM);
    const bf16* BB = (const bf16*)(P->ws + WS_BB);
    bf16x8 bfr[2][2]; f32x2 lam[2]; float hr[2] = {0.f, 0.f}, hm[2] = {0.f, 0.f};
#pragma unroll
    for (int pt = 0; pt < 2; ++pt) {
        lam[pt] = LAM[(size_t)ldg * 64 + 32 * pt + r32];
#pragma unroll
        for (int ri = 0; ri < 2; ++ri) bfr[pt][ri] = __builtin_bit_cast(bf16x8, *(const u32x4*)(BB + ((size_t)(ldg * 2 + ri) * 64 + 32 * pt + r32) * 16 + 8 * hi));
    }
    const bf16* zb = Z + (size_t)(b * 256 + kA) * NCOL + C_SSMIN + 16 * g + 8 * hi;
    const f32x16 z16 = (f32x16){0.f, 0.f, 0.f, 0.f, 0.f, 0.f, 0.f, 0.f, 0.f, 0.f, 0.f, 0.f, 0.f, 0.f, 0.f, 0.f};
#pragma unroll 1
    for (int q = 0; q < 16; q += 2) {
        const int j0 = dir ? 15 - q : q, j1 = dir ? 14 - q : q + 1;
        const bf16x8 u0 = __builtin_bit_cast(bf16x8, *(const u32x4*)(zb + (size_t)(16 * j0) * NCOL));
        const bf16x8 u1 = __builtin_bit_cast(bf16x8, *(const u32x4*)(zb + (size_t)(16 * j1) * NCOL));
#pragma unroll
        for (int half = 0; half < 2; ++half) {
            const bf16x8 ux = half ? u1 : u0;
#pragma unroll
            for (int pt = 0; pt < 2; ++pt) {
                const f32x16 xr = MFMA32(ux, bfr[pt][0], z16);
                const f32x16 xi = MFMA32(ux, bfr[pt][1], z16);
                if (dir == 0) {
#pragma unroll
                    for (int r = 0; r < 16; ++r) CMUL_ADD(hr[pt], hm[pt], lam[pt].x, lam[pt].y, xr[r], xi[r]);
                } else {
#pragma unroll
                    for (int r = 15; r >= 0; --r) CMUL_ADD(hr[pt], hm[pt], lam[pt].x, lam[pt].y, xr[r], xi[r]);
                }
            }
        }
    }
    if (hi == 0) {
#pragma unroll
        for (int pt = 0; pt < 2; ++pt) { const size_t oi = ((size_t)((b * 2 + l) * 2 + dir) * 32 + g) * 64 + 32 * pt + r32;
            P->out[O_SRE + oi] = hr[pt]; P->out[O_SIM + oi] = hm[pt]; }
    }
}
#define XB_TMO      128
#define XB_XCNT(j)  (256  + 64 * (j))
#define XB_XSUB(j)  (1280 + 64 * (j))
#define XB_XGEN(j)  (2304 + 64 * (j))
#define XB_TOP      3328
#define XB_TOPGEN   3392
#define XCD_BAR_WORDS 3456
#define XB_SPIN_CAP (1u << 18)

__device__ __forceinline__ unsigned xb_ld(unsigned* p)              { return __hip_atomic_load(p, __ATOMIC_RELAXED, __HIP_MEMORY_SCOPE_AGENT); }
__device__ __forceinline__ unsigned xb_add(unsigned* p, unsigned v) { return __hip_atomic_fetch_add(p, v, __ATOMIC_RELAXED, __HIP_MEMORY_SCOPE_AGENT); }
__device__ __forceinline__ unsigned xb_xcc_id() { return (unsigned)__builtin_amdgcn_s_getreg((3 << 11) | 20) & 0xFu; }
#define XB_SPIN(cond, bar) do { unsigned _sp = 0; while (cond) { __builtin_amdgcn_s_sleep(1); \
    if ((++_sp & 255u) == 0u) { if (xb_ld(&(bar)[XB_TMO])) break; if (_sp > XB_SPIN_CAP) { atomicAdd(&(bar)[XB_TMO], 1u); break; } } } } while (0)

struct XcdBarrier {
    unsigned* bar; unsigned x;
    volatile LAS unsigned* st;
};

__device__ __forceinline__ XcdBarrier xcd_barrier_post(unsigned* bar, volatile LAS unsigned* st) {
    XcdBarrier b; b.bar = bar; b.x = xb_xcc_id(); b.st = st;
    if (threadIdx.x == 0) (void)xb_add(&bar[XB_XCNT(b.x)], 1u);
    return b;
}
__device__ __forceinline__ void xcd_barrier_complete(unsigned* bar, unsigned x, unsigned& nloc, unsigned& nx) {
    const unsigned G = gridDim.x * gridDim.y * gridDim.z;
    unsigned sum, cnt, mine, sp = 0u;
    for (;;) {
        sum = 0u; cnt = 0u; mine = 0u;
#pragma unroll
        for (unsigned j = 0; j < 16; ++j) { const unsigned c = xb_ld(&bar[XB_XCNT(j)]); sum += c; cnt += (c > 0u) ? 1u : 0u; mine = (j == x) ? c : mine; }
        if (sum == G) break;
        __builtin_amdgcn_s_sleep(1);
        if ((++sp & 255u) == 0u) { if (xb_ld(&bar[XB_TMO])) break; if (sp > XB_SPIN_CAP) { atomicAdd(&bar[XB_TMO], 1u); break; } }
    }
    nloc = mine > 0u ? mine : 1u; nx = cnt > 0u ? cnt : 1u;
}

__device__ __forceinline__ void xcd_barrier(const XcdBarrier& b) {
    asm volatile("s_waitcnt vmcnt(0)" ::: "memory");
    __syncthreads();
    if (threadIdx.x == 0) {
        unsigned* bar = b.bar;
        __builtin_amdgcn_s_waitcnt(0);
        unsigned nloc = b.st[0], nx = b.st[1];
        if (nloc == 0u) { xcd_barrier_complete(bar, b.x, nloc, nx); b.st[0] = nloc; b.st[1] = nx; }
        const unsigned old = xb_add(&bar[XB_XSUB(b.x)], 1u);
        const unsigned gen = old / nloc;
        if (old + 1u == (gen + 1u) * nloc) {
            __builtin_amdgcn_fence(__ATOMIC_RELEASE, "agent");
            asm volatile("s_waitcnt vmcnt(0)" ::: "memory");
            const unsigned og = xb_add(&bar[XB_TOP], 1u);
            const unsigned tg = og / nx;
            if (og + 1u == (tg + 1u) * nx) xb_add(&bar[XB_TOPGEN], 1u);
            else XB_SPIN(xb_ld(&bar[XB_TOPGEN]) == tg, bar);
            __builtin_amdgcn_fence(__ATOMIC_ACQUIRE, "agent");
            xb_add(&bar[XB_XGEN(b.x)], 1u);
            asm volatile("s_waitcnt vmcnt(0)" ::: "memory");
        } else {
            XB_SPIN(xb_ld(&bar[XB_XGEN(b.x)]) == gen, bar);
            __builtin_amdgcn_fence(__ATOMIC_ACQUIRE, "agent");
            asm volatile("s_waitcnt vmcnt(0)" ::: "memory");
        }
    }
    __syncthreads();
}


constexpr int CW_XBAR = 32768;
#ifndef REP_SYNC
#define REP_SYNC 1
#endif
#ifndef REP_ATT
#define REP_ATT 1
#endif
#ifndef REP_SSM1
#define REP_SSM1 1
#endif
#ifndef REP_CONV
#define REP_CONV 1
#endif
#ifndef REP_P2
#define REP_P2 1
#endif
#ifndef REP_P3
#define REP_P3 1
#endif
#ifndef REP_P4
#define REP_P4 1
#endif
#ifndef REP_P56
#define REP_P56 1
#endif
__device__ __forceinline__ void grid_sync_all(cg::grid_group& grid) {
    asm volatile("s_waitcnt vmcnt(0) lgkmcnt(0)" ::: "memory");
    grid.sync();
    __builtin_amdgcn_fence(__ATOMIC_ACQUIRE, "agent");
    asm volatile("s_waitcnt vmcnt(0)" ::: "memory");
}
__device__ __forceinline__ int q_next(unsigned* ctr, LAS int* slot, int tid) {
    __syncthreads();
    if (tid == 0) *slot = (int)atomicAdd(ctr, 1u);
    __syncthreads();
    return *slot;
}

__global__ void __launch_bounds__(512, 2) fwd_kernel(Params Pk_unused) {
    KP P = (KP)__builtin_amdgcn_kernarg_segment_ptr();
    extern __shared__ __attribute__((aligned(16))) unsigned char lds_raw[];
    cg::grid_group grid = cg::this_grid();
    LAS unsigned char* lds = (LAS unsigned char*)lds_raw;
    LAS int* qslot = (LAS int*)(lds + 131072 + 1024);
    const int tid = threadIdx.x, lane = tid & 63, wid = __builtin_amdgcn_readfirstlane(tid >> 6);
    volatile LAS unsigned* xst = (volatile LAS unsigned*)(lds + 131072 + 2048);
    if (tid < 2) xst[tid] = 0u;
    __syncthreads();
    const XcdBarrier xbar = xcd_barrier_post((unsigned*)(P->ws + WS_CTL) + CW_XBAR, xst);

#ifndef REP_P0
#define REP_P0 1
#endif
    for (int r0_ = 0; r0_ < REP_P0; ++r0_) { if (r0_) __syncthreads(); p0_prologue(P, lds, tid, lane, wid); }
    for (int rs_ = 0; rs_ < REP_SYNC; ++rs_) xcd_barrier(xbar);
    if (xb_ld(&xbar.bar[XB_TMO]) != 0u) grid.sync();

#pragma unroll 1
    for (int l = 0; l < 2; ++l) {
#ifndef REP_P1
#define REP_P1 1
#endif
        for (int r1_ = 0; r1_ < REP_P1; ++r1_) p1_rows(P, l, lane, wid);
        for (int rs_ = 0; rs_ < REP_SYNC; ++rs_) xcd_barrier(xbar);
#ifndef NO_P2
#pragma unroll 1
        for (int rep_ = 0; rep_ < REP_P2; ++rep_) {
            RELOAD_P(P); unsigned char* ws = P->ws; const unsigned char* wl = ws + WS_W + (size_t)l * W_LAYER_B; bf16* Z = (bf16*)(ws + WS_Z); unsigned* ctl = (unsigned*)(ws + WS_CTL); (void)wl; (void)Z; (void)ctl;
            pg8::Gemm g{(const bf16*)(ws + WS_H), (const bf16*)wl, MTOK, NCOL, DM};
            pg8::WinOrder S{(int)gridDim.x, (int)blockIdx.x};
            pg8::EpiPlain E{Z, NCOL};
            pg8::gemm_phase<pg8::EpiPlain, pg8::WinOrder, true, true>(lds, g, S, E);
        }
#endif
        for (int rs_ = 0; rs_ < REP_SYNC; ++rs_) xcd_barrier(xbar);
#ifndef NO_P3
#pragma unroll 1
        for (int rep_ = 0; rep_ < REP_P3; ++rep_) {
            RELOAD_P(P); unsigned char* ws = P->ws; const unsigned char* wl = ws + WS_W + (size_t)l * W_LAYER_B; bf16* Z = (bf16*)(ws + WS_Z); unsigned* ctl = (unsigned*)(ws + WS_CTL); (void)wl; (void)Z; (void)ctl;
            unsigned* ctr = ctl + 64 * (1 + 2 * l) + 320 * rep_;
            unsigned pre0 = 0u; if (tid == 0) pre0 = atomicAdd(ctr, 1u);
            if (gridDim.x == 256) {
#pragma unroll 1
                for (int k = 0; k < 3; ++k) {
                    int item, gs;
                    if (k < 2) { item = (int)blockIdx.x + 256 * k; gs = wid; }
                    else { if (wid >= 4) break; item = 512 + ((int)blockIdx.x >> 1); gs = ((int)blockIdx.x & 1) * 4 + wid; }
                    ssm_item<1>(P, l, item, lds, tid, lane, wid, gs);
                }
            } else {
                for (int item = (int)blockIdx.x; item < 640; item += (int)gridDim.x) ssm_item<1>(P, l, item, lds, tid, lane, wid, wid);
            }
            int it;
            for (bool first = true;; first = false) {
                if (first) { __syncthreads(); if (tid == 0) *qslot = (int)pre0; __syncthreads(); it = *qslot; } else it = q_next(ctr, qslot, tid);
                if (it >= 376) break;
                if (it < 64 || it >= 120) {
                    const int ia = it < 64 ? it : it - 56;
                    for (int ra_ = 0; ra_ < REP_ATT; ++ra_) { if (ra_) __syncthreads(); attn_item(P, l, ia, lds, tid, lane, wid); }
                } else {
                    pg8::Gemm g{(const bf16*)(ws + WS_H), (const bf16*)wl, MTOK, NCOL, DM};
                    pg8::OneUnit S1{1024 + (it - 64)};
                    pg8::EpiPlain E{Z, NCOL};
                    pg8::gemm_phase<pg8::EpiPlain, pg8::OneUnit, true, true>(lds, g, S1, E);
                }
            }
            if (it < 1016) {
                float cw[32];
                { const float* wp = P->in[I_DWW] + (size_t)l * 31 * 512 + tid;
#pragma unroll
                  for (int k = 0; k < 31; ++k) cw[k] = wp[k * 512];
                  cw[31] = 0.f; }
                const float cbias = P->in[I_DWB][l * 512 + tid], clg = P->in[I_LNG][l * 512 + tid], clb = P->in[I_LNB][l * 512 + tid];
                unsigned nxt = 0u;
                do {
                    conv_item(P, l, it - 376, lds, tid, lane, wid, cw, cbias, clg, clb, ctr, nxt);
                    __syncthreads(); if (tid == 0) *qslot = (int)nxt; __syncthreads(); it = *qslot;
                } while (it < 1016);
            }
        }
#endif
        for (int rs_ = 0; rs_ < REP_SYNC; ++rs_) xcd_barrier(xbar);
#ifndef NO_P4
#pragma unroll 1
        for (int rep_ = 0; rep_ < REP_P4; ++rep_) {
            RELOAD_P(P); unsigned char* ws = P->ws; const unsigned char* wl = ws + WS_W + (size_t)l * W_LAYER_B; bf16* Z = (bf16*)(ws + WS_Z); unsigned* ctl = (unsigned*)(ws + WS_CTL); (void)wl; (void)Z; (void)ctl;
            unsigned* ctr = ctl + 64 * (2 + 2 * l) + 320 * rep_;
            (void)ctr;
            if (gridDim.x == 256) {
#pragma unroll 1
                for (int k = 0; k < 3; ++k) {
                    int item, gs;
                    if (k < 2) { item = (int)blockIdx.x + 256 * k; gs = wid; }
                    else { if (wid >= 4) break; item = 512 + ((int)blockIdx.x >> 1); gs = ((int)blockIdx.x & 1) * 4 + wid; }
                    const int it2 = item < 128 ? 512 + item : item - 128;
                    ssm_item<2>(P, l, it2, lds, tid, lane, wid, gs);
                }
            } else {
                for (int item = (int)blockIdx.x; item < 640; item += (int)gridDim.x) { const int it2 = item < 128 ? 512 + item : item - 128; ssm_item<2>(P, l, it2, lds, tid, lane, wid, wid); }
            }
#ifdef DBG_NAIVE_STATE
#pragma unroll 1
            for (int it = blockIdx.x; it < 256; it += gridDim.x) naive_state_item(P, l, it, tid);
#endif
        }
#endif
        for (int rs_ = 0; rs_ < REP_SYNC; ++rs_) xcd_barrier(xbar);
#pragma unroll 1
        for (int rep_ = 0; rep_ < REP_P56; ++rep_) {
            RELOAD_P(P); unsigned char* ws = P->ws; const unsigned char* wl = ws + WS_W + (size_t)l * W_LAYER_B; bf16* Z = (bf16*)(ws + WS_Z);
            const int G = (int)gridDim.x, NB = G >= 200 ? 160 : (G * 5) / 8;
            if ((int)blockIdx.x < NB) {
                pg8::Gemm g{(const bf16*)(ws + WS_ABR), (const bf16*)(wl + W_IN_B + W_GLU_B), 3 * MTOK, 3 * 1024, 512};
                pg8::BranchOrderX S{NB, (int)blockIdx.x};
                pg8::EpiBranch E{(bf16*)(ws + WS_H), Z + C_MERGE, NCOL};
                pg8::gemm_phase<pg8::EpiBranch, pg8::BranchOrderX, true, true>(lds, g, S, E);
            } else {
                pg8::Gemm g{(const bf16*)(ws + WS_YB), (const bf16*)(wl + W_IN_B), MTOK, 1024, 512};
                pg8::GluOrder S{G - NB, (int)blockIdx.x - NB};
                pg8::EpiGlu E{(bf16*)(ws + WS_ABR) + (size_t)MTOK * 512, Z + C_SGATE, NCOL};
                pg8::gemm_phase<pg8::EpiGlu, pg8::GluOrder, true, true>(lds, g, S, E);
            }
        }
        for (int rs_ = 0; rs_ < REP_SYNC; ++rs_) xcd_barrier(xbar);
#pragma unroll 1
        for (int rep_ = 0; rep_ < 1; ++rep_) {
            RELOAD_P(P); unsigned char* ws = P->ws; const unsigned char* wl = ws + WS_W + (size_t)l * W_LAYER_B; bf16* Z = (bf16*)(ws + WS_Z);
            pg8::Gemm g{(const bf16*)(ws + WS_ABR), (const bf16*)(wl + W_IN_B + W_GLU_B), 3 * MTOK, 3 * 1024, 512};
            pg8::BranchOrderY S{(int)gridDim.x, (int)blockIdx.x};
            pg8::EpiBranch E{(bf16*)(ws + WS_H), Z + C_MERGE, NCOL};
            pg8::gemm_phase<pg8::EpiBranch, pg8::BranchOrderY, true, true>(lds, g, S, E);
            if (l == 0 && defer_l1_weights() && blockIdx.x >= 160) convert_weights(P, 1, 1, 160, lds);
        }
        for (int rs_ = 0; rs_ < REP_SYNC; ++rs_) xcd_barrier(xbar);
#ifndef REP_P7L0
#define REP_P7L0 1
#endif
#pragma unroll 1
        for (int rep7_ = 0; rep7_ < (l == 0 ? REP_P7L0 : 1); ++rep7_) {
            RELOAD_P(P); unsigned char* ws = P->ws; const unsigned char* wl = ws + WS_W + (size_t)l * W_LAYER_B; bf16* Z = (bf16*)(ws + WS_Z); unsigned* ctl = (unsigned*)(ws + WS_CTL); (void)wl; (void)Z; (void)ctl;
            pg8::Gemm g{(const bf16*)(ws + WS_H), (const bf16*)(wl + W_IN_B + W_GLU_B + W_BR_B), MTOK, 1024, 1024};
            pg8::StaticOrder S; S.init(MTOK, 1024, (int)gridDim.x, (int)blockIdx.x);
            const float* gate = (const float*)(ws + WS_MODS) + (size_t)l * 3 * 3072 + 2048;
            pg8::EpiResid E{l == 0 ? P->in[I_XP] : P->out, l == 0 ? P->in[I_XS] : P->out + (size_t)MCTX * DM, P->out, gate};
            pg8::gemm_phase<pg8::EpiResid, pg8::StaticOrder, true, true>(lds, g, S, E);
            if (l == 0 && defer_l1_weights() && blockIdx.x >= 160) convert_weights(P, 1, 0, 160, lds);
        }
        if (l == 0) for (int rs_ = 0; rs_ < REP_SYNC; ++rs_) xcd_barrier(xbar);
    }
}

extern "C" void kernel_launch(void* const* d_in, const int* in_sizes, int n_in, void* d_out, int out_size, void* d_ws, size_t ws_size, hipStream_t stream) {
    static int grid = 0;
    if (grid == 0) {
        if (n_in != 31 || ws_size < WS_END) { fprintf(stderr, "kernel_launch: unexpected n_in %d / ws_size %zu (need %zu)\n", n_in, ws_size, (size_t)WS_END); grid = -1; return; }
        int dev = 0, cus = 0, per_cu = 0;
        hipGetDevice(&dev);
        hipDeviceGetAttribute(&cus, hipDeviceAttributeMultiprocessorCount, dev);
        if (hipFuncSetAttribute((const void*)fwd_kernel, hipFuncAttributeMaxDynamicSharedMemorySize, LDS_BYTES) != hipSuccess) { fprintf(stderr, "kernel_launch: hipFuncSetAttribute failed\n"); grid = -1; return; }
        if (hipOccupancyMaxActiveBlocksPerMultiprocessor(&per_cu, (const void*)fwd_kernel, 512, LDS_BYTES) != hipSuccess || per_cu < 1) { fprintf(stderr, "kernel_launch: occupancy query says %d\n", per_cu); (void)hipGetLastError(); per_cu = 1; }
        grid = cus * 1;
    }
    if (grid < 0) return;
    (void)hipMemsetAsync((char*)d_ws + WS_CTL, 0, CTL_ZERO_BYTES, stream);
    Params p{};
    for (int i = 0; i < 31; ++i) p.in[i] = (const float*)d_in[i];
    p.out = (float*)d_out; p.ws = (unsigned char*)d_ws;
    void* args[] = {&p};
    hipError_t e = hipLaunchCooperativeKernel((const void*)fwd_kernel, dim3(grid), dim3(512), args, LDS_BYTES, stream);
    if (e != hipSuccess) fprintf(stderr, "cooperative launch failed: %s (grid %d)\n", hipGetErrorString(e), grid);
}
```
